# Optimizing an MI355X kernel written in HIP

```python
import math
import jax
import jax.numpy as jnp
from jax import lax
import numpy as np

D_MODEL = 2048
BATCH = 32
SEQ = 256
DEPTH = 2
DEC_BATCH = 4
DEC_SEQ = 4096
PAST_LEN = 512

GRID_W = 64
BLOCK = 128
SSD_HEADS = 12
SSD_HEAD_DIM = 64
SSD_WIDTH = SSD_HEADS * SSD_HEAD_DIM
SSD_GROUPS = 2
SSD_D_STATE = 64
SSD_CONV_W = 3
SSD_CHUNK = 128
SSD_CONV_CH = SSD_WIDTH + 2 * SSD_GROUPS * SSD_D_STATE
ATT_HEADS = 12
ATT_KV_HEADS = 4
ATT_GROUP = ATT_HEADS // ATT_KV_HEADS
HEAD_DIM = 64
ATT_WIDTH = ATT_HEADS * HEAD_DIM
ATT_KV_WIDTH = ATT_KV_HEADS * HEAD_DIM
WINDOW = 128
ROPE_PER_AXIS = HEAD_DIM // 4
ROPE_BASE = 10000.0
S5_GROUPS = 32
S5_GROUP_CH = 16
S5_WIDTH = S5_GROUPS * S5_GROUP_CH
S5_P = 64
MIX_WIDTH = SSD_WIDTH + ATT_WIDTH + S5_WIDTH
D_FF = -(-(8 * D_MODEL) // (3 * 256)) * 256
OFF_Z = SSD_WIDTH
OFF_XBC = OFF_Z + SSD_CONV_CH
OFF_DT = OFF_XBC + 2 * SSD_HEADS
OFF_Q = OFF_DT + ATT_WIDTH
OFF_K = OFF_Q + ATT_KV_WIDTH
OFF_V = OFF_K + ATT_KV_WIDTH
D_IN = OFF_V + S5_WIDTH
IN_SPLITS = (OFF_Z, OFF_XBC, OFF_DT, OFF_Q, OFF_K, OFF_V)

kernel_name = 'hybrid_ssd_swa_s5_diffusion_step'


def rmsnorm(x, g, eps=1e-6):
    xf = x.astype(jnp.float32)
    y = xf * lax.rsqrt(jnp.mean(xf * xf, axis=-1, keepdims=True) + eps)
    return (y * g.astype(jnp.float32)).astype(x.dtype)


def dwconv_centred(x, w, b):
    k = w.shape[0]
    y = lax.conv_general_dilated(x, w[:, None, :].astype(x.dtype), window_strides=(1,),
                                 padding=[(k // 2, k // 2)],
                                 dimension_numbers=('NWC', 'WIO', 'NWC'),
                                 feature_group_count=w.shape[1])
    return y + b.astype(x.dtype)


def ssd_scan(x, dt, a_neg, bm, cm, h0):
    b, L, nh, hp = x.shape
    n = bm.shape[-1]
    q = SSD_CHUNK
    nc = L // q
    xc = (x * dt[..., None]).reshape(b, nc, q, nh, hp)
    bc = bm.reshape(b, nc, q, nh, n)
    cc = cm.reshape(b, nc, q, nh, n)
    cum = jnp.cumsum((dt * a_neg).reshape(b, nc, q, nh), axis=2)
    tri = jnp.tril(jnp.ones((q, q), dtype=bool))[None, None, :, :, None]
    seg = cum[:, :, :, None, :] - cum[:, :, None, :, :]
    decay = jnp.exp(jnp.where(tri, seg, -jnp.inf))
    scores = jnp.einsum('bclhn,bcshn->bclsh', cc, bc) * decay
    y_diag = jnp.einsum('bclsh,bcshp->bclhp', scores, xc)
    to_end = jnp.exp(cum[:, :, -1:, :] - cum)
    chunk_states = jnp.einsum('bcshn,bcsh,bcshp->bchpn', bc, to_end, xc)
    chunk_decay = jnp.exp(cum[:, :, -1, :])

    def step(h, inp):
        st, dec = inp
        return h * dec[:, :, None, None] + st, h

    h_final, h_start = lax.scan(step, h0, (jnp.moveaxis(chunk_states, 1, 0),
                                           jnp.moveaxis(chunk_decay, 1, 0)))
    h_start = jnp.moveaxis(h_start, 0, 1)
    y_off = jnp.einsum('bclhn,bchpn->bclhp', cc, h_start) * jnp.exp(cum)[..., None]
    return (y_diag + y_off).reshape(b, L, nh, hp), h_final


def ssd_mixer(z, xbc, dt_raw, P, l, h0_f, h0_b):
    b, L, _ = z.shape
    xbc = jax.nn.silu(dwconv_centred(xbc, P['ssd_conv_w'][l], P['ssd_conv_b'][l])).astype(jnp.float32)
    xs, bm, cm = jnp.split(xbc, [SSD_WIDTH, SSD_WIDTH + SSD_GROUPS * SSD_D_STATE], axis=-1)
    rep = SSD_HEADS // SSD_GROUPS
    xs = xs.reshape(b, L, SSD_HEADS, SSD_HEAD_DIM)
    bm = jnp.repeat(bm.reshape(b, L, SSD_GROUPS, SSD_D_STATE), rep, axis=2)
    cm = jnp.repeat(cm.reshape(b, L, SSD_GROUPS, SSD_D_STATE), rep, axis=2)
    dt = jax.nn.softplus(dt_raw.astype(jnp.float32).reshape(b, L, 2, SSD_HEADS)
                         + P['ssd_dt_bias'][l].astype(jnp.float32))
    a_neg = -jnp.exp(P['ssd_A_log'][l].astype(jnp.float32))
    y_f, h_f = ssd_scan(xs, dt[:, :, 0], a_neg[0], bm, cm, h0_f)
    y_b, h_b = ssd_scan(jnp.flip(xs, axis=1), jnp.flip(dt[:, :, 1], axis=1), a_neg[1],
                        jnp.flip(bm, axis=1), jnp.flip(cm, axis=1), h0_b)
    y = y_f + jnp.flip(y_b, axis=1) + P['ssd_D'][l].astype(jnp.float32)[:, None] * xs
    y = y.reshape(b, L, SSD_WIDTH) * jax.nn.silu(z.astype(jnp.float32))
    return rmsnorm(y, P['ssd_norm'][l]).astype(z.dtype), h_f, h_b


def axial_rope_tables(L):
    rows = L // GRID_W
    row = jnp.repeat(jnp.arange(rows, dtype=jnp.float32), GRID_W)
    col = jnp.tile(jnp.arange(GRID_W, dtype=jnp.float32), rows)
    inv = ROPE_BASE ** (-jnp.arange(ROPE_PER_AXIS, dtype=jnp.float32) / ROPE_PER_AXIS)
    ang = jnp.concatenate([row[:, None] * inv, col[:, None] * inv], axis=-1)
    return jnp.cos(ang), jnp.sin(ang)


def apply_rope(x, cos, sin):
    half = HEAD_DIM // 2
    xf = x.astype(jnp.float32)
    x1, x2 = xf[..., :half], xf[..., half:]
    c = cos[None, :, None, :]
    s = sin[None, :, None, :]
    return jnp.concatenate([x1 * c - x2 * s, x2 * c + x1 * s], axis=-1).astype(x.dtype)


def context_attention(q, k, v, sink):
    b, C, _, d = q.shape
    nq = C // BLOCK
    scale = HEAD_DIM ** -0.5
    qb = jnp.moveaxis(q.astype(jnp.float32).reshape(b, nq, BLOCK, ATT_KV_HEADS, ATT_GROUP, d), 1, 0)
    kf = k.astype(jnp.float32)
    vf = v.astype(jnp.float32)
    sk = jnp.broadcast_to(sink.astype(jnp.float32).reshape(ATT_KV_HEADS, ATT_GROUP)[None, :, :, None, None],
                          (b, ATT_KV_HEADS, ATT_GROUP, BLOCK, 1))

    def one(qblk):
        s = jnp.einsum('bqkgd,bckd->bkgqc', qblk, kf) * scale
        p = jax.nn.softmax(jnp.concatenate([sk, s], axis=-1), axis=-1)[..., 1:]
        return jnp.einsum('bkgqc,bckd->bqkgd', p, vf)

    o = lax.map(one, qb)
    return jnp.moveaxis(o, 0, 1).reshape(b, C, ATT_WIDTH).astype(q.dtype)


def latent_attention(q, k, v, ck, cv, sink):
    b, L, _, d = q.shape
    nb = L // BLOCK
    n_side = WINDOW // BLOCK
    span = BLOCK * (2 * n_side + 1)
    scale = HEAD_DIM ** -0.5
    qb = q.astype(jnp.float32).reshape(b, nb, BLOCK, ATT_KV_HEADS, ATT_GROUP, d)
    kp = jnp.pad(k.astype(jnp.float32), ((0, 0), (WINDOW, WINDOW), (0, 0), (0, 0)))
    vp = jnp.pad(v.astype(jnp.float32), ((0, 0), (WINDOW, WINDOW), (0, 0), (0, 0)))
    kwin = jnp.concatenate([kp[:, i * BLOCK:i * BLOCK + L].reshape(b, nb, BLOCK, ATT_KV_HEADS, d)
                            for i in range(2 * n_side + 1)], axis=2)
    vwin = jnp.concatenate([vp[:, i * BLOCK:i * BLOCK + L].reshape(b, nb, BLOCK, ATT_KV_HEADS, d)
                            for i in range(2 * n_side + 1)], axis=2)
    ckf = ck.astype(jnp.float32)
    cvf = cv.astype(jnp.float32)
    n_ctx = ckf.shape[1]
    sk = jnp.broadcast_to(sink.astype(jnp.float32).reshape(ATT_KV_HEADS, ATT_GROUP)[None, :, :, None, None],
                          (b, ATT_KV_HEADS, ATT_GROUP, BLOCK, 1))

    def one(args):
        qblk, kblk, vblk, n = args
        pos_q = n * BLOCK + jnp.arange(BLOCK)
        pos_k = n * BLOCK - WINDOW + jnp.arange(span)
        valid = (jnp.abs(pos_q[:, None] - pos_k[None, :]) <= WINDOW) & (pos_k >= 0) & (pos_k < L)
        s_band = jnp.where(valid, jnp.einsum('bqkgd,bskd->bkgqs', qblk, kblk) * scale, -jnp.inf)
        s_ctx = jnp.einsum('bqkgd,bckd->bkgqc', qblk, ckf) * scale
        p = jax.nn.softmax(jnp.concatenate([sk, s_ctx, s_band], axis=-1), axis=-1)
        return (jnp.einsum('bkgqc,bckd->bqkgd', p[..., 1:1 + n_ctx], cvf)
                + jnp.einsum('bkgqs,bskd->bqkgd', p[..., 1 + n_ctx:], vblk))

    o = lax.map(one, (jnp.moveaxis(qb, 1, 0), jnp.moveaxis(kwin, 1, 0),
                      jnp.moveaxis(vwin, 1, 0), jnp.arange(nb)))
    return jnp.moveaxis(o, 0, 1).reshape(b, L, ATT_WIDTH).astype(q.dtype)


def _linear_combine(e1, e2):
    a1, b1 = e1
    a2, b2 = e2
    return a1 * a2, a2 * b1 + b2


def s5_scan(bu, lam_bar, h0):
    bu = bu.at[:, 0].add(lam_bar[None] * h0)
    a = jnp.broadcast_to(lam_bar, bu.shape)
    _, hs = lax.associative_scan(_linear_combine, (a, bu), axis=1)
    return hs, hs[:, -1]


def s5_mixer(u, P, l, h0_f, h0_b):
    b, L, _ = u.shape
    uf = u.astype(jnp.float32)
    uc = uf.reshape(b, L, S5_GROUPS, S5_GROUP_CH).astype(jnp.complex64)
    b_in = lax.complex(P['s5_B_re'][l].astype(jnp.float32), P['s5_B_im'][l].astype(jnp.float32))
    y = P['s5_D'][l].astype(jnp.float32) * uf
    finals = []
    for d, h0 in enumerate((h0_f, h0_b)):
        lam = lax.complex(P['s5_A_re'][l, d].astype(jnp.float32), P['s5_A_im'][l, d].astype(jnp.float32))
        step = jnp.exp(P['s5_log_dt'][l, d].astype(jnp.float32))[:, None]
        lam_bar = jnp.exp(lam * step)
        b_bar = ((lam_bar - 1.0) / lam)[..., None] * b_in
        bu = jnp.einsum('blgc,gpc->blgp', uc, b_bar)
        if d == 1:
            bu = jnp.flip(bu, axis=1)
        hs, h_last = s5_scan(bu, lam_bar, h0)
        if d == 1:
            hs = jnp.flip(hs, axis=1)
        c_out = lax.complex(P['s5_C_re'][l, d].astype(jnp.float32), P['s5_C_im'][l, d].astype(jnp.float32))
        y = y + jnp.real(jnp.einsum('blgp,gcp->blgc', hs, c_out)).reshape(b, L, S5_WIDTH)
        finals.append(h_last)
    g = jax.nn.gelu(y)
    out = g * jax.nn.sigmoid(g @ P['s5_w_glu'][l].astype(jnp.float32) + P['s5_b_glu'][l].astype(jnp.float32))
    return out.astype(u.dtype), finals[0], finals[1]


def mixer_block(h, P, l, ctx):
    b, L, _ = h.shape
    proj = jnp.einsum('bld,de->ble', h, P['w_in'][l])
    z, xbc, dt_raw, q, k, v, u = jnp.split(proj, IN_SPLITS, axis=-1)
    q = q.reshape(b, L, ATT_HEADS, HEAD_DIM)
    k = k.reshape(b, L, ATT_KV_HEADS, HEAD_DIM)
    v = v.reshape(b, L, ATT_KV_HEADS, HEAD_DIM)
    sink = P['attn_sink'][l]
    if ctx is None:
        h0 = jnp.zeros((b, SSD_HEADS, SSD_HEAD_DIM, SSD_D_STATE), jnp.float32)
        s0 = jnp.zeros((b, S5_GROUPS, S5_P), jnp.complex64)
        o_att = context_attention(q, k, v, sink)
        y_ssd, h_f, h_b = ssd_mixer(z, xbc, dt_raw, P, l, h0, h0)
        y_s5, s_f, s_b = s5_mixer(u, P, l, s0, s0)
        new_ctx = (k, v, h_f, h_b, s_f, s_b)
    else:
        ck, cv, h0_f, h0_b, s0_f, s0_b = ctx
        cos, sin = axial_rope_tables(L)
        o_att = latent_attention(apply_rope(q, cos, sin), apply_rope(k, cos, sin), v, ck, cv, sink)
        y_ssd, _, _ = ssd_mixer(z, xbc, dt_raw, P, l, h0_f, h0_b)
        y_s5, _, _ = s5_mixer(u, P, l, s0_f, s0_b)
        new_ctx = None
    mix = jnp.concatenate([y_ssd, o_att, y_s5], axis=-1)
    return jnp.einsum('ble,ed->bld', mix, P['w_out'][l]), new_ctx


def trunk_layer(x, mod, P, l, ctx):
    sh1, sc1, g1, sh2, sc2, g2 = jnp.split(mod.astype(x.dtype), 6, axis=-1)
    h = rmsnorm(x, P['norm_mix_pre'][l]) * (1 + sc1) + sh1
    mix, new_ctx = mixer_block(h, P, l, ctx)
    x = x + g1 * rmsnorm(mix, P['norm_mix_post'][l])
    h = rmsnorm(x, P['norm_ffn_pre'][l]) * (1 + sc2) + sh2
    gate, up = jnp.split(jnp.einsum('bld,df->blf', h, P['w_ffn_in'][l]), 2, axis=-1)
    f = jnp.einsum('blf,fd->bld', jax.nn.silu(gate) * up, P['w_ffn_out'][l])
    x = x + g2 * rmsnorm(f, P['norm_ffn_post'][l])
    return x, new_ctx


def setup_inputs(seed: int = 0) -> dict:
    key = jax.random.key(seed)
    ks = iter(jax.random.split(key, 40))

    def nrm(shape, scale):
        return jax.random.normal(next(ks), shape, jnp.float32) * scale

    def unif(shape, lo, hi):
        return jax.random.uniform(next(ks), shape, jnp.float32, lo, hi)

    x_prompt = nrm((BATCH, SEQ, D_MODEL), 1.0)
    x_sample = nrm((DEC_BATCH, DEC_SEQ, D_MODEL), 1.0)
    c = nrm((DEC_BATCH, D_MODEL), 1.0)
    cache_k = nrm((DEC_BATCH, DEPTH, PAST_LEN, ATT_KV_HEADS, HEAD_DIM), 1.0)
    cache_v = nrm((DEC_BATCH, DEPTH, PAST_LEN, ATT_KV_HEADS, HEAD_DIM), 1.0)
    state_ssd = nrm((DEC_BATCH, DEPTH, 2, SSD_HEADS, SSD_HEAD_DIM, SSD_D_STATE), 0.5)
    state_s5_re = nrm((DEC_BATCH, DEPTH, 2, S5_GROUPS, S5_P), 0.5)
    state_s5_im = nrm((DEC_BATCH, DEPTH, 2, S5_GROUPS, S5_P), 0.5)
    c_ctx = nrm((D_MODEL,), 1.0)
    w_ada = nrm((DEPTH, D_MODEL, 6 * D_MODEL), 0.5 * D_MODEL ** -0.5)
    b_ada = nrm((DEPTH, 6 * D_MODEL), 0.02)
    norm_mix_pre = 1.0 + nrm((DEPTH, D_MODEL), 0.02)
    norm_mix_post = 1.0 + nrm((DEPTH, D_MODEL), 0.02)
    norm_ffn_pre = 1.0 + nrm((DEPTH, D_MODEL), 0.02)
    norm_ffn_post = 1.0 + nrm((DEPTH, D_MODEL), 0.02)
    w_in = nrm((DEPTH, D_MODEL, D_IN), D_MODEL ** -0.5)
    w_out = nrm((DEPTH, MIX_WIDTH, D_MODEL), MIX_WIDTH ** -0.5)
    ssd_conv_w = nrm((DEPTH, SSD_CONV_W, SSD_CONV_CH), SSD_CONV_W ** -0.5)
    ssd_conv_b = nrm((DEPTH, SSD_CONV_CH), 0.02)
    dt0 = jnp.exp(unif((DEPTH, 2, SSD_HEADS), math.log(1e-3), math.log(1e-1)))
    ssd_dt_bias = dt0 + jnp.log(-jnp.expm1(-dt0))
    ssd_A_log = jnp.log(unif((DEPTH, 2, SSD_HEADS), 1.0, 16.0))
    ssd_D = 1.0 + nrm((DEPTH, SSD_HEADS), 0.1)
    ssd_norm = 1.0 + nrm((DEPTH, SSD_WIDTH), 0.02)
    attn_sink = nrm((DEPTH, ATT_HEADS), 1.0)
    n_idx = jnp.arange(S5_P, dtype=jnp.float32)
    s5_A_re = -0.5 + nrm((DEPTH, 2, S5_GROUPS, S5_P), 0.01)
    s5_A_im = math.pi * n_idx + nrm((DEPTH, 2, S5_GROUPS, S5_P), 0.01)
    s5_log_dt = unif((DEPTH, 2, S5_GROUPS), math.log(1e-3), math.log(1e-1))
    s5_B_re = nrm((DEPTH, S5_GROUPS, S5_P, S5_GROUP_CH), (2 * S5_GROUP_CH) ** -0.5)
    s5_B_im = nrm((DEPTH, S5_GROUPS, S5_P, S5_GROUP_CH), (2 * S5_GROUP_CH) ** -0.5)
    s5_C_re = nrm((DEPTH, 2, S5_GROUPS, S5_GROUP_CH, S5_P), (2 * S5_P) ** -0.5)
    s5_C_im = nrm((DEPTH, 2, S5_GROUPS, S5_GROUP_CH, S5_P), (2 * S5_P) ** -0.5)
    s5_D = nrm((DEPTH, S5_WIDTH), 1.0)
    s5_w_glu = nrm((DEPTH, S5_WIDTH, S5_WIDTH), S5_WIDTH ** -0.5)
    s5_b_glu = nrm((DEPTH, S5_WIDTH), 0.02)
    w_ffn_in = nrm((DEPTH, D_MODEL, 2 * D_FF), D_MODEL ** -0.5)
    w_ffn_out = nrm((DEPTH, D_FF, D_MODEL), D_FF ** -0.5)
    return {'x_prompt': x_prompt, 'x_sample': x_sample, 'c': c,
            'cache_k': cache_k, 'cache_v': cache_v, 'state_ssd': state_ssd,
            'state_s5_re': state_s5_re, 'state_s5_im': state_s5_im, 'c_ctx': c_ctx,
            'w_ada': w_ada, 'b_ada': b_ada,
            'norm_mix_pre': norm_mix_pre, 'norm_mix_post': norm_mix_post,
            'norm_ffn_pre': norm_ffn_pre, 'norm_ffn_post': norm_ffn_post,
            'w_in': w_in, 'w_out': w_out,
            'ssd_conv_w': ssd_conv_w, 'ssd_conv_b': ssd_conv_b, 'ssd_dt_bias': ssd_dt_bias,
            'ssd_A_log': ssd_A_log, 'ssd_D': ssd_D, 'ssd_norm': ssd_norm,
            'attn_sink': attn_sink,
            's5_A_re': s5_A_re, 's5_A_im': s5_A_im, 's5_log_dt': s5_log_dt,
            's5_B_re': s5_B_re, 's5_B_im': s5_B_im, 's5_C_re': s5_C_re, 's5_C_im': s5_C_im,
            's5_D': s5_D, 's5_w_glu': s5_w_glu, 's5_b_glu': s5_b_glu,
            'w_ffn_in': w_ffn_in, 'w_ffn_out': w_ffn_out}


def reference(x_prompt, x_sample, c, cache_k, cache_v, state_ssd, state_s5_re, state_s5_im, c_ctx,
              w_ada, b_ada, norm_mix_pre, norm_mix_post, norm_ffn_pre, norm_ffn_post,
              w_in, w_out, ssd_conv_w, ssd_conv_b, ssd_dt_bias, ssd_A_log, ssd_D, ssd_norm,
              attn_sink, s5_A_re, s5_A_im, s5_log_dt, s5_B_re, s5_B_im, s5_C_re, s5_C_im,
              s5_D, s5_w_glu, s5_b_glu, w_ffn_in, w_ffn_out):
    P = {'norm_mix_pre': norm_mix_pre, 'norm_mix_post': norm_mix_post,
         'norm_ffn_pre': norm_ffn_pre, 'norm_ffn_post': norm_ffn_post,
         'w_in': w_in, 'w_out': w_out,
         'ssd_conv_w': ssd_conv_w, 'ssd_conv_b': ssd_conv_b, 'ssd_dt_bias': ssd_dt_bias,
         'ssd_A_log': ssd_A_log, 'ssd_D': ssd_D, 'ssd_norm': ssd_norm,
         'attn_sink': attn_sink,
         's5_A_re': s5_A_re, 's5_A_im': s5_A_im, 's5_log_dt': s5_log_dt,
         's5_B_re': s5_B_re, 's5_B_im': s5_B_im, 's5_C_re': s5_C_re, 's5_C_im': s5_C_im,
         's5_D': s5_D, 's5_w_glu': s5_w_glu, 's5_b_glu': s5_b_glu,
         'w_ffn_in': w_ffn_in, 'w_ffn_out': w_ffn_out}
    out_dtype = x_prompt.dtype

    xp = x_prompt
    ks, vs, ssd_st, s5_re, s5_im = [], [], [], [], []
    for l in range(DEPTH):
        mod = (jax.nn.silu(c_ctx) @ w_ada[l] + b_ada[l])[None, None, :]
        xp, (k, v, h_f, h_b, s_f, s_b) = trunk_layer(xp, mod, P, l, None)
        ks.append(k)
        vs.append(v)
        ssd_st.append(jnp.stack([h_f, h_b], axis=1))
        s5_re.append(jnp.stack([jnp.real(s_f), jnp.real(s_b)], axis=1))
        s5_im.append(jnp.stack([jnp.imag(s_f), jnp.imag(s_b)], axis=1))
    new_cache_k = jnp.stack(ks, axis=1)
    new_cache_v = jnp.stack(vs, axis=1)
    new_state_ssd = jnp.stack(ssd_st, axis=1).astype(out_dtype)
    new_state_s5_re = jnp.stack(s5_re, axis=1).astype(out_dtype)
    new_state_s5_im = jnp.stack(s5_im, axis=1).astype(out_dtype)

    xs = x_sample
    for l in range(DEPTH):
        mod = (jax.nn.silu(c) @ w_ada[l] + b_ada[l])[:, None, :]
        ctx = (cache_k[:, l], cache_v[:, l],
               state_ssd[:, l, 0].astype(jnp.float32), state_ssd[:, l, 1].astype(jnp.float32),
               lax.complex(state_s5_re[:, l, 0].astype(jnp.float32), state_s5_im[:, l, 0].astype(jnp.float32)),
               lax.complex(state_s5_re[:, l, 1].astype(jnp.float32), state_s5_im[:, l, 1].astype(jnp.float32)))
        xs, _ = trunk_layer(xs, mod, P, l, ctx)

    return (xp, xs, new_cache_k, new_cache_v, new_state_ssd, new_state_s5_re, new_state_s5_im)
```

```cpp
#include <hip/hip_runtime.h>
#include <hip/hip_bf16.h>
#include <hip/hip_cooperative_groups.h>
#include <cstdio>
namespace cg = cooperative_groups;

#ifndef PHMASK
#define PHMASK 0xFFFFu
#endif
#define PHON(b) ((PHMASK >> (b)) & 1u)
#ifndef MULTI_LAUNCH
#define MULTI_LAUNCH 0
#endif

typedef unsigned short u16;
using bf16x8 = __attribute__((ext_vector_type(8))) short;
using s16x4 = __attribute__((ext_vector_type(4))) short;
using f32x4 = __attribute__((ext_vector_type(4))) float;
using f32x16 = __attribute__((ext_vector_type(16))) float;
#define DI __device__ __forceinline__
#define LAS __attribute__((address_space(3)))

constexpr int T = 24576, TC = 8192, DM = 2048, NP = 3840, DFF = 5632, DIN = 3608;
constexpr int C_Z = 0, C_X = 768, C_B = 1536, C_C = 1664, C_Q = 1792, C_K = 2560, C_V = 2816, C_U = 3072, C_DT = 3584;
constexpr int NPH = 24;
#ifndef NPH_RUN
#define NPH_RUN NPH
#endif
constexpr int DYN_LDS = 139264;

constexpr size_t OUT_X = 0, OUT_CK = 50331648, OUT_CV = 54525952, OUT_SSD = 58720256, OUT_S5R = 65011712, OUT_S5I = 65273856;

constexpr size_t O_WIN = 0;
constexpr size_t O_WOUT = O_WIN + 31457280;
constexpr size_t O_WFFI = O_WOUT + 16777216;
constexpr size_t O_WFFO = O_WFFI + 92274688;
constexpr size_t O_WGLU = O_WFFO + 46137344;
constexpr size_t O_MOD = O_WGLU + 1048576;
constexpr size_t O_S5T = O_MOD + 491520;
constexpr size_t O_KC = O_S5T + 1179648;
constexpr size_t O_VCT = O_KC + 2097152;
constexpr size_t O_DT = O_VCT + 2097152;
constexpr size_t O_DTV = O_DT + 3145728;
constexpr size_t O_CDEC = O_DTV + 3145728;
constexpr size_t O_S5S = O_CDEC + 32768;
constexpr size_t O_SST = O_S5S + 6291456;
constexpr size_t O_G5 = O_SST + 75497472;
constexpr size_t O_VT = O_G5 + 25165824;
constexpr size_t O_PROJ = O_VT + 12582912;
constexpr size_t O_MIX = O_PROJ + 188743680;
constexpr size_t O_H = O_MIX + 100663296;
constexpr size_t O_XC = O_H;
constexpr size_t O_YF = O_XC + 50331648;
constexpr size_t O_YB = O_YF + 37748736;
constexpr size_t O_END = O_YB + 37748736;
constexpr size_t O_ACT = O_PROJ;
constexpr int S5T_L = 147456;

enum { I_XP = 0, I_XS, I_C, I_CK, I_CV, I_SSD, I_S5R, I_S5I, I_CCTX, I_WADA, I_BADA, I_NMPRE, I_NMPOST, I_NFPRE, I_NFPOST,
       I_WIN, I_WOUT, I_CONVW, I_CONVB, I_DTB, I_ALOG, I_SSDD, I_SSDN, I_SINK, I_ARE, I_AIM, I_LOGDT, I_BRE, I_BIM, I_CRE, I_CIM,
       I_S5D, I_WGLU, I_BGLU, I_WFFI, I_WFFO, N_IN };

struct P {
  const float* in[N_IN];
  float* out;
  char* ws;
  int lo, hi;
  const float* const* inp;
};

DI const float* pin(const P& p, int i) { asm volatile("" : "+s"(i)); return p.inp[i]; }
DI int otid() { int t = threadIdx.x; asm volatile("" : "+v"(t)); return t; }
DI u16 f2bf(float x) { unsigned u = __float_as_uint(x); u += 0x7fffu + ((u >> 16) & 1u); return (u16)(u >> 16); }
DI float bf2f(u16 h) { return __uint_as_float(((unsigned)h) << 16); }
DI float bfs(short h) { return __uint_as_float(((unsigned)(u16)h) << 16); }
DI float wsum(float v) { for (int o = 32; o > 0; o >>= 1) v += __shfl_xor(v, o); return v; }
DI float siluf(float x) { return x / (1.f + __expf(-x)); }
DI void sincos_acc(float x, float& sn, float& cs) {
  float n = rintf(x * 0.63661977236758f);
  float r = fmaf(n, -1.5707962513e+0f, x);
  r = fmaf(n, -7.5497899549e-8f, r);
  float r2 = r * r;
  float sp = fmaf(r * r2, fmaf(r2, fmaf(r2, -1.9515295891e-4f, 8.3321608736e-3f), -1.6666654611e-1f), r);
  float cp = fmaf(r2, fmaf(r2, fmaf(r2, fmaf(r2, 2.443315711809948e-5f, -1.388731625493765e-3f), 4.166664568298827e-2f), -0.5f), 1.f);
  int q = ((int)n) & 3;
  sn = (q == 0) ? sp : (q == 1) ? cp : (q == 2) ? -sp : -cp;
  cs = (q == 0) ? cp : (q == 1) ? -sp : (q == 2) ? -cp : sp;
}
DI int modrow(int t) { return t < TC ? 0 : 1 + ((t - TC) >> 12); }
DI void chunk_info(int gc, int& seq, int& c, int& nc) {
  if (gc < 64) { seq = gc >> 1; c = gc & 1; nc = 2; } else { seq = 32 + ((gc - 64) >> 5); c = (gc - 64) & 31; nc = 32; }
}
DI int chunk_of(int seq, int c) { return seq < 32 ? seq * 2 + c : 64 + (seq - 32) * 32 + c; }

constexpr int BM = 256, BK = 64, HALF = 128, HT = HALF * BK;
DI int lds_byte(int r, int c) {
  int st = (r >> 4) * 2 + (c >> 5), rr = r & 15, cc = c & 31, ob = rr * 64 + cc * 2;
  return st * 1024 + (ob ^ (((ob >> 9) & 1) << 5));
}
DI void stage_rc(int b, int& R, int& C) {
  int st = b / 1024, sb = b % 1024, swz = sb ^ (((sb >> 9) & 1) << 5);
  R = (st >> 1) * 16 + swz / 64; C = (st & 1) * 32 + (swz % 64) / 2;
}

struct EpiProj {
  u16* proj; float* dt; float* out; int l;
  DI void apply(int row0, int col0, int fr, const f32x4& v0, const f32x4& v1) const {
#pragma unroll
    for (int n = 0; n < 2; ++n) {
      const f32x4& v = n ? v1 : v0;
      int col = col0 + n * 16;
#pragma unroll
      for (int j = 0; j < 4; ++j) proj[(size_t)(row0 + j) * NP + col] = f2bf(v[j]);
      if (col >= C_DT && col < C_DT + 24) {
#pragma unroll
        for (int j = 0; j < 4; ++j) dt[(size_t)(row0 + j) * 32 + (col - C_DT)] = v[j];
      }
      if (col >= C_K && col < C_U && row0 < TC) {
        float* o = out + (col < C_V ? OUT_CK : OUT_CV);
        int cc = (col - C_K) & 255;
#pragma unroll
        for (int j = 0; j < 4; ++j) { int r = row0 + j; o[(size_t)((r >> 8) * 512 + l * 256 + (r & 255)) * 256 + cc] = v[j]; }
      }
    }
  }
};
struct EpiBf16 {
  u16* dst;
  DI void apply(int row0, int col0, int fr, const f32x4& v0, const f32x4& v1) const {
#pragma unroll
    for (int j = 0; j < 4; ++j) { dst[(size_t)(row0 + j) * DM + col0] = f2bf(v0[j]); dst[(size_t)(row0 + j) * DM + col0 + 16] = f2bf(v1[j]); }
  }
};
struct EpiSwiglu {
  u16* act;
  DI void apply(int row0, int col0, int fr, const f32x4& v0, const f32x4& v1) const {
    int ac = ((col0 - fr) >> 1) + fr;
#pragma unroll
    for (int j = 0; j < 4; ++j) act[(size_t)(row0 + j) * DFF + ac] = f2bf(siluf(v0[j]) * v1[j]);
  }
};
struct EpiGlu {
  const u16* g5; const float* b; u16* mix;
  DI void apply(int row0, int col0, int fr, const f32x4& v0, const f32x4& v1) const {
#pragma unroll
    for (int n = 0; n < 2; ++n) {
      const f32x4& v = n ? v1 : v0;
      int col = col0 + n * 16; float bb = b[col];
#pragma unroll
      for (int j = 0; j < 4; ++j) {
        float g = bf2f(g5[(size_t)(row0 + j) * 512 + col]);
        mix[(size_t)(row0 + j) * DM + 1536 + col] = f2bf(g / (1.f + __expf(-(v[j] + bb))));
      }
    }
  }
};

template <class Epi>
__device__ __forceinline__ void gemm_tile(const u16* __restrict__ A, const u16* __restrict__ Bt, int K, int brow, int bcol, const Epi& epi, LAS char* shm) {
#define SA(b, h) (shm + ((b) * 2 + (h)) * (HT * 2))
#define SB(b, h) (shm + (4 + (b) * 2 + (h)) * (HT * 2))
#define STAGE(Pp, BASE, br, kt) do { const char* _gb = (const char*)(BASE) + ((long)(br) * K + (long)(kt) * BK) * 2; \
    __builtin_amdgcn_global_load_lds((const unsigned*)(_gb + voff0), (LAS unsigned*)((Pp) + ldsw), 16, 0, 0); \
    __builtin_amdgcn_global_load_lds((const unsigned*)(_gb + voff1), (LAS unsigned*)((Pp) + ldsw + 8192), 16, 0, 0); } while (0)
#define LDA(dst, b, h) _Pragma("unroll") for (int m = 0; m < 4; ++m) _Pragma("unroll") for (int k = 0; k < 2; ++k) \
    dst[m][k] = *(const LAS bf16x8*)(SA(b, h) + aoff + m * 2048 + k * 1024)
#define LDB(dst, b, h) _Pragma("unroll") for (int n = 0; n < 2; ++n) _Pragma("unroll") for (int k = 0; k < 2; ++k) \
    dst[n][k] = *(const LAS bf16x8*)(SB(b, h) + boff + n * 2048 + k * 1024)
#define MMA(ai, bj, At_, Bt_) do { __builtin_amdgcn_s_setprio(1); \
    _Pragma("unroll") for (int m = 0; m < 4; ++m) _Pragma("unroll") for (int n = 0; n < 2; ++n) _Pragma("unroll") for (int k = 0; k < 2; ++k) \
      acc[ai][bj][m][n] = __builtin_amdgcn_mfma_f32_16x16x32_bf16(At_[m][k], Bt_[n][k], acc[ai][bj][m][n], 0, 0, 0); \
    __builtin_amdgcn_s_setprio(0); } while (0)
#define WAIT_V(n) asm volatile("s_waitcnt vmcnt(" #n ")" ::: "memory")
#define WAIT_L(n) asm volatile("s_waitcnt lgkmcnt(" #n ")" ::: "memory")
#define BAR __builtin_amdgcn_s_barrier()
#define SCHED __builtin_amdgcn_sched_barrier(0)
  const int tid_ = otid(), wid = __builtin_amdgcn_readfirstlane(tid_ >> 6), lane = tid_ & 63, wr = wid >> 2, wc = wid & 3, fr = lane & 15, fq = lane >> 4;
  const int ldsw = tid_ * 16;
  unsigned voff0, voff1;
  { int r_, c_; stage_rc(ldsw, r_, c_); voff0 = (unsigned)(r_ * K + c_) * 2u; stage_rc(ldsw + 8192, r_, c_); voff1 = (unsigned)(r_ * K + c_) * 2u; }
  const int aoff = lds_byte(wr * 64 + fr, fq * 8), boff = lds_byte(wc * 32 + fr, fq * 8);
  f32x4 acc[2][2][4][2];
#pragma unroll
  for (int a = 0; a < 2; ++a)
#pragma unroll
    for (int b = 0; b < 2; ++b)
#pragma unroll
      for (int m = 0; m < 4; ++m)
#pragma unroll
        for (int n = 0; n < 2; ++n) acc[a][b][m][n] = (f32x4){0.f, 0.f, 0.f, 0.f};
  bf16x8 At[4][2], B0[2][2], B1[2][2];
  const int nt = K / BK;
  STAGE(SB(0, 0), Bt, bcol, 0); STAGE(SA(0, 0), A, brow, 0);
  STAGE(SB(0, 1), Bt, bcol + HALF, 0); STAGE(SA(0, 1), A, brow + HALF, 0);
  if (wr == 1) BAR;
  WAIT_V(4); BAR;
  STAGE(SB(1, 0), Bt, bcol, 1); STAGE(SA(1, 0), A, brow, 1); STAGE(SB(1, 1), Bt, bcol + HALF, 1);
  WAIT_V(6); BAR;
  for (int t = 0; t < nt - 2; t += 2) {
    LDB(B0, 0, 0); SCHED; LDA(At, 0, 0); STAGE(SA(1, 1), A, brow + HALF, t + 1);
    WAIT_L(8); BAR; WAIT_L(0); MMA(0, 0, At, B0); BAR; SCHED;
    LDB(B1, 0, 1); STAGE(SB(0, 0), Bt, bcol, t + 2);
    BAR; WAIT_L(0); MMA(0, 1, At, B1); BAR;
    LDA(At, 0, 1); STAGE(SA(0, 0), A, brow, t + 2);
    BAR; WAIT_L(0); MMA(1, 0, At, B0); BAR; SCHED;
    STAGE(SB(0, 1), Bt, bcol + HALF, t + 2);
    WAIT_V(6); BAR; MMA(1, 1, At, B1); BAR;
    LDB(B0, 1, 0); SCHED; LDA(At, 1, 0); STAGE(SA(0, 1), A, brow + HALF, t + 2);
    WAIT_L(8); BAR; WAIT_L(0); MMA(0, 0, At, B0); BAR; SCHED;
    LDB(B1, 1, 1); STAGE(SB(1, 0), Bt, bcol, t + 3);
    BAR; WAIT_L(0); MMA(0, 1, At, B1); BAR;
    LDA(At, 1, 1); STAGE(SA(1, 0), A, brow, t + 3);
    BAR; WAIT_L(0); MMA(1, 0, At, B0); BAR; SCHED;
    STAGE(SB(1, 1), Bt, bcol + HALF, t + 3);
    WAIT_V(6); BAR; MMA(1, 1, At, B1); BAR;
  }
  { LDB(B0, 0, 0); LDA(At, 0, 0); STAGE(SA(1, 1), A, brow + HALF, nt - 1);
    BAR; WAIT_L(0); MMA(0, 0, At, B0); BAR;
    LDB(B1, 0, 1); BAR; WAIT_L(0); MMA(0, 1, At, B1); BAR;
    LDA(At, 0, 1); WAIT_V(4); BAR; WAIT_L(0); MMA(1, 0, At, B0); MMA(1, 1, At, B1); BAR; }
  { LDB(B0, 1, 0); LDA(At, 1, 0); WAIT_V(2); BAR; WAIT_L(0); MMA(0, 0, At, B0); BAR;
    LDB(B1, 1, 1); WAIT_V(0); BAR; WAIT_L(0); MMA(0, 1, At, B1); BAR;
    LDA(At, 1, 1); BAR; WAIT_L(0); MMA(1, 0, At, B0); MMA(1, 1, At, B1); BAR; }
  if (wr == 0) BAR;
#pragma unroll
  for (int ai = 0; ai < 2; ++ai)
#pragma unroll
    for (int bj = 0; bj < 2; ++bj)
#pragma unroll
      for (int m = 0; m < 4; ++m)
        epi.apply(brow + ai * HALF + wr * 64 + m * 16 + fq * 4, bcol + bj * HALF + wc * 32 + fr, fr, acc[ai][bj][m][0], acc[ai][bj][m][1]);
#undef SA
#undef SB
#undef STAGE
#undef LDA
#undef LDB
#undef MMA
}

template <class Epi>
__device__ __forceinline__ void gemm_phase(const u16* A, const u16* Bt, int M, int N, int K, const Epi& epi, LAS char* shm, int rot) {
  const int G = gridDim.x;
  int b = ((int)blockIdx.x + G - rot) % G;
  int vb = (G % 8 == 0) ? (b % 8) * (G / 8) + b / 8 : b;
  const int nM = M / BM, nN = N / BM, ntile = nM * nN;
  for (int id = vb; id < ntile; id += G) {
    int nig = 8 * nN, gid = id / nig, fm = gid * 8, gsz = min(nM - fm, 8);
    int pm = fm + ((id % nig) % gsz), pn = (id % nig) / gsz;
    gemm_tile(A, Bt, K, pm * BM, pn * BM, epi, shm);
    __syncthreads();
  }
}

DI int colmap(int kind, int n) {
  if (kind == 0) { if (n < 1792) return n; if (n < 3584) return n + 24; if (n < 3608) return n - 3584 + 1792; return -1; }
  if (kind == 2) { int jb = n >> 5, half = (n >> 4) & 1, jj = n & 15; return half * DFF + jb * 16 + jj; }
  return n;
}
DI void conv_tile(const float* __restrict__ src, int K, int N, u16* dst, int kind, int tile, LAS float* lds) {
  const int ntk = K >> 6, nt0 = tile / ntk, kt = tile - nt0 * ntk, n0 = nt0 * 64, k0 = kt * 64, tid = otid();
  { int nn = tid & 63, kr = tid >> 6; int sc = colmap(kind, n0 + nn);
#pragma unroll
    for (int i = 0; i < 8; ++i) { int kk = kr + 8 * i; lds[kk * 65 + nn] = sc >= 0 ? src[(size_t)(k0 + kk) * N + sc] : 0.f; } }
  __syncthreads();
  { int nn = tid >> 3, kq = tid & 7; bf16x8 v;
#pragma unroll
    for (int e = 0; e < 8; ++e) v[e] = (short)f2bf(lds[(kq * 8 + e) * 65 + nn]);
    *(bf16x8*)(dst + (size_t)(n0 + nn) * K + k0 + kq * 8) = v; }
  __syncthreads();
}

DI void ph_init(const P& p, LAS char* shm) {
  LAS float* lds = (LAS float*)shm;
  const int tid = otid();
  constexpr int N_MOD = 768, N_CV_L = 1920 + 1024 + 5632 + 2816 + 64, N_CV = 2 * N_CV_L, N_TAB = 16, N_CACHE = 4096;
  constexpr int TOTAL = N_MOD + N_CV + N_TAB + N_CACHE;
  for (int it = blockIdx.x; it < TOTAL; it += gridDim.x) {
    if (it < N_MOD) {
      int l = it / 384, r = it % 384, jb = r >> 4, ks = r & 15, j = jb * 512 + tid, k0 = ks * 128;
      for (int e = tid; e < 5 * 128; e += 512) { int v = e >> 7, kk = e & 127; float c = v == 0 ? pin(p, I_CCTX)[k0 + kk] : pin(p, I_C)[(v - 1) * DM + k0 + kk]; lds[e] = siluf(c); }
      __syncthreads();
      float a0 = 0, a1 = 0, a2 = 0, a3 = 0, a4 = 0;
      const float* w = pin(p, I_WADA) + ((size_t)l * DM + k0) * 12288 + j;
#pragma unroll 4
      for (int kk = 0; kk < 128; ++kk) { float wv = w[(size_t)kk * 12288]; a0 += lds[kk] * wv; a1 += lds[128 + kk] * wv; a2 += lds[256 + kk] * wv; a3 += lds[384 + kk] * wv; a4 += lds[512 + kk] * wv; }
      float bias = ks == 0 ? pin(p, I_BADA)[l * 12288 + j] : 0.f;
      float* mod = (float*)(p.ws + O_MOD) + (size_t)l * 5 * 12288 + j;
      atomicAdd(mod, a0 + bias); atomicAdd(mod + 12288, a1 + bias); atomicAdd(mod + 2 * 12288, a2 + bias); atomicAdd(mod + 3 * 12288, a3 + bias); atomicAdd(mod + 4 * 12288, a4 + bias);
      __syncthreads();
    } else if (it < N_MOD + N_CV) {
      int r = it - N_MOD, l = r / N_CV_L; r -= l * N_CV_L;
      if (r < 1920) conv_tile(pin(p, I_WIN) + (size_t)l * DM * DIN, DM, DIN, (u16*)(p.ws + O_WIN) + (size_t)l * NP * DM, 0, r, lds);
      else if ((r -= 1920) < 1024) conv_tile(pin(p, I_WOUT) + (size_t)l * DM * DM, DM, DM, (u16*)(p.ws + O_WOUT) + (size_t)l * DM * DM, 1, r, lds);
      else if ((r -= 1024) < 5632) conv_tile(pin(p, I_WFFI) + (size_t)l * DM * 2 * DFF, DM, 2 * DFF, (u16*)(p.ws + O_WFFI) + (size_t)l * 2 * DFF * DM, 2, r, lds);
      else if ((r -= 5632) < 2816) conv_tile(pin(p, I_WFFO) + (size_t)l * DFF * DM, DFF, DM, (u16*)(p.ws + O_WFFO) + (size_t)l * DM * DFF, 1, r, lds);
      else { r -= 2816; conv_tile(pin(p, I_WGLU) + (size_t)l * 512 * 512, 512, 512, (u16*)(p.ws + O_WGLU) + (size_t)l * 512 * 512, 1, r, lds); }
    } else if (it < N_MOD + N_CV + N_TAB) {
      int idx = (it - N_MOD - N_CV) * 512 + tid;
      int l = idx >> 12, d = (idx >> 11) & 1, g = (idx >> 6) & 31, pp = idx & 63;
      int ai = ((l * 2 + d) * 32 + g) * 64 + pp;
      float are = pin(p, I_ARE)[ai], aim = pin(p, I_AIM)[ai];
      float step = __expf(pin(p, I_LOGDT)[(l * 2 + d) * 32 + g]);
      float er = __expf(are * step), sn, cs; sincos_acc(aim * step, sn, cs);
      float lbr = er * cs, lbi = er * sn;
      float qr = lbr, qi = lbi;
      for (int i = 0; i < 7; ++i) { float nr = qr * qr - qi * qi, ni = 2.f * qr * qi; qr = nr; qi = ni; }
      float den = are * are + aim * aim;
      float cr = ((lbr - 1.f) * are + lbi * aim) / den, ci = (lbi * are - (lbr - 1.f) * aim) / den;
      float* tab = (float*)(p.ws + O_S5T) + (size_t)l * S5T_L;
      int e = (d * 32 + g) * 64 + pp;
      tab[e * 2] = lbr; tab[e * 2 + 1] = lbi; tab[8192 + e * 2] = qr; tab[8192 + e * 2 + 1] = qi;
      const float* bre = pin(p, I_BRE) + ((size_t)(l * 32 + g) * 64 + pp) * 16;
      const float* bim = pin(p, I_BIM) + ((size_t)(l * 32 + g) * 64 + pp) * 16;
      for (int c = 0; c < 16; ++c) { float br = bre[c], bi = bim[c]; tab[16384 + e * 32 + c * 2] = cr * br - ci * bi; tab[16384 + e * 32 + c * 2 + 1] = cr * bi + ci * br; }
    } else {
      int r = it - N_MOD - N_CV - N_TAB;
      if (r < 2048) { int e = r * 512 + tid; int d = e & 63, j = (e >> 6) & 511, kvh = (e >> 15) & 3, b = (e >> 17) & 3, l = e >> 19;
        ((u16*)(p.ws + O_KC))[e] = f2bf(pin(p, I_CK)[((size_t)((b * 2 + l) * 512 + j) * 4 + kvh) * 64 + d]); }
      else { int e = (r - 2048) * 512 + tid; int j = e & 511, d = (e >> 9) & 63, kvh = (e >> 15) & 3, b = (e >> 17) & 3, l = e >> 19;
        ((u16*)(p.ws + O_VCT))[e] = f2bf(pin(p, I_CV)[((size_t)((b * 2 + l) * 512 + j) * 4 + kvh) * 64 + d]); }
    }
  }
}

DI void ph_prenorm(const P& p) {
  const int tid_ = otid(), lane = tid_ & 63, wave = __builtin_amdgcn_readfirstlane(tid_ >> 6);
  const float* mod = (const float*)(p.ws + O_MOD);
  const float* gw = pin(p, I_NMPRE);
  u16* H = (u16*)(p.ws + O_H);
  for (int r = blockIdx.x * 8 + wave; r < T; r += gridDim.x * 8) {
    const float* x = r < TC ? pin(p, I_XP) + (size_t)r * DM : pin(p, I_XS) + (size_t)(r - TC) * DM;
    const float* mr = mod + (size_t)modrow(r) * 12288;
    float4 v[8]; float ss = 0.f;
#pragma unroll
    for (int i = 0; i < 8; ++i) { v[i] = *(const float4*)(x + i * 256 + lane * 4); ss += v[i].x * v[i].x + v[i].y * v[i].y + v[i].z * v[i].z + v[i].w * v[i].w; }
    ss = wsum(ss); float rs = rsqrtf(ss * (1.f / DM) + 1e-6f);
    float* xo = p.out + OUT_X + (size_t)r * DM;
#pragma unroll
    for (int i = 0; i < 8; ++i) {
      int c = i * 256 + lane * 4;
      *(float4*)(xo + c) = v[i];
      float4 g = *(const float4*)(gw + c), sh = *(const float4*)(mr + c), sc = *(const float4*)(mr + 2048 + c);
      s16x4 o; o[0] = (short)f2bf(v[i].x * rs * g.x * (1.f + sc.x) + sh.x); o[1] = (short)f2bf(v[i].y * rs * g.y * (1.f + sc.y) + sh.y);
      o[2] = (short)f2bf(v[i].z * rs * g.z * (1.f + sc.z) + sh.z); o[3] = (short)f2bf(v[i].w * rs * g.w * (1.f + sc.w) + sh.w);
      *(s16x4*)(H + (size_t)r * DM + c) = o;
    }
  }
}
DI void ph_row(const P& p, const float* wpost, int gate_off, const float* wpre, const float* modn, int sh_off, int sc_off, const float* modg) {
  const int tid_ = otid(), lane = tid_ & 63, wave = __builtin_amdgcn_readfirstlane(tid_ >> 6);
  u16* H = (u16*)(p.ws + O_H);
  for (int r = blockIdx.x * 8 + wave; r < T; r += gridDim.x * 8) {
    const int mrow = modrow(r);
    const float* mg = modg + (size_t)mrow * 12288 + gate_off;
    float* xr = p.out + OUT_X + (size_t)r * DM;
    u16* hr = H + (size_t)r * DM;
    float o[32]; float ss = 0.f;
#pragma unroll
    for (int i = 0; i < 4; ++i) { bf16x8 v = *(const bf16x8*)(hr + i * 512 + lane * 8);
#pragma unroll
      for (int e = 0; e < 8; ++e) { o[i * 8 + e] = bfs(v[e]); ss += o[i * 8 + e] * o[i * 8 + e]; } }
    ss = wsum(ss); float rs = rsqrtf(ss * (1.f / DM) + 1e-6f);
    float ss2 = 0.f;
#pragma unroll
    for (int i = 0; i < 4; ++i)
#pragma unroll
      for (int q = 0; q < 2; ++q) {
        int c = i * 512 + lane * 8 + q * 4;
        float4 xv = *(const float4*)(xr + c), w = *(const float4*)(wpost + c), g = *(const float4*)(mg + c);
        xv.x += g.x * o[i * 8 + q * 4 + 0] * rs * w.x; xv.y += g.y * o[i * 8 + q * 4 + 1] * rs * w.y;
        xv.z += g.z * o[i * 8 + q * 4 + 2] * rs * w.z; xv.w += g.w * o[i * 8 + q * 4 + 3] * rs * w.w;
        *(float4*)(xr + c) = xv;
        o[i * 8 + q * 4 + 0] = xv.x; o[i * 8 + q * 4 + 1] = xv.y; o[i * 8 + q * 4 + 2] = xv.z; o[i * 8 + q * 4 + 3] = xv.w;
        ss2 += xv.x * xv.x + xv.y * xv.y + xv.z * xv.z + xv.w * xv.w;
      }
    if (wpre) {
      ss2 = wsum(ss2); float rs2 = rsqrtf(ss2 * (1.f / DM) + 1e-6f);
      const float* mn = modn + (size_t)mrow * 12288;
#pragma unroll
      for (int i = 0; i < 4; ++i) {
        bf16x8 v;
#pragma unroll
        for (int q = 0; q < 2; ++q) {
          int c = i * 512 + lane * 8 + q * 4;
          float4 w = *(const float4*)(wpre + c), sh = *(const float4*)(mn + sh_off + c), sc = *(const float4*)(mn + sc_off + c);
          v[q * 4 + 0] = (short)f2bf(o[i * 8 + q * 4 + 0] * rs2 * w.x * (1.f + sc.x) + sh.x);
          v[q * 4 + 1] = (short)f2bf(o[i * 8 + q * 4 + 1] * rs2 * w.y * (1.f + sc.y) + sh.y);
          v[q * 4 + 2] = (short)f2bf(o[i * 8 + q * 4 + 2] * rs2 * w.z * (1.f + sc.z) + sh.z);
          v[q * 4 + 3] = (short)f2bf(o[i * 8 + q * 4 + 3] * rs2 * w.w * (1.f + sc.w) + sh.w);
        }
        *(bf16x8*)(hr + i * 512 + lane * 8) = v;
      }
    }
  }
}

DI void prep_item(const P& p, int l, int it) {
  const int tid = otid(), tq = tid >> 7, v = tid & 127, t = it * 4 + tq, ch0 = v * 8;
  const u16* proj = (const u16*)(p.ws + O_PROJ);
  int i, L; if (t < TC) { i = t & 255; L = 256; } else { i = (t - TC) & 4095; L = 4096; }
  const u16* px = proj + (size_t)t * NP + C_X + ch0;
  bf16x8 x1 = *(const bf16x8*)px, x0, x2;
  if (i > 0) x0 = *(const bf16x8*)(px - NP); else x0 = (bf16x8){0, 0, 0, 0, 0, 0, 0, 0};
  if (i < L - 1) x2 = *(const bf16x8*)(px + NP); else x2 = (bf16x8){0, 0, 0, 0, 0, 0, 0, 0};
  const float* cw = pin(p, I_CONVW) + (size_t)l * 3 * 1024 + ch0;
  const float* cb = pin(p, I_CONVB) + (size_t)l * 1024 + ch0;
  bf16x8 o;
#pragma unroll
  for (int e = 0; e < 8; ++e) { float y = cb[e] + cw[e] * bfs(x0[e]) + cw[1024 + e] * bfs(x1[e]) + cw[2048 + e] * bfs(x2[e]); o[e] = (short)f2bf(siluf(y)); }
  *(bf16x8*)((u16*)(p.ws + O_XC) + (size_t)t * 1024 + ch0) = o;
  if (v < 24) { float x = ((const float*)(p.ws + O_DT))[(size_t)t * 32 + v] + pin(p, I_DTB)[l * 24 + v];
    ((float*)(p.ws + O_DTV))[(size_t)t * 32 + v] = x > 15.f ? x : __logf(1.f + __expf(x)); }
}
DI void rope_item(const P& p, int it) {
  int idx = it * 512 + otid(), j = idx & 31, tl = idx >> 5, t = TC + tl, i = tl & 4095;
  float pos = (j < 16) ? (float)(i >> 6) : (float)(i & 63);
  float inv = __expf(-(float)(j & 15) * (9.210340371976184f / 16.f));
  float sn, cs; sincos_acc(pos * inv, sn, cs);
  u16* row = (u16*)(p.ws + O_PROJ) + (size_t)t * NP;
#pragma unroll 4
  for (int hh = 0; hh < 16; ++hh) {
    int base = (hh < 12 ? C_Q + hh * 64 : C_K + (hh - 12) * 64) + j;
    float x1 = bf2f(row[base]), x2 = bf2f(row[base + 32]);
    row[base] = f2bf(x1 * cs - x2 * sn); row[base + 32] = f2bf(x2 * cs + x1 * sn);
  }
}
DI void vt_item(const P& p, int it, LAS char* shm) {
  LAS u16* tile = (LAS u16*)shm;
  const int tid = otid(), t0 = (it >> 2) * 64, c0 = (it & 3) * 64;
  const u16* proj = (const u16*)(p.ws + O_PROJ);
  { int cc = tid & 63, tr = tid >> 6;
#pragma unroll
    for (int i = 0; i < 8; ++i) tile[(tr + 8 * i) * 66 + cc] = proj[(size_t)(t0 + tr + 8 * i) * NP + C_V + c0 + cc]; }
  __syncthreads();
  { int tt = tid & 63, cr = tid >> 6; u16* vt = (u16*)(p.ws + O_VT);
#pragma unroll
    for (int i = 0; i < 8; ++i) vt[(size_t)(c0 + cr + 8 * i) * T + t0 + tt] = tile[tt * 66 + cr + 8 * i]; }
  __syncthreads();
}
DI void s5p1_item(const P& p, int l, int it) {
  const int tid_ = otid(), lane = tid_ & 63, wave = __builtin_amdgcn_readfirstlane(tid_ >> 6);
  const int gc = it >> 3, g = (it & 7) * 4 + (wave >> 1), dir = wave & 1, t0 = gc * 128;
  const float* tab = (const float*)(p.ws + O_S5T) + (size_t)l * S5T_L;
  const int e = (dir * 32 + g) * 64 + lane;
  const float lr = tab[e * 2], li = tab[e * 2 + 1];
  float bb[32];
#pragma unroll
  for (int q = 0; q < 8; ++q) { float4 v = *(const float4*)(tab + 16384 + e * 32 + q * 4); bb[q * 4] = v.x; bb[q * 4 + 1] = v.y; bb[q * 4 + 2] = v.z; bb[q * 4 + 3] = v.w; }
  const u16* up = (const u16*)(p.ws + O_PROJ) + C_U + g * 16;
  float hr = 0.f, hi = 0.f;
  int tt = dir ? 127 : 0;
  bf16x8 ua = *(const bf16x8*)(up + (size_t)(t0 + tt) * NP), ub = *(const bf16x8*)(up + (size_t)(t0 + tt) * NP + 8);
  for (int s = 0; s < 128; ++s) {
    bf16x8 ca = ua, cb = ub;
    if (s < 127) { int tn = dir ? 126 - s : s + 1; ua = *(const bf16x8*)(up + (size_t)(t0 + tn) * NP); ub = *(const bf16x8*)(up + (size_t)(t0 + tn) * NP + 8); }
    float br = 0.f, bi = 0.f;
#pragma unroll
    for (int c = 0; c < 8; ++c) { float u = bfs(ca[c]); br += u * bb[c * 2]; bi += u * bb[c * 2 + 1]; }
#pragma unroll
    for (int c = 0; c < 8; ++c) { float u = bfs(cb[c]); br += u * bb[16 + c * 2]; bi += u * bb[16 + c * 2 + 1]; }
    float nr = hr * lr - hi * li + br, ni = hr * li + hi * lr + bi; hr = nr; hi = ni;
  }
  float* s5s = (float*)(p.ws + O_S5S) + ((size_t)(gc * 32 + g) * 2 + dir) * 128 + lane * 2;
  s5s[0] = hr; s5s[1] = hi;
}
DI void s5comb_item(const P& p, int l, int it) {
  int idx = it * 512 + otid(), pp = idx & 63, dir = (idx >> 6) & 1, g = (idx >> 7) & 31, seq = idx >> 12;
  const float* tab = (const float*)(p.ws + O_S5T) + (size_t)l * S5T_L;
  int e = (dir * 32 + g) * 64 + pp;
  float qr = tab[8192 + e * 2], qi = tab[8192 + e * 2 + 1];
  float hr = 0.f, hi = 0.f; int nc = 2;
  if (seq >= 32) { int b = seq - 32; nc = 32; size_t o = (size_t)((b * 2 + l) * 2 + dir) * 2048 + g * 64 + pp; hr = pin(p, I_S5R)[o]; hi = pin(p, I_S5I)[o]; }
  float* s5s = (float*)(p.ws + O_S5S);
  for (int k = 0; k < nc; ++k) {
    int c = dir ? nc - 1 - k : k, gc = chunk_of(seq, c);
    float* q = s5s + ((size_t)(gc * 32 + g) * 2 + dir) * 128 + pp * 2;
    float tr = q[0], ti = q[1]; q[0] = hr; q[1] = hi;
    float nr = hr * qr - hi * qi + tr, ni = hr * qi + hi * qr + ti; hr = nr; hi = ni;
  }
  if (seq < 32) { size_t o = (size_t)((seq * 2 + l) * 2 + dir) * 2048 + g * 64 + pp; p.out[OUT_S5R + o] = hr; p.out[OUT_S5I + o] = hi; }
}
DI void s5p2_item(const P& p, int l, int it, LAS char* shm) {
  const int tid_ = otid(), lane = tid_ & 63, wave = __builtin_amdgcn_readfirstlane(tid_ >> 6);
  const int gc = it >> 2, g = (it & 3) * 8 + wave, t0 = gc * 128;
  LAS float* hsb = (LAS float*)(shm + wave * 17408);
  LAS float* ybuf = (LAS float*)(shm + wave * 17408 + 8448);
  const float* tab = (const float*)(p.ws + O_S5T) + (size_t)l * S5T_L;
  const u16* up = (const u16*)(p.ws + O_PROJ) + C_U + g * 16;
  const int c = lane & 15, sq = lane >> 4;
  const float Dv = pin(p, I_S5D)[l * 512 + g * 16 + c];
  for (int dd = 0; dd < 2; ++dd) {
    const int dir = 1 - dd;
    const int e = (dir * 32 + g) * 64 + lane;
    const float lr = tab[e * 2], li = tab[e * 2 + 1];
    float bb[32];
#pragma unroll
    for (int q = 0; q < 8; ++q) { float4 v = *(const float4*)(tab + 16384 + e * 32 + q * 4); bb[q * 4] = v.x; bb[q * 4 + 1] = v.y; bb[q * 4 + 2] = v.z; bb[q * 4 + 3] = v.w; }
    const float* s5s = (const float*)(p.ws + O_S5S) + ((size_t)(gc * 32 + g) * 2 + dir) * 128 + lane * 2;
    float hr = s5s[0], hi = s5s[1];
    const float* cre = pin(p, I_CRE) + ((size_t)((l * 2 + dir) * 32 + g) * 16 + c) * 64;
    const float* cim = pin(p, I_CIM) + ((size_t)((l * 2 + dir) * 32 + g) * 16 + c) * 64;
    int tt = dir ? 127 : 0;
    bf16x8 ua = *(const bf16x8*)(up + (size_t)(t0 + tt) * NP), ub = *(const bf16x8*)(up + (size_t)(t0 + tt) * NP + 8);
    for (int sb = 0; sb < 8; ++sb) {
      for (int s16 = 0; s16 < 16; ++s16) {
        int s = sb * 16 + s16;
        bf16x8 ca = ua, cb = ub;
        if (s < 127) { int tn = dir ? 126 - s : s + 1; ua = *(const bf16x8*)(up + (size_t)(t0 + tn) * NP); ub = *(const bf16x8*)(up + (size_t)(t0 + tn) * NP + 8); }
        float br = 0.f, bi = 0.f;
#pragma unroll
        for (int k = 0; k < 8; ++k) { float u = bfs(ca[k]); br += u * bb[k * 2]; bi += u * bb[k * 2 + 1]; }
#pragma unroll
        for (int k = 0; k < 8; ++k) { float u = bfs(cb[k]); br += u * bb[16 + k * 2]; bi += u * bb[16 + k * 2 + 1]; }
        float nr = hr * lr - hi * li + br, ni = hr * li + hi * lr + bi; hr = nr; hi = ni;
        hsb[s16 * 132 + lane] = hr; hsb[s16 * 132 + 64 + lane] = hi;
      }
      asm volatile("s_waitcnt lgkmcnt(0)" ::: "memory");
      float acc[4] = {0.f, 0.f, 0.f, 0.f};
#pragma unroll 4
      for (int p4 = 0; p4 < 16; ++p4) {
        float4 cr4 = *(const float4*)(cre + p4 * 4), ci4 = *(const float4*)(cim + p4 * 4);
#pragma unroll
        for (int i = 0; i < 4; ++i) {
          f32x4 h4 = *(const LAS f32x4*)(hsb + (sq * 4 + i) * 132 + p4 * 4), g4 = *(const LAS f32x4*)(hsb + (sq * 4 + i) * 132 + 64 + p4 * 4);
          acc[i] += h4[0] * cr4.x + h4[1] * cr4.y + h4[2] * cr4.z + h4[3] * cr4.w - g4[0] * ci4.x - g4[1] * ci4.y - g4[2] * ci4.z - g4[3] * ci4.w;
        }
      }
#pragma unroll
      for (int i = 0; i < 4; ++i) {
        int s = sb * 16 + sq * 4 + i, t2 = dir ? 127 - s : s;
        if (dd == 0) ybuf[t2 * 16 + c] = acc[i];
        else {
          float u = bf2f(up[(size_t)(t0 + t2) * NP + c]);
          float y = ybuf[t2 * 16 + c] + acc[i] + Dv * u;
          float gl = y / (1.f + __expf(-1.5957691216057308f * (y + 0.044715f * y * y * y)));
          ((u16*)(p.ws + O_G5))[(size_t)(t0 + t2) * 512 + g * 16 + c] = f2bf(gl);
        }
      }
      asm volatile("s_waitcnt lgkmcnt(0)" ::: "memory");
    }
  }
}
template <bool SECOND>
DI void ssd_item(const P& p, int l, int it, LAS char* shm) {
  const int tid = otid(), lane = tid & 63, wave = __builtin_amdgcn_readfirstlane(tid >> 6);
  const int gc = it / 3, rr = it - gc * 3, t0 = gc * 128;
  LAS float* bc = (LAS float*)shm;
  const u16* xc = (const u16*)(p.ws + O_XC);
  __syncthreads();
#pragma unroll
  for (int i = 0; i < 8; ++i) { int v = tid + 512 * i, tt = v >> 5, c8 = (v & 31) * 8;
    bf16x8 x = *(const bf16x8*)(xc + (size_t)(t0 + tt) * 1024 + 768 + c8);
    f32x4 a = {bfs(x[0]), bfs(x[1]), bfs(x[2]), bfs(x[3])}, b = {bfs(x[4]), bfs(x[5]), bfs(x[6]), bfs(x[7])};
    *(LAS f32x4*)(bc + tt * 256 + c8) = a; *(LAS f32x4*)(bc + tt * 256 + c8 + 4) = b; }
  __syncthreads();
  const int task = rr * 8 + wave, dir = task / 12, head = task - dir * 12, g = head / 6;
  const float a = -__expf(pin(p, I_ALOG)[(l * 2 + dir) * 12 + head]);
  float* sst = (float*)(p.ws + O_SST) + ((size_t)(gc * 2 + dir) * 12 + head) * 4096 + lane * 64;
  float h[64];
  if (SECOND) {
#pragma unroll
    for (int q = 0; q < 16; ++q) { float4 v = *(const float4*)(sst + q * 4); h[q * 4] = v.x; h[q * 4 + 1] = v.y; h[q * 4 + 2] = v.z; h[q * 4 + 3] = v.w; }
  } else {
#pragma unroll
    for (int n = 0; n < 64; ++n) h[n] = 0.f;
  }
  const float* dtv = (const float*)(p.ws + O_DTV) + dir * 12 + head;
  const u16* xp = xc + head * 64 + lane;
  u16* yo = (u16*)(p.ws + (dir ? O_YB : O_YF)) + head * 64 + lane;
  int tt = dir ? 127 : 0;
  float dn = dtv[(size_t)(t0 + tt) * 32]; u16 xn = xp[(size_t)(t0 + tt) * 1024];
  float sumdt = 0.f;
  for (int s = 0; s < 128; ++s) {
    const int tc = dir ? 127 - s : s;
    const float dtc = dn, xv = bf2f(xn);
    if (s < 127) { int tn = dir ? 126 - s : s + 1; dn = dtv[(size_t)(t0 + tn) * 32]; xn = xp[(size_t)(t0 + tn) * 1024]; }
    const float dA = __expf(dtc * a), xd = xv * dtc;
    sumdt += dtc;
    const LAS f32x4* B4 = (const LAS f32x4*)(bc + tc * 256 + g * 64);
#pragma unroll
    for (int q = 0; q < 16; ++q) { f32x4 b = B4[q];
      h[q * 4] = h[q * 4] * dA + xd * b[0]; h[q * 4 + 1] = h[q * 4 + 1] * dA + xd * b[1]; h[q * 4 + 2] = h[q * 4 + 2] * dA + xd * b[2]; h[q * 4 + 3] = h[q * 4 + 3] * dA + xd * b[3];
      if ((q & 3) == 3) __builtin_amdgcn_sched_barrier(0); }
    if (SECOND) {
      const LAS f32x4* C4 = (const LAS f32x4*)(bc + tc * 256 + 128 + g * 64);
      float y0 = 0.f, y1 = 0.f, y2 = 0.f, y3 = 0.f;
#pragma unroll
      for (int q = 0; q < 16; ++q) { f32x4 cv = C4[q]; y0 += h[q * 4] * cv[0]; y1 += h[q * 4 + 1] * cv[1]; y2 += h[q * 4 + 2] * cv[2]; y3 += h[q * 4 + 3] * cv[3];
        if ((q & 3) == 3) __builtin_amdgcn_sched_barrier(0); }
      yo[(size_t)(t0 + tc) * 768] = f2bf((y0 + y1) + (y2 + y3));
    }
  }
  if (!SECOND) {
#pragma unroll
    for (int q = 0; q < 16; ++q) { float4 v = {h[q * 4], h[q * 4 + 1], h[q * 4 + 2], h[q * 4 + 3]}; *(float4*)(sst + q * 4) = v; }
    if (lane == 0) ((float*)(p.ws + O_CDEC))[(gc * 2 + dir) * 12 + head] = __expf(a * sumdt);
  }
}
DI void ssdcomb_item(const P& p, int l, int it) {
  int idx = it * 512 + otid();
  int pn = idx & 4095, hd = (idx >> 12) % 24, seq = idx / (24 * 4096), dir = hd / 12, head = hd - dir * 12;
  float hs = 0.f; int nc = 2;
  if (seq >= 32) { nc = 32; hs = pin(p, I_SSD)[((size_t)(((seq - 32) * 2 + l) * 2 + dir) * 12 + head) * 4096 + pn]; }
  float* sst = (float*)(p.ws + O_SST); const float* cdec = (const float*)(p.ws + O_CDEC);
  for (int k = 0; k < nc; ++k) {
    int c = dir ? nc - 1 - k : k, gc = chunk_of(seq, c);
    size_t o = ((size_t)(gc * 2 + dir) * 12 + head);
    float tmp = sst[o * 4096 + pn]; sst[o * 4096 + pn] = hs; hs = hs * cdec[o] + tmp;
  }
  if (seq < 32) p.out[OUT_SSD + ((size_t)((seq * 2 + l) * 2 + dir) * 12 + head) * 4096 + pn] = hs;
}
DI void ph_ssdfinal(const P& p, int l) {
  const int tid_ = otid(), lane = tid_ & 63, wave = __builtin_amdgcn_readfirstlane(tid_ >> 6);
  const u16* proj = (const u16*)(p.ws + O_PROJ); const u16* xc = (const u16*)(p.ws + O_XC);
  const u16* yf = (const u16*)(p.ws + O_YF); const u16* yb = (const u16*)(p.ws + O_YB);
  u16* mix = (u16*)(p.ws + O_MIX);
  for (int r = blockIdx.x * 8 + wave; r < T; r += gridDim.x * 8) {
    float y[12]; float ss = 0.f;
#pragma unroll
    for (int i = 0; i < 3; ++i) {
      int c = i * 256 + lane * 4;
      s16x4 a = *(const s16x4*)(yf + (size_t)r * 768 + c), b = *(const s16x4*)(yb + (size_t)r * 768 + c);
      s16x4 x = *(const s16x4*)(xc + (size_t)r * 1024 + c), z = *(const s16x4*)(proj + (size_t)r * NP + C_Z + c);
      float Dh = pin(p, I_SSDD)[l * 12 + (c >> 6)];
#pragma unroll
      for (int e = 0; e < 4; ++e) { float v = bfs(a[e]) + bfs(b[e]) + Dh * bfs(x[e]); v *= siluf(bfs(z[e])); y[i * 4 + e] = v; ss += v * v; }
    }
    ss = wsum(ss); float rs = rsqrtf(ss * (1.f / 768.f) + 1e-6f);
#pragma unroll
    for (int i = 0; i < 3; ++i) {
      int c = i * 256 + lane * 4;
      float4 w = *(const float4*)(pin(p, I_SSDN) + l * 768 + c);
      s16x4 o; o[0] = (short)f2bf(y[i * 4] * rs * w.x); o[1] = (short)f2bf(y[i * 4 + 1] * rs * w.y); o[2] = (short)f2bf(y[i * 4 + 2] * rs * w.z); o[3] = (short)f2bf(y[i * 4 + 3] * rs * w.w);
      *(s16x4*)(mix + (size_t)r * DM + c) = o;
    }
  }
}
DI int crow(int i, int h) { return (i & 3) + 8 * (i >> 2) + 4 * h; }
struct AttState { float m, lsum; f32x16 o0, o1; };
template <bool MASK>
DI void attn_tile(AttState& st, const bf16x8 (&qf)[4], const u16* kp, int kstride, const u16* vp, int vstride, int r, int h, int qi, int k0) {
  f32x16 s;
#pragma unroll
  for (int i = 0; i < 16; ++i) s[i] = 0.f;
#pragma unroll
  for (int ks = 0; ks < 4; ++ks) {
    bf16x8 kf = *(const bf16x8*)(kp + (size_t)r * kstride + ks * 16 + 8 * h);
    s = __builtin_amdgcn_mfma_f32_32x32x16_bf16(kf, qf[ks], s, 0, 0, 0);
  }
  float mt = -1e30f;
#pragma unroll
  for (int i = 0; i < 16; ++i) {
    float v = s[i] * 0.125f;
    if (MASK) { int d = qi - (k0 + crow(i, h)); if (d > 128 || d < -128) v = -1e30f; }
    s[i] = v; mt = fmaxf(mt, v);
  }
  mt = fmaxf(mt, __shfl_xor(mt, 32));
  float mn = fmaxf(st.m, mt), alpha = __expf(st.m - mn);
  st.m = mn;
  float ps = 0.f;
#pragma unroll
  for (int i = 0; i < 16; ++i) { float e = __expf(s[i] - mn); s[i] = e; ps += e; }
  st.lsum = st.lsum * alpha + ps;
#pragma unroll
  for (int i = 0; i < 16; ++i) { st.o0[i] *= alpha; st.o1[i] *= alpha; }
#pragma unroll
  for (int sp = 0; sp < 2; ++sp) {
    bf16x8 pf;
#pragma unroll
    for (int j = 0; j < 8; ++j) pf[j] = (short)f2bf(s[8 * sp + j]);
    const u16* v0 = vp + (size_t)r * vstride + 16 * sp + 4 * h;
    const u16* v1 = vp + (size_t)(32 + r) * vstride + 16 * sp + 4 * h;
    s16x4 a0 = *(const s16x4*)v0, a1 = *(const s16x4*)(v0 + 8), b0 = *(const s16x4*)v1, b1 = *(const s16x4*)(v1 + 8);
    bf16x8 va = __builtin_shufflevector(a0, a1, 0, 1, 2, 3, 4, 5, 6, 7), vb = __builtin_shufflevector(b0, b1, 0, 1, 2, 3, 4, 5, 6, 7);
    st.o0 = __builtin_amdgcn_mfma_f32_32x32x16_bf16(va, pf, st.o0, 0, 0, 0);
    st.o1 = __builtin_amdgcn_mfma_f32_32x32x16_bf16(vb, pf, st.o1, 0, 0, 0);
  }
}
DI void attn_item(const P& p, int l, int item) {
  const int tid_ = otid(), lane = tid_ & 63, wave = __builtin_amdgcn_readfirstlane(tid_ >> 6), r = lane & 31, h = lane >> 5;
  int seq, head, q0, b = 0; bool lat;
  if (item < 768) { lat = true; b = item / 192; head = (item >> 4) % 12; q0 = (item & 15) * 256 + wave * 32; seq = 32 + b; }
  else { int it2 = item - 768; lat = false; seq = it2 / 12; head = it2 % 12; q0 = wave * 32; }
  const int kvh = head / 3;
  const int seqstart = seq < 32 ? seq * 256 : TC + (seq - 32) * 4096;
  const u16* proj = (const u16*)(p.ws + O_PROJ);
  bf16x8 qf[4];
  { const u16* qrow = proj + (size_t)(seqstart + q0 + r) * NP + C_Q + head * 64;
#pragma unroll
    for (int ks = 0; ks < 4; ++ks) qf[ks] = *(const bf16x8*)(qrow + ks * 16 + 8 * h); }
  AttState st; st.m = pin(p, I_SINK)[l * 12 + head]; st.lsum = h == 0 ? 1.f : 0.f;
#pragma unroll
  for (int i = 0; i < 16; ++i) { st.o0[i] = 0.f; st.o1[i] = 0.f; }
  const u16* kself = proj + (size_t)seqstart * NP + C_K + kvh * 64;
  const u16* vself = (const u16*)(p.ws + O_VT) + (size_t)(kvh * 64) * T + seqstart;
  if (lat) {
    const u16* kc = (const u16*)(p.ws + O_KC) + (size_t)((l * 4 + b) * 4 + kvh) * 512 * 64;
    const u16* vc = (const u16*)(p.ws + O_VCT) + (size_t)((l * 4 + b) * 4 + kvh) * 64 * 512;
    for (int kt = 0; kt < 16; ++kt) attn_tile<false>(st, qf, kc + kt * 32 * 64, 64, vc + kt * 32, 512, r, h, 0, 0);
    int klo = max(0, q0 - 128), khi = min(4096, q0 + 160);
    for (int k0 = klo; k0 < khi; k0 += 32) attn_tile<true>(st, qf, kself + (size_t)k0 * NP, NP, vself + k0, T, r, h, q0 + r, k0);
  } else {
    for (int k0 = 0; k0 < 256; k0 += 32) attn_tile<false>(st, qf, kself + (size_t)k0 * NP, NP, vself + k0, T, r, h, 0, 0);
  }
  float lt = st.lsum + __shfl_xor(st.lsum, 32), inv = 1.f / lt;
  u16* orow = (u16*)(p.ws + O_MIX) + (size_t)(seqstart + q0 + r) * DM + 768 + head * 64;
#pragma unroll
  for (int gq = 0; gq < 4; ++gq) {
    s16x4 a, bq;
#pragma unroll
    for (int e = 0; e < 4; ++e) { a[e] = (short)f2bf(st.o0[gq * 4 + e] * inv); bq[e] = (short)f2bf(st.o1[gq * 4 + e] * inv); }
    *(s16x4*)(orow + 8 * gq + 4 * h) = a; *(s16x4*)(orow + 32 + 8 * gq + 4 * h) = bq;
  }
}

__global__ void __launch_bounds__(512) mega(P p0) {
  extern __shared__ __attribute__((aligned(16))) char dyn_smem[];
  LAS char* shm = (LAS char*)dyn_smem;
  cg::grid_group grid = cg::this_grid();
  const int G = gridDim.x, bid = blockIdx.x;
  for (int ph = p0.lo; ph < p0.hi; ++ph) {
    P p; p.inp = p0.in; p.out = p0.out; p.ws = p0.ws; p.lo = p0.lo; p.hi = p0.hi;
    asm volatile("" : "+s"(p.out), "+s"(p.ws));
    const float* mod = (const float*)(p.ws + O_MOD);
    if (ph == 0) { if (PHON(11)) ph_init(p, shm); }
    else if (ph == 1) { if (PHON(12)) ph_prenorm(p); }
    else {
      const int l = (ph - 2) / 11, s = (ph - 2) % 11;
      const float* modl = mod + (size_t)l * 5 * 12288;
      if (PHON(s)) switch (s) {
        case 0: { EpiProj e{(u16*)(p.ws + O_PROJ), (float*)(p.ws + O_DT), p.out, l};
          gemm_phase((const u16*)(p.ws + O_H), (const u16*)(p.ws + O_WIN) + (size_t)l * NP * DM, T, NP, DM, e, shm, 0); } break;
        case 1: {
          constexpr int N0 = 1536, N1 = N0 + 6144, N2 = N1 + 1024, N3 = N2 + 1536;
          for (int it = bid; it < N3; it += G) {
            if (it < N0) s5p1_item(p, l, it); else if (it < N1) prep_item(p, l, it - N0); else if (it < N2) rope_item(p, it - N1); else vt_item(p, it - N2, shm);
          } } break;
        case 2: {
          constexpr int N0 = 576, N1 = N0 + 768 + 384, N2 = N1 + 288;
          for (int it = bid; it < N2; it += G) {
            if (it < N0) ssd_item<false>(p, l, it, shm); else if (it < N1) attn_item(p, l, it - N0); else s5comb_item(p, l, it - N1);
          } } break;
        case 3: {
          constexpr int N0 = 768, N1 = N0 + 6912;
          for (int it = bid; it < N1; it += G) { if (it < N0) s5p2_item(p, l, it, shm); else ssdcomb_item(p, l, it - N0); }
          } break;
        case 4: {
          for (int it = bid; it < 576; it += G) ssd_item<true>(p, l, it, shm);
          __syncthreads();
          EpiGlu e{(const u16*)(p.ws + O_G5), pin(p, I_BGLU) + l * 512, (u16*)(p.ws + O_MIX)};
          gemm_phase((const u16*)(p.ws + O_G5), (const u16*)(p.ws + O_WGLU) + (size_t)l * 512 * 512, T, 512, 512, e, shm, 64);
          } break;
        case 5: ph_ssdfinal(p, l); break;
        case 6: { EpiBf16 e{(u16*)(p.ws + O_H)};
          gemm_phase((const u16*)(p.ws + O_MIX), (const u16*)(p.ws + O_WOUT) + (size_t)l * DM * DM, T, DM, DM, e, shm, 0); } break;
        case 7: ph_row(p, pin(p, I_NMPOST) + l * DM, 4096, pin(p, I_NFPRE) + l * DM, modl, 6144, 8192, modl); break;
        case 8: { EpiSwiglu e{(u16*)(p.ws + O_ACT)};
          gemm_phase((const u16*)(p.ws + O_H), (const u16*)(p.ws + O_WFFI) + (size_t)l * 2 * DFF * DM, T, 2 * DFF, DM, e, shm, 0); } break;
        case 9: { EpiBf16 e{(u16*)(p.ws + O_H)};
          gemm_phase((const u16*)(p.ws + O_ACT), (const u16*)(p.ws + O_WFFO) + (size_t)l * DM * DFF, T, DM, DFF, e, shm, 0); } break;
        case 10: {
          const bool last = (l == 1);
          ph_row(p, pin(p, I_NFPOST) + l * DM, 10240, last ? nullptr : pin(p, I_NMPRE) + (l + 1) * DM, last ? modl : modl + 5 * 12288, 0, 2048, modl);
          } break;
      }
    }
    if (ph + 1 < p0.hi) grid.sync();
  }
}

extern "C" void kernel_launch(void* const* d_in, const int* in_sizes, int n_in, void* d_out, int out_size, void* d_ws, size_t ws_size, hipStream_t stream) {
  static int grid_blocks = 0;
  if (!grid_blocks) {
    if (n_in != N_IN || ws_size < O_END) { fprintf(stderr, "kernel_launch: bad n_in %d or ws %zu < %zu\n", n_in, ws_size, (size_t)O_END); grid_blocks = -1; return; }
    int dev = 0, cus = 0, per_cu = 0;
    hipGetDevice(&dev);
    hipDeviceGetAttribute(&cus, hipDeviceAttributeMultiprocessorCount, dev);
    hipFuncSetAttribute((const void*)mega, hipFuncAttributeMaxDynamicSharedMemorySize, DYN_LDS);
    hipOccupancyMaxActiveBlocksPerMultiprocessor(&per_cu, (const void*)mega, 512, DYN_LDS);
    if (per_cu < 1) per_cu = 1;
    grid_blocks = cus * per_cu;
    if (grid_blocks % 8) grid_blocks -= grid_blocks % 8;
  }
  if (grid_blocks < 0) return;
  hipMemsetAsync((char*)d_ws + O_MOD, 0, 491520, stream);
  P p{};
  for (int i = 0; i < N_IN; ++i) p.in[i] = (const float*)d_in[i];
  p.out = (float*)d_out; p.ws = (char*)d_ws;
#if MULTI_LAUNCH
  for (int ph = 0; ph < NPH_RUN; ++ph) {
    p.lo = ph; p.hi = ph + 1;
    hipLaunchKernelGGL(mega, dim3(grid_blocks), dim3(512), DYN_LDS, stream, p);
  }
#else
  p.lo = 0; p.hi = NPH;
  void* args[] = {&p};
  hipError_t e = hipLaunchCooperativeKernel((const void*)mega, dim3(grid_blocks), dim3(512), args, DYN_LDS, stream);
  if (e != hipSuccess) fprintf(stderr, "cooperative launch failed: %s (grid %d)\n", hipGetErrorString(e), grid_blocks);
#endif
}
```

```cpp
#include <hip/hip_runtime.h>
#include <hip/hip_bf16.h>
#include <hip/hip_cooperative_groups.h>
#include <cstdio>
namespace cg = cooperative_groups;

#ifndef PHMASK
#define PHMASK 0xFFFFu
#endif
#define PHON(b) ((PHMASK >> (b)) & 1u)
#ifndef DUPMASK
#define DUPMASK 0u
#endif
#define NREP(b) (1 + (int)((DUPMASK >> (b)) & 1u))
#ifndef MULTI_LAUNCH
#define MULTI_LAUNCH 0
#endif

typedef unsigned short u16;
using bf16x8 = __attribute__((ext_vector_type(8))) short;
using s16x4 = __attribute__((ext_vector_type(4))) short;
using f32x4 = __attribute__((ext_vector_type(4))) float;
using f32x16 = __attribute__((ext_vector_type(16))) float;
#define DI __device__ __forceinline__
#define LAS __attribute__((address_space(3)))

constexpr int T = 24576, TC = 8192, DM = 2048, NP = 3840, DFF = 5632, DIN = 3608;
constexpr int C_Z = 0, C_X = 768, C_B = 1536, C_C = 1664, C_Q = 1792, C_K = 2560, C_V = 2816, C_U = 3072, C_DT = 3584;
constexpr int NPH = 24;
#ifndef NPH_RUN
#define NPH_RUN NPH
#endif
constexpr int DYN_LDS = 139264 + 16;

constexpr size_t OUT_X = 0, OUT_CK = 50331648, OUT_CV = 54525952, OUT_SSD = 58720256, OUT_S5R = 65011712, OUT_S5I = 65273856;

constexpr size_t O_WIN = 0;
constexpr size_t O_WOUT = O_WIN + 31457280;
constexpr size_t O_WFFI = O_WOUT + 16777216;
constexpr size_t O_WFFO = O_WFFI + 92274688;
constexpr size_t O_WGLU = O_WFFO + 46137344;
constexpr size_t O_MOD = O_WGLU + 1048576;
constexpr size_t O_BAR = O_MOD + 491520;
constexpr size_t O_S5T = O_BAR + 16384;
constexpr size_t O_KC = O_S5T + 1179648;
constexpr size_t O_VCT = O_KC + 2097152;
constexpr size_t O_DT = O_VCT + 2097152;
constexpr size_t O_DTV = O_DT + 3145728;
constexpr size_t O_CDEC = O_DTV + 3145728;
constexpr size_t O_S5S = O_CDEC + 32768;
constexpr size_t O_SST = O_S5S + 6291456;
constexpr size_t O_G5 = O_SST + 75497472;
constexpr size_t O_VT = O_G5 + 25165824;
constexpr size_t O_PROJ = O_VT + 12582912;
constexpr size_t O_MIX = O_PROJ + 188743680;
constexpr size_t O_H = O_MIX + 100663296;
constexpr size_t O_XC = O_H;
constexpr size_t O_YF = O_XC + 50331648;
constexpr size_t O_YB = O_YF + 37748736;
constexpr size_t O_END = O_YB + 37748736;
constexpr size_t O_DTW = O_END;
constexpr size_t O_XCT = O_DTW + 2359296;
constexpr size_t O_END2 = O_XCT + 50331648;
constexpr size_t O_END3 = O_END2 + 4096;
constexpr size_t O_CUM = O_DTV;
constexpr size_t O_Y = O_YF;
constexpr size_t O_S5H = O_YB;
constexpr size_t O_ACT = O_PROJ;
constexpr int S5T_L = 147456;

enum { I_XP = 0, I_XS, I_C, I_CK, I_CV, I_SSD, I_S5R, I_S5I, I_CCTX, I_WADA, I_BADA, I_NMPRE, I_NMPOST, I_NFPRE, I_NFPOST,
       I_WIN, I_WOUT, I_CONVW, I_CONVB, I_DTB, I_ALOG, I_SSDD, I_SSDN, I_SINK, I_ARE, I_AIM, I_LOGDT, I_BRE, I_BIM, I_CRE, I_CIM,
       I_S5D, I_WGLU, I_BGLU, I_WFFI, I_WFFO, N_IN };

struct P {
  const float* in[N_IN];
  float* out;
  char* ws;
  int lo, hi;
  const float* const* inp;
};

DI const float* pin(const P& p, int i) { asm volatile("" : "+s"(i)); return p.inp[i]; }
DI int otid() { int t = threadIdx.x; asm volatile("" : "+v"(t)); return t; }
DI u16 f2bf(float x) { unsigned u = __float_as_uint(x); u += 0x7fffu + ((u >> 16) & 1u); return (u16)(u >> 16); }
DI unsigned cvt_pk_bf16(float a, float b) { unsigned r; asm("v_cvt_pk_bf16_f32 %0, %1, %2" : "=v"(r) : "v"(a), "v"(b)); return r; }
using u32x4 = __attribute__((ext_vector_type(4))) unsigned;
DI bf16x8 pack8(float a0, float a1, float a2, float a3, float a4, float a5, float a6, float a7) {
  u32x4 q;
  asm volatile("v_cvt_pk_bf16_f32 %0, %4, %5\n\tv_cvt_pk_bf16_f32 %1, %6, %7\n\tv_cvt_pk_bf16_f32 %2, %8, %9\n\tv_cvt_pk_bf16_f32 %3, %10, %11\n\ts_nop 1"
               : "=&v"(q[0]), "=&v"(q[1]), "=&v"(q[2]), "=&v"(q[3]) : "v"(a0), "v"(a1), "v"(a2), "v"(a3), "v"(a4), "v"(a5), "v"(a6), "v"(a7));
  return __builtin_bit_cast(bf16x8, q);
}
DI float bf2f(u16 h) { return __uint_as_float(((unsigned)h) << 16); }
DI float bfs(short h) { return __uint_as_float(((unsigned)(u16)h) << 16); }
DI float wsum(float v) { for (int o = 32; o > 0; o >>= 1) v += __shfl_xor(v, o); return v; }
DI float siluf(float x) { return x * __builtin_amdgcn_rcpf(1.f + __expf(-x)); }
DI void sincos_acc(float x, float& sn, float& cs) {
  float n = rintf(x * 0.63661977236758f);
  float r = fmaf(n, -1.5707962513e+0f, x);
  r = fmaf(n, -7.5497899549e-8f, r);
  float r2 = r * r;
  float sp = fmaf(r * r2, fmaf(r2, fmaf(r2, -1.9515295891e-4f, 8.3321608736e-3f), -1.6666654611e-1f), r);
  float cp = fmaf(r2, fmaf(r2, fmaf(r2, fmaf(r2, 2.443315711809948e-5f, -1.388731625493765e-3f), 4.166664568298827e-2f), -0.5f), 1.f);
  int q = ((int)n) & 3;
  sn = (q == 0) ? sp : (q == 1) ? cp : (q == 2) ? -sp : -cp;
  cs = (q == 0) ? cp : (q == 1) ? -sp : (q == 2) ? -cp : sp;
}
DI int crow(int i, int h) { return (i & 3) + 8 * (i >> 2) + 4 * h; }
DI int pi23(int m) { return (m & ~12) | ((m & 4) << 1) | ((m & 8) >> 1); }
DI int modrow(int t) { return t < TC ? 0 : 1 + ((t - TC) >> 12); }
DI void chunk_info(int gc, int& seq, int& c, int& nc) {
  if (gc < 64) { seq = gc >> 1; c = gc & 1; nc = 2; } else { seq = 32 + ((gc - 64) >> 5); c = (gc - 64) & 31; nc = 32; }
}
DI int chunk_of(int seq, int c) { return seq < 32 ? seq * 2 + c : 64 + (seq - 32) * 32 + c; }


#define XB_TMO      128
#define XB_XCNT(j)  (256  + 64 * (j))
#define XB_XSUB(j)  (1280 + 64 * (j))
#define XB_XGEN(j)  (2304 + 64 * (j))
#define XB_TOP      3328
#define XB_TOPGEN   3392
#define XCD_BAR_WORDS 3456
#define XB_SPIN_CAP (1u << 21)
DI unsigned xb_ld(unsigned* p) { return __hip_atomic_load(p, __ATOMIC_RELAXED, __HIP_MEMORY_SCOPE_AGENT); }
DI unsigned xb_add(unsigned* p, unsigned v) { return __hip_atomic_fetch_add(p, v, __ATOMIC_RELAXED, __HIP_MEMORY_SCOPE_AGENT); }
DI unsigned xb_xcc_id() { return (unsigned)__builtin_amdgcn_s_getreg((3 << 11) | 20) & 0xFu; }
#define XB_SPIN(cond, bar) do { unsigned _sp = 0; while (cond) { __builtin_amdgcn_s_sleep(1); \
    if ((++_sp & 255u) == 0u) { if (xb_ld(&(bar)[XB_TMO])) break; if (_sp > XB_SPIN_CAP) { atomicAdd(&(bar)[XB_TMO], 1u); break; } } } } while (0)
struct XcdBarrier { unsigned* bar; unsigned x; volatile LAS unsigned* st; };
DI XcdBarrier xcd_barrier_post(unsigned* bar, volatile LAS unsigned* st) {
  XcdBarrier b; b.bar = bar; b.x = xb_xcc_id(); b.st = st;
  if (threadIdx.x == 0) (void)xb_add(&bar[XB_XCNT(b.x)], 1u);
  return b;
}
DI void xcd_barrier_complete(unsigned* bar, unsigned x, unsigned& nloc, unsigned& nx) {
  const unsigned G = gridDim.x * gridDim.y * gridDim.z;
  unsigned sum, cnt, mine, sp = 0u;
  for (;;) {
    sum = 0u; cnt = 0u; mine = 0u;
#pragma unroll
    for (unsigned j = 0; j < 16; ++j) { const unsigned c = xb_ld(&bar[XB_XCNT(j)]); sum += c; cnt += (c > 0u) ? 1u : 0u; mine = (j == x) ? c : mine; }
    if (sum == G) break;
    __builtin_amdgcn_s_sleep(1);
    if ((++sp & 255u) == 0u) { if (xb_ld(&bar[XB_TMO])) break; if (sp > XB_SPIN_CAP) { atomicAdd(&bar[XB_TMO], 1u); break; } }
  }
  nloc = mine > 0u ? mine : 1u; nx = cnt > 0u ? cnt : 1u;
}
DI void xcd_barrier(const XcdBarrier& b) {
  asm volatile("s_waitcnt vmcnt(0)" ::: "memory");
  __syncthreads();
  if (threadIdx.x == 0) {
    unsigned* bar = b.bar;
    __builtin_amdgcn_s_waitcnt(0);
    unsigned nloc = b.st[0], nx = b.st[1];
    if (nloc == 0u) { xcd_barrier_complete(bar, b.x, nloc, nx); b.st[0] = nloc; b.st[1] = nx; }
    const unsigned old = xb_add(&bar[XB_XSUB(b.x)], 1u);
    const unsigned gen = old / nloc;
    if (old + 1u == (gen + 1u) * nloc) {
      __builtin_amdgcn_fence(__ATOMIC_RELEASE, "agent");
      asm volatile("s_waitcnt vmcnt(0)" ::: "memory");
      const unsigned og = xb_add(&bar[XB_TOP], 1u);
      const unsigned tg = og / nx;
      if (og + 1u == (tg + 1u) * nx) xb_add(&bar[XB_TOPGEN], 1u);
      else XB_SPIN(xb_ld(&bar[XB_TOPGEN]) == tg, bar);
      __builtin_amdgcn_fence(__ATOMIC_ACQUIRE, "agent");
      xb_add(&bar[XB_XGEN(b.x)], 1u);
      asm volatile("s_waitcnt vmcnt(0)" ::: "memory");
    } else {
      XB_SPIN(xb_ld(&bar[XB_XGEN(b.x)]) == gen, bar);
      __builtin_amdgcn_fence(__ATOMIC_ACQUIRE, "agent");
      asm volatile("s_waitcnt vmcnt(0)" ::: "memory");
    }
  }
  __syncthreads();
}

constexpr int BM = 256, BK = 64, HALF = 128, HT = HALF * BK;
DI int lds_byte(int r, int c) {
  int st = (r >> 4) * 2 + (c >> 5), rr = r & 15, cc = c & 31, ob = rr * 64 + cc * 2;
  return st * 1024 + (ob ^ (((ob >> 9) & 1) << 5));
}
DI void stage_rc(int b, int& R, int& C) {
  int st = b / 1024, sb = b % 1024, swz = sb ^ (((sb >> 9) & 1) << 5);
  R = (st >> 1) * 16 + swz / 64; C = (st & 1) * 32 + (swz % 64) / 2;
}

struct EpiProj {
  u16* proj; float* dt; float* out; int l;
  DI void apply(int row0, int col0, int fr, const f32x4& v0, const f32x4& v1) const {
#pragma unroll
    for (int n = 0; n < 2; ++n) {
      const f32x4& v = n ? v1 : v0;
      int col = col0 + n * 16;
      { unsigned a = cvt_pk_bf16(v[0], v[1]), b = cvt_pk_bf16(v[2], v[3]); u16* q = proj + (size_t)row0 * NP + col;
        q[0] = (u16)a; q[NP] = (u16)(a >> 16); q[2 * NP] = (u16)b; q[3 * NP] = (u16)(b >> 16); }
      if (col >= C_DT && col < C_DT + 24) {
#pragma unroll
        for (int j = 0; j < 4; ++j) dt[(size_t)(row0 + j) * 32 + (col - C_DT)] = v[j];
      }
      if (col >= C_K && col < C_U && row0 < TC) {
        float* o = out + (col < C_V ? OUT_CK : OUT_CV);
        int cc = (col - C_K) & 255;
#pragma unroll
        for (int j = 0; j < 4; ++j) { int r = row0 + j; o[(size_t)((r >> 8) * 512 + l * 256 + (r & 255)) * 256 + cc] = v[j]; }
      }
    }
  }
};
struct EpiBf16 {
  u16* dst;
  DI void apply(int row0, int col0, int fr, const f32x4& v0, const f32x4& v1) const {
    unsigned a = cvt_pk_bf16(v0[0], v0[1]), b = cvt_pk_bf16(v0[2], v0[3]), c = cvt_pk_bf16(v1[0], v1[1]), d = cvt_pk_bf16(v1[2], v1[3]);
    u16* q = dst + (size_t)row0 * DM + col0;
    q[0] = (u16)a; q[DM] = (u16)(a >> 16); q[2 * DM] = (u16)b; q[3 * DM] = (u16)(b >> 16);
    q[16] = (u16)c; q[DM + 16] = (u16)(c >> 16); q[2 * DM + 16] = (u16)d; q[3 * DM + 16] = (u16)(d >> 16);
  }
};
struct EpiSwiglu {
  u16* act;
  DI void apply(int row0, int col0, int fr, const f32x4& v0, const f32x4& v1) const {
    int ac = ((col0 - fr) >> 1) + fr;
    unsigned a = cvt_pk_bf16(siluf(v0[0]) * v1[0], siluf(v0[1]) * v1[1]), b = cvt_pk_bf16(siluf(v0[2]) * v1[2], siluf(v0[3]) * v1[3]);
    u16* q = act + (size_t)row0 * DFF + ac;
    q[0] = (u16)a; q[DFF] = (u16)(a >> 16); q[2 * DFF] = (u16)b; q[3 * DFF] = (u16)(b >> 16);
  }
};
struct EpiGlu {
  const u16* g5; const float* b; u16* mix;
  DI void apply(int row0, int col0, int fr, const f32x4& v0, const f32x4& v1) const {
#pragma unroll
    for (int n = 0; n < 2; ++n) {
      const f32x4& v = n ? v1 : v0;
      int col = col0 + n * 16; float bb = b[col];
#pragma unroll
      for (int j = 0; j < 4; ++j) {
        float g = bf2f(g5[(size_t)(row0 + j) * 512 + col]);
        mix[(size_t)(row0 + j) * DM + 1536 + col] = f2bf(g * __builtin_amdgcn_rcpf(1.f + __expf(-(v[j] + bb))));
      }
    }
  }
};

template <class Epi>
__device__ __forceinline__ void gemm_tile(const u16* __restrict__ A, const u16* __restrict__ Bt, int K, int brow, int bcol, const Epi& epi, LAS char* shm, bool prefetched, int nbrow, int nbcol) {
#define SA(b, h) (shm + ((b) * 2 + (h)) * (HT * 2))
#define SB(b, h) (shm + (4 + (b) * 2 + (h)) * (HT * 2))
#define STAGE(Pp, BASE, br, kt) do { const char* _gb = (const char*)(BASE) + ((long)(br) * K + (long)(kt) * BK) * 2; \
    __builtin_amdgcn_global_load_lds((const unsigned*)(_gb + voff0), (LAS unsigned*)((Pp) + ldsw), 16, 0, 0); \
    __builtin_amdgcn_global_load_lds((const unsigned*)(_gb + voff1), (LAS unsigned*)((Pp) + ldsw + 8192), 16, 0, 0); } while (0)
#define LDA(dst, b, h) _Pragma("unroll") for (int m = 0; m < 4; ++m) _Pragma("unroll") for (int k = 0; k < 2; ++k) \
    dst[m][k] = *(const LAS bf16x8*)(SA(b, h) + aoff + m * 2048 + k * 1024)
#define LDB(dst, b, h) _Pragma("unroll") for (int n = 0; n < 2; ++n) _Pragma("unroll") for (int k = 0; k < 2; ++k) \
    dst[n][k] = *(const LAS bf16x8*)(SB(b, h) + boff + n * 2048 + k * 1024)
#define MMA(ai, bj, At_, Bt_) do { __builtin_amdgcn_s_setprio(1); \
    _Pragma("unroll") for (int m = 0; m < 4; ++m) _Pragma("unroll") for (int n = 0; n < 2; ++n) _Pragma("unroll") for (int k = 0; k < 2; ++k) \
      acc[ai][bj][m][n] = __builtin_amdgcn_mfma_f32_16x16x32_bf16(At_[m][k], Bt_[n][k], acc[ai][bj][m][n], 0, 0, 0); \
    __builtin_amdgcn_s_setprio(0); } while (0)
#define WAIT_V(n) asm volatile("s_waitcnt vmcnt(" #n ")" ::: "memory")
#define WAIT_L(n) asm volatile("s_waitcnt lgkmcnt(" #n ")" ::: "memory")
#define BAR __builtin_amdgcn_s_barrier()
#define SCHED __builtin_amdgcn_sched_barrier(0)
  const int tid_ = otid(), wid = __builtin_amdgcn_readfirstlane(tid_ >> 6), lane = tid_ & 63, wr = wid >> 2, wc = wid & 3, fr = lane & 15, fq = lane >> 4;
  const int ldsw = tid_ * 16;
  unsigned voff0, voff1;
  { int r_, c_; stage_rc(ldsw, r_, c_); voff0 = (unsigned)(r_ * K + c_) * 2u; stage_rc(ldsw + 8192, r_, c_); voff1 = (unsigned)(r_ * K + c_) * 2u; }
  const int aoff = lds_byte(wr * 64 + fr, fq * 8), boff = lds_byte(wc * 32 + fr, fq * 8);
  f32x4 acc[2][2][4][2];
#pragma unroll
  for (int a = 0; a < 2; ++a)
#pragma unroll
    for (int b = 0; b < 2; ++b)
#pragma unroll
      for (int m = 0; m < 4; ++m)
#pragma unroll
        for (int n = 0; n < 2; ++n) acc[a][b][m][n] = (f32x4){0.f, 0.f, 0.f, 0.f};
  bf16x8 At[4][2], B0[2][2], B1[2][2];
  const int nt = K / BK;
  if (!prefetched) { STAGE(SB(0, 0), Bt, bcol, 0); STAGE(SA(0, 0), A, brow, 0);
    STAGE(SB(0, 1), Bt, bcol + HALF, 0); STAGE(SA(0, 1), A, brow + HALF, 0); }
  if (wr == 1) BAR;
  WAIT_V(4); BAR;
  STAGE(SB(1, 0), Bt, bcol, 1); STAGE(SA(1, 0), A, brow, 1); STAGE(SB(1, 1), Bt, bcol + HALF, 1);
  WAIT_V(6); BAR;
  for (int t = 0; t < nt - 2; t += 2) {
    LDB(B0, 0, 0); SCHED; LDA(At, 0, 0); STAGE(SA(1, 1), A, brow + HALF, t + 1);
    WAIT_L(8); BAR; WAIT_L(0); MMA(0, 0, At, B0); BAR; SCHED;
    LDB(B1, 0, 1); STAGE(SB(0, 0), Bt, bcol, t + 2);
    BAR; WAIT_L(0); MMA(0, 1, At, B1); BAR;
    LDA(At, 0, 1); STAGE(SA(0, 0), A, brow, t + 2);
    BAR; WAIT_L(0); MMA(1, 0, At, B0); BAR; SCHED;
    STAGE(SB(0, 1), Bt, bcol + HALF, t + 2);
    WAIT_V(6); BAR; MMA(1, 1, At, B1); BAR;
    LDB(B0, 1, 0); SCHED; LDA(At, 1, 0); STAGE(SA(0, 1), A, brow + HALF, t + 2);
    WAIT_L(8); BAR; WAIT_L(0); MMA(0, 0, At, B0); BAR; SCHED;
    LDB(B1, 1, 1); STAGE(SB(1, 0), Bt, bcol, t + 3);
    BAR; WAIT_L(0); MMA(0, 1, At, B1); BAR;
    LDA(At, 1, 1); STAGE(SA(1, 0), A, brow, t + 3);
    BAR; WAIT_L(0); MMA(1, 0, At, B0); BAR; SCHED;
    STAGE(SB(1, 1), Bt, bcol + HALF, t + 3);
    WAIT_V(6); BAR; MMA(1, 1, At, B1); BAR;
  }
  { LDB(B0, 0, 0); LDA(At, 0, 0); STAGE(SA(1, 1), A, brow + HALF, nt - 1);
    BAR; WAIT_L(0); MMA(0, 0, At, B0); BAR;
    LDB(B1, 0, 1); BAR; WAIT_L(0); MMA(0, 1, At, B1); BAR;
    LDA(At, 0, 1); WAIT_V(4); BAR; WAIT_L(0); MMA(1, 0, At, B0); MMA(1, 1, At, B1); BAR; }
  { LDB(B0, 1, 0); LDA(At, 1, 0); WAIT_V(2); BAR; WAIT_L(0); MMA(0, 0, At, B0); BAR;
    LDB(B1, 1, 1); WAIT_V(0); BAR; WAIT_L(0); MMA(0, 1, At, B1); BAR;
    LDA(At, 1, 1); BAR; WAIT_L(0); MMA(1, 0, At, B0); MMA(1, 1, At, B1); BAR; }
  if (wr == 0) BAR;
  if (nbrow >= 0) {
    STAGE(SB(0, 0), Bt, nbcol, 0); STAGE(SA(0, 0), A, nbrow, 0);
    STAGE(SB(0, 1), Bt, nbcol + HALF, 0); STAGE(SA(0, 1), A, nbrow + HALF, 0); }
#pragma unroll
  for (int ai = 0; ai < 2; ++ai)
#pragma unroll
    for (int bj = 0; bj < 2; ++bj)
#pragma unroll
      for (int m = 0; m < 4; ++m)
        epi.apply(brow + ai * HALF + wr * 64 + m * 16 + fq * 4, bcol + bj * HALF + wc * 32 + fr, fr, acc[ai][bj][m][0], acc[ai][bj][m][1]);
#undef SA
#undef SB
#undef STAGE
#undef LDA
#undef LDB
#undef MMA
}

template <class Epi>
__device__ __forceinline__ void gemm_phase(const u16* A, const u16* Bt, int M, int N, int K, const Epi& epi, LAS char* shm, int rot) {
  const int G = gridDim.x;
  int b = ((int)blockIdx.x + G - rot) % G;
  int vb = (G % 8 == 0) ? (b % 8) * (G / 8) + b / 8 : b;
  const int nM = M / BM, nN = N / BM, ntile = nM * nN;
  bool pre = false;
  for (int id = vb; id < ntile; id += G) {
    int nig = 8 * nN, gid = id / nig, fm = gid * 8, gsz = min(nM - fm, 8);
    int pm = fm + ((id % nig) % gsz), pn = (id % nig) / gsz;
    int nbrow = -1, nbcol = 0;
    if (id + G < ntile) { int id2 = id + G, gid2 = id2 / nig, fm2 = gid2 * 8, gsz2 = min(nM - fm2, 8); nbrow = (fm2 + ((id2 % nig) % gsz2)) * BM; nbcol = ((id2 % nig) / gsz2) * BM; }
    gemm_tile(A, Bt, K, pm * BM, pn * BM, epi, shm, pre, nbrow, nbcol);
    pre = nbrow >= 0;
    if (!pre) __syncthreads();
  }
}

DI int colmap(int kind, int n) {
  if (kind == 0) { if (n < 1792) return n; if (n < 3584) return n + 24; if (n < 3608) return n - 3584 + 1792; return -1; }
  if (kind == 2) { int jb = n >> 5, half = (n >> 4) & 1, jj = n & 15; return half * DFF + jb * 16 + jj; }
  return n;
}
DI void conv_tile(const float* __restrict__ src, int K, int N, u16* dst, int kind, int tile, LAS float* lds) {
  const int ntk = K >> 6, nt0 = tile / ntk, kt = tile - nt0 * ntk, n0 = nt0 * 256, k0 = kt * 64, tid = otid();
  { int nn = tid & 63, kr = tid >> 6; int sc[4];
#pragma unroll
    for (int q = 0; q < 4; ++q) sc[q] = colmap(kind, n0 + q * 64 + nn);
#pragma unroll
    for (int i = 0; i < 8; ++i) { int kk = kr + 8 * i;
#pragma unroll
      for (int q = 0; q < 4; ++q) lds[kk * 257 + q * 64 + nn] = sc[q] >= 0 ? src[(size_t)(k0 + kk) * N + sc[q]] : 0.f; } }
  __syncthreads();
#pragma unroll
  for (int j = 0; j < 4; ++j) { int v = tid + 512 * j, nn = v >> 3, kq = v & 7; bf16x8 o;
#pragma unroll
    for (int e = 0; e < 8; ++e) o[e] = (short)f2bf(lds[(kq * 8 + e) * 257 + nn]);
    *(bf16x8*)(dst + (size_t)(n0 + nn) * K + k0 + kq * 8) = o; }
  __syncthreads();
}

DI void ph_init(const P& p, LAS char* shm, int rep) {
  LAS float* lds = (LAS float*)shm;
  const int tid = otid();
  constexpr int N_MOD = 768, N_CV_L = 480 + 256 + 1408 + 704 + 16, N_CV = 2 * N_CV_L, N_TAB = 16, N_CACHE = 4096;
  constexpr int TOTAL = N_MOD + N_CV + N_TAB + N_CACHE;
  for (int it = blockIdx.x + (rep ? N_MOD : 0); it < TOTAL; it += gridDim.x) {
    if (it < N_MOD) {
      int l = it / 384, r = it % 384, jb = r >> 4, ks = r & 15, j = jb * 512 + tid, k0 = ks * 128;
      for (int e = tid; e < 5 * 128; e += 512) { int v = e >> 7, kk = e & 127; float c = v == 0 ? pin(p, I_CCTX)[k0 + kk] : pin(p, I_C)[(v - 1) * DM + k0 + kk]; lds[e] = siluf(c); }
      __syncthreads();
      float a0 = 0, a1 = 0, a2 = 0, a3 = 0, a4 = 0;
      const float* w = pin(p, I_WADA) + ((size_t)l * DM + k0) * 12288 + j;
#pragma unroll 16
      for (int kk = 0; kk < 128; ++kk) { float wv = w[(size_t)kk * 12288]; a0 += lds[kk] * wv; a1 += lds[128 + kk] * wv; a2 += lds[256 + kk] * wv; a3 += lds[384 + kk] * wv; a4 += lds[512 + kk] * wv; }
      float bias = ks == 0 ? pin(p, I_BADA)[l * 12288 + j] : 0.f;
      float* mod = (float*)(p.ws + O_MOD) + (size_t)l * 5 * 12288 + j;
      atomicAdd(mod, a0 + bias); atomicAdd(mod + 12288, a1 + bias); atomicAdd(mod + 2 * 12288, a2 + bias); atomicAdd(mod + 3 * 12288, a3 + bias); atomicAdd(mod + 4 * 12288, a4 + bias);
      __syncthreads();
    } else if (it < N_MOD + N_CV) {
      int r = it - N_MOD, l = r / N_CV_L; r -= l * N_CV_L;
      if (r < 480) conv_tile(pin(p, I_WIN) + (size_t)l * DM * DIN, DM, DIN, (u16*)(p.ws + O_WIN) + (size_t)l * NP * DM, 0, r, lds);
      else if ((r -= 480) < 256) conv_tile(pin(p, I_WOUT) + (size_t)l * DM * DM, DM, DM, (u16*)(p.ws + O_WOUT) + (size_t)l * DM * DM, 1, r, lds);
      else if ((r -= 256) < 1408) conv_tile(pin(p, I_WFFI) + (size_t)l * DM * 2 * DFF, DM, 2 * DFF, (u16*)(p.ws + O_WFFI) + (size_t)l * 2 * DFF * DM, 2, r, lds);
      else if ((r -= 1408) < 704) conv_tile(pin(p, I_WFFO) + (size_t)l * DFF * DM, DFF, DM, (u16*)(p.ws + O_WFFO) + (size_t)l * DM * DFF, 1, r, lds);
      else { r -= 704; conv_tile(pin(p, I_WGLU) + (size_t)l * 512 * 512, 512, 512, (u16*)(p.ws + O_WGLU) + (size_t)l * 512 * 512, 1, r, lds); }
    } else if (it < N_MOD + N_CV + N_TAB) {
      int idx = (it - N_MOD - N_CV) * 512 + tid;
      int l = idx >> 12, d = (idx >> 11) & 1, g = (idx >> 6) & 31, pp = idx & 63;
      int ai = ((l * 2 + d) * 32 + g) * 64 + pp;
      float are = pin(p, I_ARE)[ai], aim = pin(p, I_AIM)[ai];
      float step = __expf(pin(p, I_LOGDT)[(l * 2 + d) * 32 + g]);
      float er = __expf(are * step), sn, cs; sincos_acc(aim * step, sn, cs);
      float lbr = er * cs, lbi = er * sn;
      float qr = lbr, qi = lbi;
      for (int i = 0; i < 6; ++i) { float nr = qr * qr - qi * qi, ni = 2.f * qr * qi; qr = nr; qi = ni; }
      float den = are * are + aim * aim;
      float cr = ((lbr - 1.f) * are + lbi * aim) / den, ci = (lbi * are - (lbr - 1.f) * aim) / den;
      float* tab = (float*)(p.ws + O_S5T) + (size_t)l * S5T_L;
      int e = (d * 32 + g) * 64 + pp;
      tab[e * 2] = lbr; tab[e * 2 + 1] = lbi; tab[8192 + e * 2] = qr; tab[8192 + e * 2 + 1] = qi;
      const float* bre = pin(p, I_BRE) + ((size_t)(l * 32 + g) * 64 + pp) * 16;
      const float* bim = pin(p, I_BIM) + ((size_t)(l * 32 + g) * 64 + pp) * 16;
      u16* bb16 = (u16*)(tab + 16384) + (size_t)(d * 32 + g) * 4 * 32 * 16;
      u16* cc16 = (u16*)(tab + 81920) + (size_t)(d * 32 + g) * 16 * 128;
      const float* cre = pin(p, I_CRE) + (size_t)((l * 2 + d) * 32 + g) * 16 * 64 + pp;
      const float* cim = pin(p, I_CIM) + (size_t)((l * 2 + d) * 32 + g) * 16 * 64 + pp;
      for (int c = 0; c < 16; ++c) {
        float br = bre[c], bi = bim[c];
        bb16[(((pp >> 5)) * 32 + (pp & 31)) * 16 + c] = f2bf(cr * br - ci * bi);
        bb16[((2 + (pp >> 5)) * 32 + (pp & 31)) * 16 + c] = f2bf(cr * bi + ci * br);
        cc16[c * 128 + pp] = f2bf(cre[c * 64]); cc16[c * 128 + 64 + pp] = f2bf(-cim[c * 64]);
      }
    } else {
      int r = it - N_MOD - N_CV - N_TAB;
      if (r < 2048) { int e = r * 512 + tid; int d = e & 63, j = (e >> 6) & 511, kvh = (e >> 15) & 3, b = (e >> 17) & 3, l = e >> 19;
        ((u16*)(p.ws + O_KC))[e] = f2bf(pin(p, I_CK)[((size_t)((b * 2 + l) * 512 + j) * 4 + kvh) * 64 + d]); }
      else { int e = (r - 2048) * 512 + tid; int j = e & 511, d = (e >> 9) & 63, kvh = (e >> 15) & 3, b = (e >> 17) & 3, l = e >> 19;
        ((u16*)(p.ws + O_VCT))[e] = f2bf(pin(p, I_CV)[((size_t)((b * 2 + l) * 512 + j) * 4 + kvh) * 64 + d]); }
    }
  }
}

DI void ph_prenorm(const P& p) {
  const int tid_ = otid(), lane = tid_ & 63, wave = __builtin_amdgcn_readfirstlane(tid_ >> 6);
  const float* mod = (const float*)(p.ws + O_MOD);
  const float* gw = pin(p, I_NMPRE);
  u16* H = (u16*)(p.ws + O_H);
  for (int r = blockIdx.x * 8 + wave; r < T; r += gridDim.x * 8) {
    const float* x = r < TC ? pin(p, I_XP) + (size_t)r * DM : pin(p, I_XS) + (size_t)(r - TC) * DM;
    const float* mr = mod + (size_t)modrow(r) * 12288;
    float4 v[8]; float ss = 0.f;
#pragma unroll
    for (int i = 0; i < 8; ++i) { v[i] = *(const float4*)(x + i * 256 + lane * 4); ss += v[i].x * v[i].x + v[i].y * v[i].y + v[i].z * v[i].z + v[i].w * v[i].w; }
    ss = wsum(ss); float rs = rsqrtf(ss * (1.f / DM) + 1e-6f);
#pragma unroll
    for (int i = 0; i < 8; ++i) {
      int c = i * 256 + lane * 4;
      float4 g = *(const float4*)(gw + c), sh = *(const float4*)(mr + c), sc = *(const float4*)(mr + 2048 + c);
      s16x4 o; o[0] = (short)f2bf(v[i].x * rs * g.x * (1.f + sc.x) + sh.x); o[1] = (short)f2bf(v[i].y * rs * g.y * (1.f + sc.y) + sh.y);
      o[2] = (short)f2bf(v[i].z * rs * g.z * (1.f + sc.z) + sh.z); o[3] = (short)f2bf(v[i].w * rs * g.w * (1.f + sc.w) + sh.w);
      *(s16x4*)(H + (size_t)r * DM + c) = o;
    }
  }
}
DI void ph_row(const P& p, const float* wpost, int gate_off, const float* wpre, const float* modn, int sh_off, int sc_off, const float* modg, bool from_input) {
  const int tid_ = otid(), lane = tid_ & 63, wave = __builtin_amdgcn_readfirstlane(tid_ >> 6);
  u16* H = (u16*)(p.ws + O_H);
  const int stride = gridDim.x * 8;
  int r = blockIdx.x * 8 + wave;
  bf16x8 nh[4]; float4 nx[8];
#define ROW_LOAD(rr) do { const u16* hr_ = H + (size_t)(rr) * DM + lane * 8; \
    const float* xs_ = (from_input ? ((rr) < TC ? pin(p, I_XP) + (size_t)(rr) * DM : pin(p, I_XS) + (size_t)((rr) - TC) * DM) : p.out + OUT_X + (size_t)(rr) * DM) + lane * 8; \
    _Pragma("unroll") for (int i_ = 0; i_ < 4; ++i_) { nh[i_] = *(const bf16x8*)(hr_ + i_ * 512); nx[2 * i_] = *(const float4*)(xs_ + i_ * 512); nx[2 * i_ + 1] = *(const float4*)(xs_ + i_ * 512 + 4); } } while (0)
  if (r < T) ROW_LOAD(r);
  for (; r < T; r += stride) {
    bf16x8 ch[4]; float4 cx[8];
#pragma unroll
    for (int i = 0; i < 4; ++i) { ch[i] = nh[i]; cx[2 * i] = nx[2 * i]; cx[2 * i + 1] = nx[2 * i + 1]; }
    if (r + stride < T) ROW_LOAD(r + stride);
    const int mrow = modrow(r);
    const float* mg = modg + (size_t)mrow * 12288 + gate_off;
    float* xr = p.out + OUT_X + (size_t)r * DM;
    u16* hr = H + (size_t)r * DM;
    float o[32]; float ss = 0.f;
#pragma unroll
    for (int i = 0; i < 4; ++i)
#pragma unroll
      for (int e = 0; e < 8; ++e) { o[i * 8 + e] = bfs(ch[i][e]); ss += o[i * 8 + e] * o[i * 8 + e]; }
    ss = wsum(ss); float rs = rsqrtf(ss * (1.f / DM) + 1e-6f);
    float ss2 = 0.f;
#pragma unroll
    for (int i = 0; i < 4; ++i)
#pragma unroll
      for (int q = 0; q < 2; ++q) {
        int c = i * 512 + lane * 8 + q * 4;
        float4 xv = cx[2 * i + q], w = *(const float4*)(wpost + c), g = *(const float4*)(mg + c);
        xv.x += g.x * o[i * 8 + q * 4 + 0] * rs * w.x; xv.y += g.y * o[i * 8 + q * 4 + 1] * rs * w.y;
        xv.z += g.z * o[i * 8 + q * 4 + 2] * rs * w.z; xv.w += g.w * o[i * 8 + q * 4 + 3] * rs * w.w;
        *(float4*)(xr + c) = xv;
        o[i * 8 + q * 4 + 0] = xv.x; o[i * 8 + q * 4 + 1] = xv.y; o[i * 8 + q * 4 + 2] = xv.z; o[i * 8 + q * 4 + 3] = xv.w;
        ss2 += xv.x * xv.x + xv.y * xv.y + xv.z * xv.z + xv.w * xv.w;
      }
    if (wpre) {
      ss2 = wsum(ss2); float rs2 = rsqrtf(ss2 * (1.f / DM) + 1e-6f);
      const float* mn = modn + (size_t)mrow * 12288;
#pragma unroll
      for (int i = 0; i < 4; ++i) {
        int c = i * 512 + lane * 8;
        float4 w0 = *(const float4*)(wpre + c), w1 = *(const float4*)(wpre + c + 4), sh0 = *(const float4*)(mn + sh_off + c), sh1 = *(const float4*)(mn + sh_off + c + 4), sc0 = *(const float4*)(mn + sc_off + c), sc1 = *(const float4*)(mn + sc_off + c + 4);
        const float* oo = &o[i * 8];
        bf16x8 v = pack8(oo[0] * rs2 * w0.x * (1.f + sc0.x) + sh0.x, oo[1] * rs2 * w0.y * (1.f + sc0.y) + sh0.y, oo[2] * rs2 * w0.z * (1.f + sc0.z) + sh0.z, oo[3] * rs2 * w0.w * (1.f + sc0.w) + sh0.w,
                         oo[4] * rs2 * w1.x * (1.f + sc1.x) + sh1.x, oo[5] * rs2 * w1.y * (1.f + sc1.y) + sh1.y, oo[6] * rs2 * w1.z * (1.f + sc1.z) + sh1.z, oo[7] * rs2 * w1.w * (1.f + sc1.w) + sh1.w);
        *(bf16x8*)(hr + c) = v;
      }
    }
  }
#undef ROW_LOAD
}

DI void prep_item(const P& p, int l, int it, LAS char* shm) {
  LAS u16* tile = (LAS u16*)shm;
  const int tid = otid(), tb = it >> 4, c0 = (it & 15) * 64, t0 = tb * 64;
  const u16* proj = (const u16*)(p.ws + O_PROJ);
  { const int tt = tid >> 3, ch0 = c0 + (tid & 7) * 8, t = t0 + tt;
    int i, L; if (t < TC) { i = t & 255; L = 256; } else { i = (t - TC) & 4095; L = 4096; }
    const u16* px = proj + (size_t)t * NP + C_X + ch0;
    bf16x8 x1 = *(const bf16x8*)px, x0, x2;
    if (i > 0) x0 = *(const bf16x8*)(px - NP); else x0 = (bf16x8){0, 0, 0, 0, 0, 0, 0, 0};
    if (i < L - 1) x2 = *(const bf16x8*)(px + NP); else x2 = (bf16x8){0, 0, 0, 0, 0, 0, 0, 0};
    const float* cw = pin(p, I_CONVW) + (size_t)l * 3 * 1024 + ch0;
    const float* cb = pin(p, I_CONVB) + (size_t)l * 1024 + ch0;
    bf16x8 o;
#pragma unroll
    for (int e = 0; e < 8; ++e) { float y = cb[e] + cw[e] * bfs(x0[e]) + cw[1024 + e] * bfs(x1[e]) + cw[2048 + e] * bfs(x2[e]); o[e] = (short)f2bf(siluf(y)); }
    *(bf16x8*)((u16*)(p.ws + O_XC) + (size_t)t * 1024 + ch0) = o;
    *(LAS bf16x8*)(tile + tt * 72 + (tid & 7) * 8) = o; }
  __syncthreads();
  { const int cc = tid >> 3, tv = tid & 7; bf16x8 o;
#pragma unroll
    for (int e = 0; e < 8; ++e) o[e] = (short)tile[(tv * 8 + e) * 72 + cc];
    *(bf16x8*)((u16*)(p.ws + O_XCT) + (size_t)(c0 + cc) * T + t0 + tv * 8) = o; }
  __syncthreads();
}
DI void cum_item(const P& p, int l, int gc) {
  const int tid = otid(), lane = tid & 63, wave = __builtin_amdgcn_readfirstlane(tid >> 6), t0 = gc * 128;
  const float* dtr = (const float*)(p.ws + O_DT);
  for (int hd = wave; hd < 24; hd += 8) {
    const float bias = pin(p, I_DTB)[l * 24 + hd], a = -__expf(pin(p, I_ALOG)[l * 24 + hd]);
    float x0 = dtr[(size_t)(t0 + 2 * lane) * 32 + hd] + bias, x1 = dtr[(size_t)(t0 + 2 * lane + 1) * 32 + hd] + bias;
    float d0 = x0 > 15.f ? x0 : __logf(1.f + __expf(x0)), d1 = x1 > 15.f ? x1 : __logf(1.f + __expf(x1));
    float v0 = d0 * a, v1 = d1 * a, ps = v0 + v1, inc = ps;
#pragma unroll
    for (int o = 1; o < 64; o <<= 1) { float y = __shfl_up(inc, o); if (lane >= o) inc += y; }
    float total = __shfl(inc, 63), exc = inc - ps;
    float c0, c1;
    if (hd < 12) { c0 = exc + v0; c1 = inc; } else { c0 = total - exc; c1 = total - exc - v0; }
    float* cum = (float*)(p.ws + O_CUM) + ((size_t)gc * 24 + hd) * 128 + 2 * lane;
    float* dtw = (float*)(p.ws + O_DTW) + ((size_t)gc * 24 + hd) * 128 + 2 * lane;
    *(float2*)cum = make_float2(c0, c1); *(float2*)dtw = make_float2(d0, d1);
    if (lane == 0) ((float*)(p.ws + O_CDEC))[gc * 24 + hd] = __expf(total);
  }
}
DI void rope_item(const P& p, int it) {
  int idx = it * 512 + otid(), j = idx & 31, tl = idx >> 5, t = TC + tl, i = tl & 4095;
  float pos = (j < 16) ? (float)(i >> 6) : (float)(i & 63);
  float inv = __expf(-(float)(j & 15) * (9.210340371976184f / 16.f));
  float sn, cs; sincos_acc(pos * inv, sn, cs);
  u16* row = (u16*)(p.ws + O_PROJ) + (size_t)t * NP;
#pragma unroll 4
  for (int hh = 0; hh < 16; ++hh) {
    int base = (hh < 12 ? C_Q + hh * 64 : C_K + (hh - 12) * 64) + j;
    float x1 = bf2f(row[base]), x2 = bf2f(row[base + 32]);
    row[base] = f2bf(x1 * cs - x2 * sn); row[base + 32] = f2bf(x2 * cs + x1 * sn);
  }
}
DI void vt_item(const P& p, int it, LAS char* shm) {
  LAS u16* tile = (LAS u16*)shm;
  const int tid = otid(), t0 = (it >> 2) * 64, c0 = (it & 3) * 64;
  const u16* proj = (const u16*)(p.ws + O_PROJ);
  { int cc = tid & 63, tr = tid >> 6;
#pragma unroll
    for (int i = 0; i < 8; ++i) tile[(tr + 8 * i) * 66 + cc] = proj[(size_t)(t0 + tr + 8 * i) * NP + C_V + c0 + cc]; }
  __syncthreads();
  { int tt = tid & 63, cr = tid >> 6; u16* vt = (u16*)(p.ws + O_VT);
#pragma unroll
    for (int i = 0; i < 8; ++i) vt[(size_t)(c0 + cr + 8 * i) * T + t0 + tt] = tile[tt * 66 + cr + 8 * i]; }
  __syncthreads();
}
DI int s5_tok(int hh, int stp, int dir) { return hh * 64 + (dir ? 63 - stp : stp); }
#define S5_SCAN_STEP(i) do { float n0r = s0r * lr0 - s0i * li0 + a0[i], n0i = s0r * li0 + s0i * lr0 + a2[i]; s0r = n0r; s0i = n0i; \
    float n1r = s1r * lr1 - s1i * li1 + a1[i], n1i = s1r * li1 + s1i * lr1 + a3[i]; s1r = n1r; s1i = n1i; } while (0)
DI void s5p1_item(const P& p, int l, int it) {
  const int tid_ = otid(), lane = tid_ & 63, wave = __builtin_amdgcn_readfirstlane(tid_ >> 6), r = lane & 31, h = lane >> 5;
  const int gc = it >> 3, g = (it & 7) * 4 + (wave >> 1), dir = wave & 1, t0 = gc * 128;
  const float* tab = (const float*)(p.ws + O_S5T) + (size_t)l * S5T_L;
  const int e0 = (dir * 32 + g) * 64 + r;
  const float lr0 = tab[e0 * 2], li0 = tab[e0 * 2 + 1], lr1 = tab[(e0 + 32) * 2], li1 = tab[(e0 + 32) * 2 + 1];
  const u16* bb16 = (const u16*)(tab + 16384) + (size_t)(dir * 32 + g) * 4 * 32 * 16;
  bf16x8 bop[4];
#pragma unroll
  for (int nt = 0; nt < 4; ++nt) bop[nt] = *(const bf16x8*)(bb16 + (nt * 32 + r) * 16 + 8 * h);
  const u16* up = (const u16*)(p.ws + O_PROJ) + C_U + g * 16 + 8 * h;
  const int mh = (r >> 2) & 1, mi = (r & 3) + 4 * (r >> 3);
  float s0r = 0.f, s0i = 0.f, s1r = 0.f, s1i = 0.f;
  f32x16 zero;
#pragma unroll
  for (int i = 0; i < 16; ++i) zero[i] = 0.f;
#pragma unroll 1
  for (int it4 = 0; it4 < 4; ++it4) {
    bf16x8 af = *(const bf16x8*)(up + (size_t)(t0 + s5_tok(mh, 16 * it4 + mi, dir)) * NP);
    f32x16 a0 = __builtin_amdgcn_mfma_f32_32x32x16_bf16(af, bop[0], zero, 0, 0, 0);
    f32x16 a1 = __builtin_amdgcn_mfma_f32_32x32x16_bf16(af, bop[1], zero, 0, 0, 0);
    f32x16 a2 = __builtin_amdgcn_mfma_f32_32x32x16_bf16(af, bop[2], zero, 0, 0, 0);
    f32x16 a3 = __builtin_amdgcn_mfma_f32_32x32x16_bf16(af, bop[3], zero, 0, 0, 0);
#pragma unroll
    for (int i = 0; i < 16; ++i) S5_SCAN_STEP(i);
  }
  float* sh = (float*)(p.ws + O_S5H) + ((size_t)((2 * gc + h) * 32 + g) * 2 + dir) * 128;
  *(float2*)(sh + r * 2) = make_float2(s0r, s0i); *(float2*)(sh + (32 + r) * 2) = make_float2(s1r, s1i);
}
DI void s5comb_item(const P& p, int l, int it) {
  int idx = it * 512 + otid(), pp = idx & 63, dir = (idx >> 6) & 1, g = (idx >> 7) & 31, seq = idx >> 12;
  const float* tab = (const float*)(p.ws + O_S5T) + (size_t)l * S5T_L;
  int e = (dir * 32 + g) * 64 + pp;
  float qr = tab[8192 + e * 2], qi = tab[8192 + e * 2 + 1];
  float hr = 0.f, hi = 0.f; int nc = 4, hc0 = seq * 4;
  if (seq >= 32) { int b = seq - 32; nc = 64; hc0 = 128 + b * 64; size_t o = (size_t)((b * 2 + l) * 2 + dir) * 2048 + g * 64 + pp; hr = pin(p, I_S5R)[o]; hi = pin(p, I_S5I)[o]; }
  float* s5h = (float*)(p.ws + O_S5H);
#pragma unroll 1
  for (int kb = 0; kb < nc; kb += 16) {
    float2 v[16];
#pragma unroll
    for (int k = 0; k < 16; ++k) if (kb + k < nc) {
      int hc = hc0 + (dir ? nc - 1 - (kb + k) : kb + k);
      v[k] = *(const float2*)(s5h + ((size_t)(hc * 32 + g) * 2 + dir) * 128 + pp * 2); }
#pragma unroll
    for (int k = 0; k < 16; ++k) if (kb + k < nc) {
      int hc = hc0 + (dir ? nc - 1 - (kb + k) : kb + k);
      *(float2*)(s5h + ((size_t)(hc * 32 + g) * 2 + dir) * 128 + pp * 2) = make_float2(hr, hi);
      float nr = hr * qr - hi * qi + v[k].x, ni = hr * qi + hi * qr + v[k].y; hr = nr; hi = ni; }
  }
  if (seq < 32) { size_t o = (size_t)((seq * 2 + l) * 2 + dir) * 2048 + g * 64 + pp; p.out[OUT_S5R + o] = hr; p.out[OUT_S5I + o] = hi; }
}
DI void s5p2_item(const P& p, int l, int it, LAS char* shm) {
  const int tid_ = otid(), lane = tid_ & 63, wave = __builtin_amdgcn_readfirstlane(tid_ >> 6), r = lane & 31, h = lane >> 5;
  const int gc = it >> 2, g = (it & 3) * 8 + wave, t0 = gc * 128;
  LAS u16* HT = (LAS u16*)(shm + wave * 17408);
  LAS float* ybuf = (LAS float*)(shm + wave * 17408 + 8704);
  const float* tab = (const float*)(p.ws + O_S5T) + (size_t)l * S5T_L;
  const u16* up = (const u16*)(p.ws + O_PROJ) + C_U + g * 16;
  const int mh = (r >> 2) & 1, mi = (r & 3) + 4 * (r >> 3);
  const float Dv = pin(p, I_S5D)[l * 512 + g * 16 + (r & 15)];
  f32x16 zero;
#pragma unroll
  for (int i = 0; i < 16; ++i) zero[i] = 0.f;
#pragma unroll 1
  for (int dd = 0; dd < 2; ++dd) {
    const int dir = 1 - dd;
    const int e0 = (dir * 32 + g) * 64 + r;
    const float lr0 = tab[e0 * 2], li0 = tab[e0 * 2 + 1], lr1 = tab[(e0 + 32) * 2], li1 = tab[(e0 + 32) * 2 + 1];
    const u16* bb16 = (const u16*)(tab + 16384) + (size_t)(dir * 32 + g) * 4 * 32 * 16;
    const u16* cc16 = (const u16*)(tab + 81920) + (size_t)(dir * 32 + g) * 16 * 128;
    bf16x8 bop[4], cop[8];
#pragma unroll
    for (int nt = 0; nt < 4; ++nt) bop[nt] = *(const bf16x8*)(bb16 + (nt * 32 + r) * 16 + 8 * h);
#pragma unroll
    for (int ks = 0; ks < 8; ++ks) { if (r < 16) cop[ks] = *(const bf16x8*)(cc16 + r * 128 + ks * 16 + 8 * h); else cop[ks] = (bf16x8){0, 0, 0, 0, 0, 0, 0, 0}; }
    const float* sh = (const float*)(p.ws + O_S5H) + ((size_t)((2 * gc + h) * 32 + g) * 2 + dir) * 128;
    float s0r = sh[r * 2], s0i = sh[r * 2 + 1], s1r = sh[(32 + r) * 2], s1i = sh[(32 + r) * 2 + 1];
#pragma unroll 1
    for (int it4 = 0; it4 < 4; ++it4) {
      bf16x8 af = *(const bf16x8*)(up + 8 * h + (size_t)(t0 + s5_tok(mh, 16 * it4 + mi, dir)) * NP);
      f32x16 a0 = __builtin_amdgcn_mfma_f32_32x32x16_bf16(af, bop[0], zero, 0, 0, 0);
      f32x16 a1 = __builtin_amdgcn_mfma_f32_32x32x16_bf16(af, bop[1], zero, 0, 0, 0);
      f32x16 a2 = __builtin_amdgcn_mfma_f32_32x32x16_bf16(af, bop[2], zero, 0, 0, 0);
      f32x16 a3 = __builtin_amdgcn_mfma_f32_32x32x16_bf16(af, bop[3], zero, 0, 0, 0);
#pragma unroll
      for (int i = 0; i < 16; ++i) { S5_SCAN_STEP(i); a0[i] = s0r; a1[i] = s1r; a2[i] = s0i; a3[i] = s1i; }
#pragma unroll
      for (int i = 0; i < 16; i += 2) {
        LAS u16* row = HT + (16 * h + i) * 136 + r;
        unsigned k0 = cvt_pk_bf16(a0[i], a0[i + 1]), k1 = cvt_pk_bf16(a1[i], a1[i + 1]), k2 = cvt_pk_bf16(a2[i], a2[i + 1]), k3 = cvt_pk_bf16(a3[i], a3[i + 1]);
        row[0] = (u16)k0; row[136] = (u16)(k0 >> 16); row[32] = (u16)k1; row[136 + 32] = (u16)(k1 >> 16);
        row[64] = (u16)k2; row[136 + 64] = (u16)(k2 >> 16); row[96] = (u16)k3; row[136 + 96] = (u16)(k3 >> 16);
      }
      asm volatile("s_waitcnt lgkmcnt(0)" ::: "memory");
      f32x16 y2 = zero;
#pragma unroll
      for (int ks = 0; ks < 8; ++ks) {
        bf16x8 a2f = *(const LAS bf16x8*)(HT + r * 136 + ks * 16 + 8 * h);
        y2 = __builtin_amdgcn_mfma_f32_32x32x16_bf16(a2f, cop[ks], y2, 0, 0, 0);
      }
      if (r < 16) {
#pragma unroll
        for (int i2 = 0; i2 < 16; ++i2) {
          const int m2 = crow(i2, h), tok = s5_tok(m2 >> 4, 16 * it4 + (m2 & 15), dir);
          if (dd == 0) ybuf[tok * 16 + r] = y2[i2];
          else {
            float u = bf2f(up[(size_t)(t0 + tok) * NP + r]);
            float y = ybuf[tok * 16 + r] + y2[i2] + Dv * u;
            float gl = y / (1.f + __expf(-1.5957691216057308f * (y + 0.044715f * y * y * y)));
            ((u16*)(p.ws + O_G5))[(size_t)(t0 + tok) * 512 + g * 16 + r] = f2bf(gl);
          }
        }
      }
      asm volatile("s_waitcnt lgkmcnt(0)" ::: "memory");
    }
  }
}
DI void ssd_p1_item(const P& p, int l, int it, LAS char* shm) {
  const int tid = otid(), lane = tid & 63, wave = __builtin_amdgcn_readfirstlane(tid >> 6), r = lane & 31, h = lane >> 5;
  const int gc = it / 3, rr = it - gc * 3, t0 = gc * 128, hd = rr * 8 + wave, dir = hd / 12, head = hd - dir * 12, g = head / 6;
  LAS float* wb = (LAS float*)(shm + wave * 512);
  const float* cum = (const float*)(p.ws + O_CUM) + ((size_t)gc * 24 + hd) * 128;
  const float* dtw = (const float*)(p.ws + O_DTW) + ((size_t)gc * 24 + hd) * 128;
  const float total = dir ? cum[0] : cum[127];
  wb[lane] = dtw[lane] * __expf(total - cum[lane]); wb[lane + 64] = dtw[lane + 64] * __expf(total - cum[lane + 64]);
  asm volatile("s_waitcnt lgkmcnt(0)" ::: "memory");
  const u16* xct = (const u16*)(p.ws + O_XCT);
  const u16* xa0 = xct + (size_t)(head * 64 + r) * T + t0 + 8 * h;
  const u16* xa1 = xa0 + (size_t)32 * T;
  const u16* xb0 = xct + (size_t)(768 + g * 64 + r) * T + t0 + 8 * h;
  const u16* xb1 = xb0 + (size_t)32 * T;
  f32x16 a00, a01, a10, a11;
#pragma unroll
  for (int i = 0; i < 16; ++i) { a00[i] = 0.f; a01[i] = 0.f; a10[i] = 0.f; a11[i] = 0.f; }
#pragma unroll 2
  for (int ks = 0; ks < 8; ++ks) {
    bf16x8 r0 = *(const bf16x8*)(xa0 + ks * 16), r1 = *(const bf16x8*)(xa1 + ks * 16);
    bf16x8 b0 = *(const bf16x8*)(xb0 + ks * 16), b1 = *(const bf16x8*)(xb1 + ks * 16);
    f32x4 w0 = *(const LAS f32x4*)(wb + ks * 16 + 8 * h), w1 = *(const LAS f32x4*)(wb + ks * 16 + 8 * h + 4);
    bf16x8 f0, f1;
#pragma unroll
    for (int j = 0; j < 8; ++j) { float w = j < 4 ? w0[j & 3] : w1[j & 3]; f0[j] = (short)f2bf(bfs(r0[j]) * w); f1[j] = (short)f2bf(bfs(r1[j]) * w); }
    a00 = __builtin_amdgcn_mfma_f32_32x32x16_bf16(f0, b0, a00, 0, 0, 0);
    a01 = __builtin_amdgcn_mfma_f32_32x32x16_bf16(f0, b1, a01, 0, 0, 0);
    a10 = __builtin_amdgcn_mfma_f32_32x32x16_bf16(f1, b0, a10, 0, 0, 0);
    a11 = __builtin_amdgcn_mfma_f32_32x32x16_bf16(f1, b1, a11, 0, 0, 0);
  }
  float* sst = (float*)(p.ws + O_SST) + ((size_t)(gc * 2 + dir) * 12 + head) * 4096;
#pragma unroll
  for (int i = 0; i < 16; ++i) {
    int pr = crow(i, h);
    sst[pr * 64 + r] = a00[i]; sst[pr * 64 + 32 + r] = a01[i]; sst[(32 + pr) * 64 + r] = a10[i]; sst[(32 + pr) * 64 + 32 + r] = a11[i];
  }
  asm volatile("s_waitcnt lgkmcnt(0)" ::: "memory");
}
DI void ssd_p2_item(const P& p, int l, int it, LAS char* shm) {
  const int tid = otid(), lane = tid & 63, wave = __builtin_amdgcn_readfirstlane(tid >> 6), r = lane & 31, h = lane >> 5;
  const int task = it * 8 + wave, lb = task & 3, head = (task >> 2) % 12, gc = task / 48, g = head / 6, t0 = gc * 128;
  LAS float* lf = (LAS float*)(shm + wave * 2048);
  { const float* cumf = (const float*)(p.ws + O_CUM) + ((size_t)gc * 24 + head) * 128;
    const float* dtf = (const float*)(p.ws + O_DTW) + ((size_t)gc * 24 + head) * 128;
    lf[lane] = cumf[lane]; lf[64 + lane] = cumf[64 + lane]; lf[128 + lane] = cumf[12 * 128 + lane]; lf[192 + lane] = cumf[12 * 128 + 64 + lane];
    lf[256 + lane] = dtf[lane]; lf[320 + lane] = dtf[64 + lane]; lf[384 + lane] = dtf[12 * 128 + lane]; lf[448 + lane] = dtf[12 * 128 + 64 + lane]; }
  asm volatile("s_waitcnt lgkmcnt(0)" ::: "memory");
  const int lq = lb * 32 + r;
  const float cfl = lf[lq], cbl = lf[128 + lq];
  const float Dh = pin(p, I_SSDD)[l * 12 + head];
  const u16* xc = (const u16*)(p.ws + O_XC);
  bf16x8 cq[4];
  { const u16* crowp = xc + (size_t)(t0 + lq) * 1024 + 896 + g * 64 + 8 * h;
#pragma unroll
    for (int ks = 0; ks < 4; ++ks) cq[ks] = *(const bf16x8*)(crowp + ks * 16); }
  f32x16 o0, o1;
#pragma unroll
  for (int i = 0; i < 16; ++i) { o0[i] = 0.f; o1[i] = 0.f; }
#pragma unroll
  for (int dir = 0; dir < 2; ++dir) {
    const float* hs = (const float*)(p.ws + O_SST) + ((size_t)(gc * 2 + dir) * 12 + head) * 4096;
    f32x16 u0, u1;
#pragma unroll
    for (int i = 0; i < 16; ++i) { u0[i] = 0.f; u1[i] = 0.f; }
#pragma unroll
    for (int ks = 0; ks < 4; ++ks) {
      const float* h0 = hs + (size_t)r * 64 + ks * 16 + 8 * h; const float* h1 = h0 + 32 * 64;
      float4 x0 = *(const float4*)h0, x1 = *(const float4*)(h0 + 4), y0 = *(const float4*)h1, y1 = *(const float4*)(h1 + 4);
      bf16x8 fa = pack8(x0.x, x0.y, x0.z, x0.w, x1.x, x1.y, x1.z, x1.w), fb = pack8(y0.x, y0.y, y0.z, y0.w, y1.x, y1.y, y1.z, y1.w);
      u0 = __builtin_amdgcn_mfma_f32_32x32x16_bf16(fa, cq[ks], u0, 0, 0, 0);
      u1 = __builtin_amdgcn_mfma_f32_32x32x16_bf16(fb, cq[ks], u1, 0, 0, 0);
    }
    const float sc = __expf(dir ? cbl : cfl);
#pragma unroll
    for (int i = 0; i < 16; ++i) { o0[i] += sc * u0[i]; o1[i] += sc * u1[i]; }
  }
  const u16* xct = (const u16*)(p.ws + O_XCT);
  const u16* vrow0 = xct + (size_t)(head * 64 + r) * T + t0 + 8 * h;
  const u16* vrow1 = vrow0 + (size_t)32 * T;
  const u16* brow = xc + (size_t)(t0 + pi23(r)) * 1024 + 768 + g * 64 + 8 * h;
#pragma unroll 1
  for (int st = 0; st < 4; ++st) {
    f32x16 sg;
#pragma unroll
    for (int i = 0; i < 16; ++i) sg[i] = 0.f;
#pragma unroll
    for (int ks = 0; ks < 4; ++ks) {
      bf16x8 kf = *(const bf16x8*)(brow + (size_t)st * 32 * 1024 + ks * 16);
      sg = __builtin_amdgcn_mfma_f32_32x32x16_bf16(kf, cq[ks], sg, 0, 0, 0);
    }
#pragma unroll
    for (int q = 0; q < 4; ++q) {
      const int sb = st * 32 + 16 * (q >> 1) + 8 * h + 4 * (q & 1);
      f32x4 cf4 = *(const LAS f32x4*)(lf + sb), cb4 = *(const LAS f32x4*)(lf + 128 + sb), df4 = *(const LAS f32x4*)(lf + 256 + sb), db4 = *(const LAS f32x4*)(lf + 384 + sb);
#pragma unroll
      for (int e = 0; e < 4; ++e) {
        const int si = sb + e;
        float wf = (si <= lq) ? df4[e] * __expf(fminf(cfl - cf4[e], 0.f)) : 0.f;
        float wbk = (si >= lq) ? db4[e] * __expf(fminf(cbl - cb4[e], 0.f)) : 0.f;
        float v = sg[q * 4 + e] * (wf + wbk);
        if (si == lq) v += Dh;
        sg[q * 4 + e] = v;
      }
    }
#pragma unroll
    for (int sp = 0; sp < 2; ++sp) {
      bf16x8 pf = pack8(sg[8 * sp], sg[8 * sp + 1], sg[8 * sp + 2], sg[8 * sp + 3], sg[8 * sp + 4], sg[8 * sp + 5], sg[8 * sp + 6], sg[8 * sp + 7]);
      bf16x8 va = *(const bf16x8*)(vrow0 + st * 32 + 16 * sp), vb = *(const bf16x8*)(vrow1 + st * 32 + 16 * sp);
      o0 = __builtin_amdgcn_mfma_f32_32x32x16_bf16(va, pf, o0, 0, 0, 0);
      o1 = __builtin_amdgcn_mfma_f32_32x32x16_bf16(vb, pf, o1, 0, 0, 0);
    }
  }
  u16* yrow = (u16*)(p.ws + O_Y) + (size_t)(t0 + lq) * 768 + head * 64;
#pragma unroll
  for (int gq = 0; gq < 4; ++gq) {
    s16x4 a, bq;
#pragma unroll
    for (int e = 0; e < 4; ++e) { a[e] = (short)f2bf(o0[gq * 4 + e]); bq[e] = (short)f2bf(o1[gq * 4 + e]); }
    *(s16x4*)(yrow + 8 * gq + 4 * h) = a; *(s16x4*)(yrow + 32 + 8 * gq + 4 * h) = bq;
  }
  asm volatile("s_waitcnt lgkmcnt(0)" ::: "memory");
}
DI void ssdcomb_item(const P& p, int l, int it) {
  int idx = it * 512 + otid();
  int pn = idx & 4095, hd = (idx >> 12) % 24, seq = idx / (24 * 4096), dir = hd / 12, head = hd - dir * 12;
  float hs = 0.f; int nc = 2;
  if (seq >= 32) { nc = 32; hs = pin(p, I_SSD)[((size_t)(((seq - 32) * 2 + l) * 2 + dir) * 12 + head) * 4096 + pn]; }
  float* sst = (float*)(p.ws + O_SST); const float* cdec = (const float*)(p.ws + O_CDEC);
#pragma unroll 1
  for (int kb = 0; kb < nc; kb += 16) {
    float v[16], dc[16];
#pragma unroll
    for (int k = 0; k < 16; ++k) if (kb + k < nc) {
      int c = dir ? nc - 1 - (kb + k) : kb + k, gc = chunk_of(seq, c); size_t o = ((size_t)(gc * 2 + dir) * 12 + head);
      v[k] = sst[o * 4096 + pn]; dc[k] = cdec[o]; }
#pragma unroll
    for (int k = 0; k < 16; ++k) if (kb + k < nc) {
      int c = dir ? nc - 1 - (kb + k) : kb + k, gc = chunk_of(seq, c); size_t o = ((size_t)(gc * 2 + dir) * 12 + head);
      sst[o * 4096 + pn] = hs; hs = hs * dc[k] + v[k]; }
  }
  if (seq < 32) p.out[OUT_SSD + ((size_t)((seq * 2 + l) * 2 + dir) * 12 + head) * 4096 + pn] = hs;
}
DI void ph_ssdfinal(const P& p, int l) {
  const int tid_ = otid(), lane = tid_ & 63, wave = __builtin_amdgcn_readfirstlane(tid_ >> 6);
  const u16* proj = (const u16*)(p.ws + O_PROJ);
  const u16* yf = (const u16*)(p.ws + O_Y);
  u16* mix = (u16*)(p.ws + O_MIX);
  for (int r = blockIdx.x * 8 + wave; r < T; r += gridDim.x * 8) {
    float y[12]; float ss = 0.f;
#pragma unroll
    for (int i = 0; i < 3; ++i) {
      int c = i * 256 + lane * 4;
      s16x4 a = *(const s16x4*)(yf + (size_t)r * 768 + c);
      s16x4 z = *(const s16x4*)(proj + (size_t)r * NP + C_Z + c);
#pragma unroll
      for (int e = 0; e < 4; ++e) { float v = bfs(a[e]) * siluf(bfs(z[e])); y[i * 4 + e] = v; ss += v * v; }
    }
    ss = wsum(ss); float rs = rsqrtf(ss * (1.f / 768.f) + 1e-6f);
#pragma unroll
    for (int i = 0; i < 3; ++i) {
      int c = i * 256 + lane * 4;
      float4 w = *(const float4*)(pin(p, I_SSDN) + l * 768 + c);
      s16x4 o; o[0] = (short)f2bf(y[i * 4] * rs * w.x); o[1] = (short)f2bf(y[i * 4 + 1] * rs * w.y); o[2] = (short)f2bf(y[i * 4 + 2] * rs * w.z); o[3] = (short)f2bf(y[i * 4 + 3] * rs * w.w);
      *(s16x4*)(mix + (size_t)r * DM + c) = o;
    }
  }
}
struct AttState { float m, lsum; f32x16 o0, o1; };
struct AttKV { bf16x8 k[4]; bf16x8 v[4]; };

constexpr int ATT_KS = 72, ATT_VS = 264, ATT_VOFF = 256 * ATT_KS;
DI void attn_load_lds(AttKV& t, const LAS u16* sk, const LAS u16* sv, int j, int r, int h) {
  const LAS u16* kp = sk + (j * 32 + pi23(r)) * ATT_KS + 8 * h;
#pragma unroll
  for (int ks = 0; ks < 4; ++ks) t.k[ks] = *(const LAS bf16x8*)(kp + ks * 16);
  const LAS u16* vp = sv + r * ATT_VS + j * 32 + 8 * h;
#pragma unroll
  for (int sp = 0; sp < 2; ++sp) { t.v[sp * 2 + 0] = *(const LAS bf16x8*)(vp + 16 * sp); t.v[sp * 2 + 1] = *(const LAS bf16x8*)(vp + 32 * ATT_VS + 16 * sp); }
}
DI void attn_compute(AttState& st, const bf16x8 (&qf)[4], const AttKV& t, bool mask, int h, int qi, int k0) {
  f32x16 s;
#pragma unroll
  for (int i = 0; i < 16; ++i) s[i] = 0.f;
#pragma unroll
  for (int ks = 0; ks < 4; ++ks) s = __builtin_amdgcn_mfma_f32_32x32x16_bf16(t.k[ks], qf[ks], s, 0, 0, 0);
  float mt = -1e30f;
#pragma unroll
  for (int i = 0; i < 16; ++i) {
    float v = s[i] * 0.125f;
    if (mask) { int d = qi - (k0 + pi23(crow(i, h))); if (d > 128 || d < -128) v = -1e30f; }
    s[i] = v; mt = fmaxf(mt, v);
  }
  mt = fmaxf(mt, __shfl_xor(mt, 32));
  float mn = fmaxf(st.m, mt), alpha = __expf(st.m - mn);
  st.m = mn;
  float ps = 0.f;
#pragma unroll
  for (int i = 0; i < 16; ++i) { float e = __expf(s[i] - mn); s[i] = e; ps += e; }
  st.lsum = st.lsum * alpha + ps;
#pragma unroll
  for (int i = 0; i < 16; ++i) { st.o0[i] *= alpha; st.o1[i] *= alpha; }
#pragma unroll
  for (int sp = 0; sp < 2; ++sp) {
    bf16x8 pf = pack8(s[8 * sp], s[8 * sp + 1], s[8 * sp + 2], s[8 * sp + 3], s[8 * sp + 4], s[8 * sp + 5], s[8 * sp + 6], s[8 * sp + 7]);
    st.o0 = __builtin_amdgcn_mfma_f32_32x32x16_bf16(t.v[sp * 2 + 0], pf, st.o0, 0, 0, 0);
    st.o1 = __builtin_amdgcn_mfma_f32_32x32x16_bf16(t.v[sp * 2 + 1], pf, st.o1, 0, 0, 0);
  }
}
DI void attn_item(const P& p, int l, int item, LAS char* shm) {
  const int tid_ = otid(), lane = tid_ & 63, wave = __builtin_amdgcn_readfirstlane(tid_ >> 6), r = lane & 31, h = lane >> 5;
  int seq, head, q0b, b = 0; bool lat;
  if (item < 768) { lat = true; b = item / 192; head = (item >> 4) % 12; q0b = (item & 15) * 256; seq = 32 + b; }
  else { int it2 = item - 768; lat = false; seq = it2 / 12; head = it2 % 12; q0b = 0; }
  const int q0 = q0b + wave * 32, kvh = head / 3, L = lat ? 4096 : 256;
  const int seqstart = seq < 32 ? seq * 256 : TC + (seq - 32) * 4096;
  const u16* proj = (const u16*)(p.ws + O_PROJ);
  bf16x8 qf[4];
  { const u16* qrow = proj + (size_t)(seqstart + q0 + r) * NP + C_Q + head * 64;
#pragma unroll
    for (int ks = 0; ks < 4; ++ks) qf[ks] = *(const bf16x8*)(qrow + ks * 16 + 8 * h); }
  AttState st; st.m = pin(p, I_SINK)[l * 12 + head]; st.lsum = h == 0 ? 1.f : 0.f;
#pragma unroll
  for (int i = 0; i < 16; ++i) { st.o0[i] = 0.f; st.o1[i] = 0.f; }
  const u16* kself = proj + (size_t)seqstart * NP + C_K + kvh * 64;
  const u16* vself = (const u16*)(p.ws + O_VT) + (size_t)(kvh * 64) * T + seqstart;
  const u16* kc = (const u16*)(p.ws + O_KC) + (size_t)((l * 4 + b) * 4 + kvh) * 512 * 64;
  const u16* vc = (const u16*)(p.ws + O_VCT) + (size_t)((l * 4 + b) * 4 + kvh) * 64 * 512;
  LAS u16* sk = (LAS u16*)shm; LAS u16* sv = sk + ATT_VOFF;
  const int ns = lat ? 4 : 1, kb0 = lat ? q0b - 128 : 0, qi = q0 + r;
  const int krow = tid_ >> 1, khalf = tid_ & 1, vd = tid_ >> 3, vseg = tid_ & 7;
  bf16x8 kreg[4], vreg[4];
#define ATT_STAGE_LOAD(s_) do { const int s__ = (s_); \
    if (lat && s__ < 2) { const u16* kp_ = kc + (size_t)(s__ * 256 + krow) * 64 + khalf * 32; const u16* vp_ = vc + (size_t)vd * 512 + s__ * 256 + vseg * 32; \
      _Pragma("unroll") for (int q_ = 0; q_ < 4; ++q_) { kreg[q_] = *(const bf16x8*)(kp_ + q_ * 8); vreg[q_] = *(const bf16x8*)(vp_ + q_ * 8); } } \
    else { const int kb_ = kb0 + 256 * (lat ? s__ - 2 : 0); const int key_ = kb_ + krow, vk_ = kb_ + vseg * 32; \
      if (key_ >= 0 && key_ < L) { const u16* kp_ = kself + (size_t)key_ * NP + khalf * 32; _Pragma("unroll") for (int q_ = 0; q_ < 4; ++q_) kreg[q_] = *(const bf16x8*)(kp_ + q_ * 8); } \
      if (vk_ >= 0 && vk_ < L) { const u16* vp_ = vself + (size_t)vd * T + vk_; _Pragma("unroll") for (int q_ = 0; q_ < 4; ++q_) vreg[q_] = *(const bf16x8*)(vp_ + q_ * 8); } } } while (0)
  ATT_STAGE_LOAD(0);
#pragma unroll 1
  for (int s = 0; s < ns; ++s) {
    __syncthreads();
#pragma unroll
    for (int q = 0; q < 4; ++q) { *(LAS bf16x8*)(sk + krow * ATT_KS + khalf * 32 + q * 8) = kreg[q]; *(LAS bf16x8*)(sv + vd * ATT_VS + vseg * 32 + q * 8) = vreg[q]; }
    __syncthreads();
    if (s + 1 < ns) ATT_STAGE_LOAD(s + 1);
    const bool band = lat && s >= 2;
    const int kb = band ? kb0 + 256 * (s - 2) : 0;
    int j0 = 0, j1 = 8;
    if (band) { int lo = max(max(0, q0 - 128), kb), hi = min(min(4096, q0 + 160), kb + 256); j0 = (lo - kb) >> 5; j1 = (hi - kb) >> 5; if (j1 < j0) j1 = j0; }
    AttKV ta, tb;
    if (j0 < j1) attn_load_lds(ta, sk, sv, j0, r, h);
#pragma unroll 1
    for (int j = j0; j < j1; j += 2) {
      if (j + 1 < j1) attn_load_lds(tb, sk, sv, j + 1, r, h);
      attn_compute(st, qf, ta, band, h, qi, kb + 32 * j);
      if (j + 1 < j1) {
        if (j + 2 < j1) attn_load_lds(ta, sk, sv, j + 2, r, h);
        attn_compute(st, qf, tb, band, h, qi, kb + 32 * (j + 1));
      }
    }
  }
#undef ATT_STAGE_LOAD
  float lt = st.lsum + __shfl_xor(st.lsum, 32), inv = 1.f / lt;
  u16* orow = (u16*)(p.ws + O_MIX) + (size_t)(seqstart + q0 + r) * DM + 768 + head * 64;
#pragma unroll
  for (int gq = 0; gq < 4; ++gq) {
    s16x4 a, bq;
#pragma unroll
    for (int e = 0; e < 4; ++e) { a[e] = (short)f2bf(st.o0[gq * 4 + e] * inv); bq[e] = (short)f2bf(st.o1[gq * 4 + e] * inv); }
    *(s16x4*)(orow + 8 * gq + 4 * h) = a; *(s16x4*)(orow + 32 + 8 * gq + 4 * h) = bq;
  }
  __syncthreads();
}

#ifdef TPROBE
#define TSTAMP(k) do { if (blockIdx.x == 0 && otid() == 0) ((unsigned long long*)(p0.ws + O_END2))[(k)] = wall_clock64(); } while (0)
#else
#define TSTAMP(k) do { } while (0)
#endif
#define PH_BEGIN(k) if (p0.lo <= (k) && (k) < p0.hi) { P p; p.inp = p0.in; p.out = p0.out; p.ws = p0.ws; p.lo = p0.lo; p.hi = p0.hi; \
    asm volatile("" : "+s"(p.out), "+s"(p.ws)); const int G = gridDim.x, bid = blockIdx.x; (void)G; (void)bid;
#define PH_END(k) if ((k) + 1 < p0.hi) { if ((k) == 0) grid.sync(); else xcd_barrier(xb); } TSTAMP((k) + 1); }

template <int l>
DI void layer_phases(const P& p0, cg::grid_group& grid, const XcdBarrier& xb, LAS char* shm) {
  constexpr int B = 2 + 11 * l;
  PH_BEGIN(B + 0) for (int rep = 0; rep < NREP(0); ++rep) { EpiProj e{(u16*)(p.ws + O_PROJ), (float*)(p.ws + O_DT), p.out, l};
    gemm_phase((const u16*)(p.ws + O_H), (const u16*)(p.ws + O_WIN) + (size_t)l * NP * DM, T, NP, DM, e, shm, 0); } PH_END(B + 0)
  PH_BEGIN(B + 1) for (int rep = 0; rep < NREP(1); ++rep) {
    constexpr int N0 = 1536, N1 = N0 + 6144, N2 = N1 + 1024, N3 = N2 + 1536, N4 = N3 + 192;
    for (int it = bid; it < N4; it += G) {
      if (it < N0) s5p1_item(p, l, it); else if (it < N1) prep_item(p, l, it - N0, shm); else if (it < N2) { if (rep == 0) rope_item(p, it - N1); } else if (it < N3) vt_item(p, it - N2, shm); else cum_item(p, l, it - N3);
    } } PH_END(B + 1)
  PH_BEGIN(B + 2) for (int rep = 0; rep < NREP(2); ++rep) {
    constexpr int N0 = 576, N1 = N0 + 768 + 384, N2 = N1 + 288;
    for (int it = bid; it < N2; it += G) {
      if (it < N0) ssd_p1_item(p, l, it, shm); else if (it < N1) attn_item(p, l, it - N0, shm); else if (rep == 0) s5comb_item(p, l, it - N1);
    } } PH_END(B + 2)
  PH_BEGIN(B + 3) for (int rep = 0; rep < NREP(3); ++rep) {
    constexpr int N0 = 768, N1 = N0 + 6912;
    for (int it = bid; it < N1; it += G) { if (it < N0) s5p2_item(p, l, it, shm); else if (rep == 0) ssdcomb_item(p, l, it - N0); }
    } PH_END(B + 3)
  PH_BEGIN(B + 4) for (int rep = 0; rep < NREP(4); ++rep) {
    for (int it = bid; it < 1152; it += G) ssd_p2_item(p, l, it, shm);
    __syncthreads();
    EpiGlu e{(const u16*)(p.ws + O_G5), pin(p, I_BGLU) + l * 512, (u16*)(p.ws + O_MIX)};
    gemm_phase((const u16*)(p.ws + O_G5), (const u16*)(p.ws + O_WGLU) + (size_t)l * 512 * 512, T, 512, 512, e, shm, 64);
    } PH_END(B + 4)
  PH_BEGIN(B + 5) for (int rep = 0; rep < NREP(5); ++rep) { ph_ssdfinal(p, l); } PH_END(B + 5)
  PH_BEGIN(B + 6) for (int rep = 0; rep < NREP(6); ++rep) { EpiBf16 e{(u16*)(p.ws + O_H)};
    gemm_phase((const u16*)(p.ws + O_MIX), (const u16*)(p.ws + O_WOUT) + (size_t)l * DM * DM, T, DM, DM, e, shm, 0); } PH_END(B + 6)
  PH_BEGIN(B + 7) { const float* modl = (const float*)(p.ws + O_MOD) + (size_t)l * 5 * 12288;
    ph_row(p, pin(p, I_NMPOST) + l * DM, 4096, pin(p, I_NFPRE) + l * DM, modl, 6144, 8192, modl, l == 0); } PH_END(B + 7)
  PH_BEGIN(B + 8) for (int rep = 0; rep < NREP(8); ++rep) { EpiSwiglu e{(u16*)(p.ws + O_ACT)};
    gemm_phase((const u16*)(p.ws + O_H), (const u16*)(p.ws + O_WFFI) + (size_t)l * 2 * DFF * DM, T, 2 * DFF, DM, e, shm, 0); } PH_END(B + 8)
  PH_BEGIN(B + 9) for (int rep = 0; rep < NREP(9); ++rep) { EpiBf16 e{(u16*)(p.ws + O_H)};
    gemm_phase((const u16*)(p.ws + O_ACT), (const u16*)(p.ws + O_WFFO) + (size_t)l * DM * DFF, T, DM, DFF, e, shm, 0); } PH_END(B + 9)
  PH_BEGIN(B + 10) { const float* modl = (const float*)(p.ws + O_MOD) + (size_t)l * 5 * 12288;
    constexpr bool last = (l == 1);
    ph_row(p, pin(p, I_NFPOST) + l * DM, 10240, last ? nullptr : pin(p, I_NMPRE) + (l + 1) * DM, last ? modl : modl + 5 * 12288, 0, 2048, modl, false);
    } PH_END(B + 10)
}

__global__ void __launch_bounds__(512) mega(P p0) {
  extern __shared__ __attribute__((aligned(16))) char dyn_smem[];
  LAS char* shm = (LAS char*)dyn_smem;
  cg::grid_group grid = cg::this_grid();
  volatile LAS unsigned* xst = (volatile LAS unsigned*)(shm + 139264);
  if (threadIdx.x < 4) xst[threadIdx.x] = 0u;
  __syncthreads();
  XcdBarrier xb = xcd_barrier_post((unsigned*)(p0.ws + O_BAR), xst);
  TSTAMP(0);
  PH_BEGIN(0) for (int rep = 0; rep < NREP(11); ++rep) { ph_init(p, shm, rep); } PH_END(0)
  PH_BEGIN(1) for (int rep = 0; rep < NREP(12); ++rep) { ph_prenorm(p); } PH_END(1)
  layer_phases<0>(p0, grid, xb, shm);
  layer_phases<1>(p0, grid, xb, shm);
#ifdef TPROBE
  PH_BEGIN(NPH) {
#define TFILL(a, o0, o1) do { const unsigned long long* ts = (const unsigned long long*)(p.ws + O_END2); \
    unsigned long long d = ((a) >= 0) ? ts[(a) + 1] - ts[(a)] : ts[NPH - 1] - ts[0]; size_t n = (size_t)(d / 2); if (n > (size_t)(o1) - (o0)) n = (size_t)(o1) - (o0); \
    for (size_t i = (size_t)blockIdx.x * 512 + otid(); i < n; i += (size_t)gridDim.x * 512) ((unsigned*)p.out)[(o0) + i] = 0xAAAAAAAAu; } while (0)
    TFILL(TP0, 0, 16777216); TFILL(TP1, 16777216, OUT_CK); TFILL(TP2, OUT_CK, OUT_CV); TFILL(TP3, OUT_CV, OUT_SSD);
    TFILL(TP4, OUT_SSD, OUT_S5R); TFILL(TP5, OUT_S5R, OUT_S5I); TFILL(TP6, OUT_S5I, 65536000);
  } }
#endif
}

extern "C" void kernel_launch(void* const* d_in, const int* in_sizes, int n_in, void* d_out, int out_size, void* d_ws, size_t ws_size, hipStream_t stream) {
  static int grid_blocks = 0;
  if (!grid_blocks) {
    if (n_in != N_IN || ws_size < O_END3) { fprintf(stderr, "kernel_launch: bad n_in %d or ws %zu < %zu\n", n_in, ws_size, (size_t)O_END); grid_blocks = -1; return; }
    int dev = 0, cus = 0, per_cu = 0;
    hipGetDevice(&dev);
    hipDeviceGetAttribute(&cus, hipDeviceAttributeMultiprocessorCount, dev);
    hipFuncSetAttribute((const void*)mega, hipFuncAttributeMaxDynamicSharedMemorySize, DYN_LDS);
    hipOccupancyMaxActiveBlocksPerMultiprocessor(&per_cu, (const void*)mega, 512, DYN_LDS);
    if (per_cu < 1) per_cu = 1;
    grid_blocks = cus * per_cu;
    if (grid_blocks % 8) grid_blocks -= grid_blocks % 8;
  }
  if (grid_blocks < 0) return;
  hipMemsetAsync((char*)d_ws + O_MOD, 0, 491520 + 16384, stream);
  P p{};
  for (int i = 0; i < N_IN; ++i) p.in[i] = (const float*)d_in[i];
  p.out = (float*)d_out; p.ws = (char*)d_ws;
#if MULTI_LAUNCH
  for (int ph = 0; ph < NPH_RUN; ++ph) {
    p.lo = ph; p.hi = ph + 1;
    hipLaunchKernelGGL(mega, dim3(grid_blocks), dim3(512), DYN_LDS, stream, p);
  }
#else
#ifdef TPROBE
  p.lo = 0; p.hi = NPH + 1;
#else
  p.lo = 0; p.hi = NPH;
#endif
  void* args[] = {&p};
  hipError_t e = hipLaunchCooperativeKernel((const void*)mega, dim3(grid_blocks), dim3(512), args, DYN_LDS, stream);
  if (e != hipSuccess) fprintf(stderr, "cooperative launch failed: %s (grid %d)\n", hipGetErrorString(e), grid_blocks);
#endif
}
```

```cpp
#include <hip/hip_runtime.h>
#include <hip/hip_bf16.h>
#include <hip/hip_cooperative_groups.h>
#include <cstdio>
namespace cg = cooperative_groups;

#ifndef PHMASK
#define PHMASK 0xFFFFu
#endif
#define PHON(b) ((PHMASK >> (b)) & 1u)
#ifndef DUPMASK
#define DUPMASK 0u
#endif
#define NREP(b) (1 + (int)((DUPMASK >> (b)) & 1u))
#ifndef MULTI_LAUNCH
#define MULTI_LAUNCH 0
#endif

typedef unsigned short u16;
using bf16x8 = __attribute__((ext_vector_type(8))) short;
using s16x4 = __attribute__((ext_vector_type(4))) short;
using f32x4 = __attribute__((ext_vector_type(4))) float;
using f32x16 = __attribute__((ext_vector_type(16))) float;
#define DI __device__ __forceinline__
#define LAS __attribute__((address_space(3)))

constexpr int T = 24576, TC = 8192, DM = 2048, NP = 3840, DFF = 5632, DIN = 3608;
constexpr int C_Z = 0, C_X = 768, C_B = 1536, C_C = 1664, C_Q = 1792, C_K = 2560, C_V = 2816, C_U = 3072, C_DT = 3584;
constexpr int NPH = 24;
#ifndef NPH_RUN
#define NPH_RUN NPH
#endif
constexpr int DYN_LDS = 139264 + 16;

constexpr size_t OUT_X = 0, OUT_CK = 50331648, OUT_CV = 54525952, OUT_SSD = 58720256, OUT_S5R = 65011712, OUT_S5I = 65273856;

constexpr size_t O_WIN = 0;
constexpr size_t O_WOUT = O_WIN + 31457280;
constexpr size_t O_WFFI = O_WOUT + 16777216;
constexpr size_t O_WFFO = O_WFFI + 92274688;
constexpr size_t O_WGLU = O_WFFO + 46137344;
constexpr size_t O_MOD = O_WGLU + 1048576;
constexpr size_t O_BAR = O_MOD + 491520;
constexpr size_t O_S5T = O_BAR + 16384;
constexpr size_t O_KC = O_S5T + 1179648;
constexpr size_t O_VCT = O_KC + 2097152;
constexpr size_t O_DT = O_VCT + 2097152;
constexpr size_t O_DTV = O_DT + 3145728;
constexpr size_t O_CDEC = O_DTV + 3145728;
constexpr size_t O_S5S = O_CDEC + 32768;
constexpr size_t O_SST = O_S5S + 6291456;
constexpr size_t O_G5 = O_SST + 75497472;
constexpr size_t O_VT = O_G5 + 25165824;
constexpr size_t O_PROJ = O_VT + 12582912;
constexpr size_t O_MIX = O_PROJ + 188743680;
constexpr size_t O_H = O_MIX + 100663296;
constexpr size_t O_XC = O_H;
constexpr size_t O_YF = O_XC + 50331648;
constexpr size_t O_YB = O_YF + 37748736;
constexpr size_t O_END = O_YB + 37748736;
constexpr size_t O_DTW = O_END;
constexpr size_t O_XCT = O_DTW + 2359296;
constexpr size_t O_END2 = O_XCT + 50331648;
constexpr size_t O_END3 = O_END2 + 4096;
constexpr size_t O_CUM = O_DTV;
constexpr size_t O_Y = O_YF;
constexpr size_t O_S5H = O_YB;
constexpr size_t O_ACT = O_PROJ;
constexpr int S5T_L = 147456;

enum { I_XP = 0, I_XS, I_C, I_CK, I_CV, I_SSD, I_S5R, I_S5I, I_CCTX, I_WADA, I_BADA, I_NMPRE, I_NMPOST, I_NFPRE, I_NFPOST,
       I_WIN, I_WOUT, I_CONVW, I_CONVB, I_DTB, I_ALOG, I_SSDD, I_SSDN, I_SINK, I_ARE, I_AIM, I_LOGDT, I_BRE, I_BIM, I_CRE, I_CIM,
       I_S5D, I_WGLU, I_BGLU, I_WFFI, I_WFFO, N_IN };

struct P {
  const float* in[N_IN];
  float* out;
  char* ws;
  int lo, hi;
  const float* const* inp;
};

DI const float* pin(const P& p, int i) { asm volatile("" : "+s"(i)); return p.inp[i]; }
DI int otid() { int t = threadIdx.x; asm volatile("" : "+v"(t)); return t; }
DI u16 f2bf(float x) { unsigned u = __float_as_uint(x); u += 0x7fffu + ((u >> 16) & 1u); return (u16)(u >> 16); }
DI unsigned cvt_pk_bf16(float a, float b) { unsigned r; asm("v_cvt_pk_bf16_f32 %0, %1, %2" : "=v"(r) : "v"(a), "v"(b)); return r; }
using u32x4 = __attribute__((ext_vector_type(4))) unsigned;
DI bf16x8 pack8(float a0, float a1, float a2, float a3, float a4, float a5, float a6, float a7) {
  u32x4 q;
  asm volatile("v_cvt_pk_bf16_f32 %0, %4, %5\n\tv_cvt_pk_bf16_f32 %1, %6, %7\n\tv_cvt_pk_bf16_f32 %2, %8, %9\n\tv_cvt_pk_bf16_f32 %3, %10, %11\n\ts_nop 1"
               : "=&v"(q[0]), "=&v"(q[1]), "=&v"(q[2]), "=&v"(q[3]) : "v"(a0), "v"(a1), "v"(a2), "v"(a3), "v"(a4), "v"(a5), "v"(a6), "v"(a7));
  return __builtin_bit_cast(bf16x8, q);
}
DI float bf2f(u16 h) { return __uint_as_float(((unsigned)h) << 16); }
DI float bfs(short h) { return __uint_as_float(((unsigned)(u16)h) << 16); }
DI float wsum(float v) { for (int o = 32; o > 0; o >>= 1) v += __shfl_xor(v, o); return v; }
DI float siluf(float x) { return x * __builtin_amdgcn_rcpf(1.f + __expf(-x)); }
DI void sincos_acc(float x, float& sn, float& cs) {
  float n = rintf(x * 0.63661977236758f);
  float r = fmaf(n, -1.5707962513e+0f, x);
  r = fmaf(n, -7.5497899549e-8f, r);
  float r2 = r * r;
  float sp = fmaf(r * r2, fmaf(r2, fmaf(r2, -1.9515295891e-4f, 8.3321608736e-3f), -1.6666654611e-1f), r);
  float cp = fmaf(r2, fmaf(r2, fmaf(r2, fmaf(r2, 2.443315711809948e-5f, -1.388731625493765e-3f), 4.166664568298827e-2f), -0.5f), 1.f);
  int q = ((int)n) & 3;
  sn = (q == 0) ? sp : (q == 1) ? cp : (q == 2) ? -sp : -cp;
  cs = (q == 0) ? cp : (q == 1) ? -sp : (q == 2) ? -cp : sp;
}
DI int crow(int i, int h) { return (i & 3) + 8 * (i >> 2) + 4 * h; }
DI int pi23(int m) { return (m & ~12) | ((m & 4) << 1) | ((m & 8) >> 1); }
DI int modrow(int t) { return t < TC ? 0 : 1 + ((t - TC) >> 12); }
DI void chunk_info(int gc, int& seq, int& c, int& nc) {
  if (gc < 64) { seq = gc >> 1; c = gc & 1; nc = 2; } else { seq = 32 + ((gc - 64) >> 5); c = (gc - 64) & 31; nc = 32; }
}
DI int chunk_of(int seq, int c) { return seq < 32 ? seq * 2 + c : 64 + (seq - 32) * 32 + c; }


#define XB_TMO      128
#define XB_XCNT(j)  (256  + 64 * (j))
#define XB_XSUB(j)  (1280 + 64 * (j))
#define XB_XGEN(j)  (2304 + 64 * (j))
#define XB_TOP      3328
#define XB_TOPGEN   3392
#define XCD_BAR_WORDS 3456
#define XB_SPIN_CAP (1u << 21)
DI unsigned xb_ld(unsigned* p) { return __hip_atomic_load(p, __ATOMIC_RELAXED, __HIP_MEMORY_SCOPE_AGENT); }
DI unsigned xb_add(unsigned* p, unsigned v) { return __hip_atomic_fetch_add(p, v, __ATOMIC_RELAXED, __HIP_MEMORY_SCOPE_AGENT); }
DI unsigned xb_xcc_id() { return (unsigned)__builtin_amdgcn_s_getreg((3 << 11) | 20) & 0xFu; }
#define XB_SPIN(cond, bar) do { unsigned _sp = 0; while (cond) { __builtin_amdgcn_s_sleep(1); \
    if ((++_sp & 255u) == 0u) { if (xb_ld(&(bar)[XB_TMO])) break; if (_sp > XB_SPIN_CAP) { atomicAdd(&(bar)[XB_TMO], 1u); break; } } } } while (0)
struct XcdBarrier { unsigned* bar; unsigned x; volatile LAS unsigned* st; };
DI XcdBarrier xcd_barrier_post(unsigned* bar, volatile LAS unsigned* st) {
  XcdBarrier b; b.bar = bar; b.x = xb_xcc_id(); b.st = st;
  if (threadIdx.x == 0) (void)xb_add(&bar[XB_XCNT(b.x)], 1u);
  return b;
}
DI void xcd_barrier_complete(unsigned* bar, unsigned x, unsigned& nloc, unsigned& nx) {
  const unsigned G = gridDim.x * gridDim.y * gridDim.z;
  unsigned sum, cnt, mine, sp = 0u;
  for (;;) {
    sum = 0u; cnt = 0u; mine = 0u;
#pragma unroll
    for (unsigned j = 0; j < 16; ++j) { const unsigned c = xb_ld(&bar[XB_XCNT(j)]); sum += c; cnt += (c > 0u) ? 1u : 0u; mine = (j == x) ? c : mine; }
    if (sum == G) break;
    __builtin_amdgcn_s_sleep(1);
    if ((++sp & 255u) == 0u) { if (xb_ld(&bar[XB_TMO])) break; if (sp > XB_SPIN_CAP) { atomicAdd(&bar[XB_TMO], 1u); break; } }
  }
  nloc = mine > 0u ? mine : 1u; nx = cnt > 0u ? cnt : 1u;
}
DI void xcd_barrier(const XcdBarrier& b) {
  asm volatile("s_waitcnt vmcnt(0)" ::: "memory");
  __syncthreads();
  if (threadIdx.x == 0) {
    unsigned* bar = b.bar;
    __builtin_amdgcn_s_waitcnt(0);
    unsigned nloc = b.st[0], nx = b.st[1];
    if (nloc == 0u) { xcd_barrier_complete(bar, b.x, nloc, nx); b.st[0] = nloc; b.st[1] = nx; }
    const unsigned old = xb_add(&bar[XB_XSUB(b.x)], 1u);
    const unsigned gen = old / nloc;
    if (old + 1u == (gen + 1u) * nloc) {
      __builtin_amdgcn_fence(__ATOMIC_RELEASE, "agent");
      asm volatile("s_waitcnt vmcnt(0)" ::: "memory");
      const unsigned og = xb_add(&bar[XB_TOP], 1u);
      const unsigned tg = og / nx;
      if (og + 1u == (tg + 1u) * nx) xb_add(&bar[XB_TOPGEN], 1u);
      else XB_SPIN(xb_ld(&bar[XB_TOPGEN]) == tg, bar);
      __builtin_amdgcn_fence(__ATOMIC_ACQUIRE, "agent");
      xb_add(&bar[XB_XGEN(b.x)], 1u);
      asm volatile("s_waitcnt vmcnt(0)" ::: "memory");
    } else {
      XB_SPIN(xb_ld(&bar[XB_XGEN(b.x)]) == gen, bar);
      __builtin_amdgcn_fence(__ATOMIC_ACQUIRE, "agent");
      asm volatile("s_waitcnt vmcnt(0)" ::: "memory");
    }
  }
  __syncthreads();
}

constexpr int BM = 256, BK = 64, HALF = 128, HT = HALF * BK;
DI int lds_byte(int r, int c) {
  int st = (r >> 4) * 2 + (c >> 5), rr = r & 15, cc = c & 31, ob = rr * 64 + cc * 2;
  return st * 1024 + (ob ^ (((ob >> 9) & 1) << 5));
}
DI void stage_rc(int b, int& R, int& C) {
  int st = b / 1024, sb = b % 1024, swz = sb ^ (((sb >> 9) & 1) << 5);
  R = (st >> 1) * 16 + swz / 64; C = (st & 1) * 32 + (swz % 64) / 2;
}

struct EpiProj {
  u16* proj; float* dt; float* out; int l;
  DI void apply(int row0, int col0, int fr, const f32x4& v0, const f32x4& v1) const {
#pragma unroll
    for (int n = 0; n < 2; ++n) {
      const f32x4& v = n ? v1 : v0;
      int col = col0 + n * 16;
      { unsigned a = cvt_pk_bf16(v[0], v[1]), b = cvt_pk_bf16(v[2], v[3]); u16* q = proj + (size_t)row0 * NP + col;
        q[0] = (u16)a; q[NP] = (u16)(a >> 16); q[2 * NP] = (u16)b; q[3 * NP] = (u16)(b >> 16); }
      if (col >= C_DT && col < C_DT + 24) {
#pragma unroll
        for (int j = 0; j < 4; ++j) dt[(size_t)(row0 + j) * 32 + (col - C_DT)] = v[j];
      }
      if (col >= C_K && col < C_U && row0 < TC) {
        float* o = out + (col < C_V ? OUT_CK : OUT_CV);
        int cc = (col - C_K) & 255;
#pragma unroll
        for (int j = 0; j < 4; ++j) { int r = row0 + j; o[(size_t)((r >> 8) * 512 + l * 256 + (r & 255)) * 256 + cc] = v[j]; }
      }
    }
  }
};
struct EpiBf16 {
  u16* dst;
  DI void apply(int row0, int col0, int fr, const f32x4& v0, const f32x4& v1) const {
    unsigned a = cvt_pk_bf16(v0[0], v0[1]), b = cvt_pk_bf16(v0[2], v0[3]), c = cvt_pk_bf16(v1[0], v1[1]), d = cvt_pk_bf16(v1[2], v1[3]);
    u16* q = dst + (size_t)row0 * DM + col0;
    q[0] = (u16)a; q[DM] = (u16)(a >> 16); q[2 * DM] = (u16)b; q[3 * DM] = (u16)(b >> 16);
    q[16] = (u16)c; q[DM + 16] = (u16)(c >> 16); q[2 * DM + 16] = (u16)d; q[3 * DM + 16] = (u16)(d >> 16);
  }
};
struct EpiSwiglu {
  u16* act;
  DI void apply(int row0, int col0, int fr, const f32x4& v0, const f32x4& v1) const {
    int ac = ((col0 - fr) >> 1) + fr;
    unsigned a = cvt_pk_bf16(siluf(v0[0]) * v1[0], siluf(v0[1]) * v1[1]), b = cvt_pk_bf16(siluf(v0[2]) * v1[2], siluf(v0[3]) * v1[3]);
    u16* q = act + (size_t)row0 * DFF + ac;
    q[0] = (u16)a; q[DFF] = (u16)(a >> 16); q[2 * DFF] = (u16)b; q[3 * DFF] = (u16)(b >> 16);
  }
};
struct EpiGlu {
  const u16* g5; const float* b; u16* mix;
  DI void apply(int row0, int col0, int fr, const f32x4& v0, const f32x4& v1) const {
#pragma unroll
    for (int n = 0; n < 2; ++n) {
      const f32x4& v = n ? v1 : v0;
      int col = col0 + n * 16; float bb = b[col];
#pragma unroll
      for (int j = 0; j < 4; ++j) {
        float g = bf2f(g5[(size_t)(row0 + j) * 512 + col]);
        mix[(size_t)(row0 + j) * DM + 1536 + col] = f2bf(g * __builtin_amdgcn_rcpf(1.f + __expf(-(v[j] + bb))));
      }
    }
  }
};

template <class Epi>
__device__ __forceinline__ void gemm_tile(const u16* __restrict__ A, const u16* __restrict__ Bt, int K, int brow, int bcol, const Epi& epi, LAS char* shm, bool prefetched, int nbrow, int nbcol) {
#define SA(b, h) (shm + ((b) * 2 + (h)) * (HT * 2))
#define SB(b, h) (shm + (4 + (b) * 2 + (h)) * (HT * 2))
#define STAGE(Pp, BASE, br, kt) do { const char* _gb = (const char*)(BASE) + ((long)(br) * K + (long)(kt) * BK) * 2; \
    __builtin_amdgcn_global_load_lds((const unsigned*)(_gb + voff0), (LAS unsigned*)((Pp) + ldsw), 16, 0, 0); \
    __builtin_amdgcn_global_load_lds((const unsigned*)(_gb + voff1), (LAS unsigned*)((Pp) + ldsw + 8192), 16, 0, 0); } while (0)
#define LDA(dst, b, h) _Pragma("unroll") for (int m = 0; m < 4; ++m) _Pragma("unroll") for (int k = 0; k < 2; ++k) \
    dst[m][k] = *(const LAS bf16x8*)(SA(b, h) + aoff + m * 2048 + k * 1024)
#define LDB(dst, b, h) _Pragma("unroll") for (int n = 0; n < 2; ++n) _Pragma("unroll") for (int k = 0; k < 2; ++k) \
    dst[n][k] = *(const LAS bf16x8*)(SB(b, h) + boff + n * 2048 + k * 1024)
#define MMA(ai, bj, At_, Bt_) do { __builtin_amdgcn_s_setprio(1); \
    _Pragma("unroll") for (int m = 0; m < 4; ++m) _Pragma("unroll") for (int n = 0; n < 2; ++n) _Pragma("unroll") for (int k = 0; k < 2; ++k) \
      acc[ai][bj][m][n] = __builtin_amdgcn_mfma_f32_16x16x32_bf16(At_[m][k], Bt_[n][k], acc[ai][bj][m][n], 0, 0, 0); \
    __builtin_amdgcn_s_setprio(0); } while (0)
#define WAIT_V(n) asm volatile("s_waitcnt vmcnt(" #n ")" ::: "memory")
#define WAIT_L(n) asm volatile("s_waitcnt lgkmcnt(" #n ")" ::: "memory")
#define BAR __builtin_amdgcn_s_barrier()
#define SCHED __builtin_amdgcn_sched_barrier(0)
  const int tid_ = otid(), wid = __builtin_amdgcn_readfirstlane(tid_ >> 6), lane = tid_ & 63, wr = wid >> 2, wc = wid & 3, fr = lane & 15, fq = lane >> 4;
  const int ldsw = tid_ * 16;
  unsigned voff0, voff1;
  { int r_, c_; stage_rc(ldsw, r_, c_); voff0 = (unsigned)(r_ * K + c_) * 2u; stage_rc(ldsw + 8192, r_, c_); voff1 = (unsigned)(r_ * K + c_) * 2u; }
  const int aoff = lds_byte(wr * 64 + fr, fq * 8), boff = lds_byte(wc * 32 + fr, fq * 8);
  f32x4 acc[2][2][4][2];
#pragma unroll
  for (int a = 0; a < 2; ++a)
#pragma unroll
    for (int b = 0; b < 2; ++b)
#pragma unroll
      for (int m = 0; m < 4; ++m)
#pragma unroll
        for (int n = 0; n < 2; ++n) acc[a][b][m][n] = (f32x4){0.f, 0.f, 0.f, 0.f};
  bf16x8 At[4][2], B0[2][2], B1[2][2];
  const int nt = K / BK;
  if (!prefetched) { STAGE(SB(0, 0), Bt, bcol, 0); STAGE(SA(0, 0), A, brow, 0);
    STAGE(SB(0, 1), Bt, bcol + HALF, 0); STAGE(SA(0, 1), A, brow + HALF, 0); }
  if (wr == 1) BAR;
  WAIT_V(4); BAR;
  STAGE(SB(1, 0), Bt, bcol, 1); STAGE(SA(1, 0), A, brow, 1); STAGE(SB(1, 1), Bt, bcol + HALF, 1);
  WAIT_V(6); BAR;
  for (int t = 0; t < nt - 2; t += 2) {
    LDB(B0, 0, 0); SCHED; LDA(At, 0, 0); STAGE(SA(1, 1), A, brow + HALF, t + 1);
    WAIT_L(8); BAR; WAIT_L(0); MMA(0, 0, At, B0); BAR; SCHED;
    LDB(B1, 0, 1); STAGE(SB(0, 0), Bt, bcol, t + 2);
    BAR; WAIT_L(0); MMA(0, 1, At, B1); BAR;
    LDA(At, 0, 1); STAGE(SA(0, 0), A, brow, t + 2);
    BAR; WAIT_L(0); MMA(1, 0, At, B0); BAR; SCHED;
    STAGE(SB(0, 1), Bt, bcol + HALF, t + 2);
    WAIT_V(6); BAR; MMA(1, 1, At, B1); BAR;
    LDB(B0, 1, 0); SCHED; LDA(At, 1, 0); STAGE(SA(0, 1), A, brow + HALF, t + 2);
    WAIT_L(8); BAR; WAIT_L(0); MMA(0, 0, At, B0); BAR; SCHED;
    LDB(B1, 1, 1); STAGE(SB(1, 0), Bt, bcol, t + 3);
    BAR; WAIT_L(0); MMA(0, 1, At, B1); BAR;
    LDA(At, 1, 1); STAGE(SA(1, 0), A, brow, t + 3);
    BAR; WAIT_L(0); MMA(1, 0, At, B0); BAR; SCHED;
    STAGE(SB(1, 1), Bt, bcol + HALF, t + 3);
    WAIT_V(6); BAR; MMA(1, 1, At, B1); BAR;
  }
  { LDB(B0, 0, 0); LDA(At, 0, 0); STAGE(SA(1, 1), A, brow + HALF, nt - 1);
    BAR; WAIT_L(0); MMA(0, 0, At, B0); BAR;
    LDB(B1, 0, 1); BAR; WAIT_L(0); MMA(0, 1, At, B1); BAR;
    LDA(At, 0, 1); WAIT_V(4); BAR; WAIT_L(0); MMA(1, 0, At, B0); MMA(1, 1, At, B1); BAR; }
  { LDB(B0, 1, 0); LDA(At, 1, 0); WAIT_V(2); BAR; WAIT_L(0); MMA(0, 0, At, B0); BAR;
    LDB(B1, 1, 1); WAIT_V(0); BAR; WAIT_L(0); MMA(0, 1, At, B1); BAR;
    LDA(At, 1, 1); BAR; WAIT_L(0); MMA(1, 0, At, B0); MMA(1, 1, At, B1); BAR; }
  if (wr == 0) BAR;
  if (nbrow >= 0) {
    STAGE(SB(0, 0), Bt, nbcol, 0); STAGE(SA(0, 0), A, nbrow, 0);
    STAGE(SB(0, 1), Bt, nbcol + HALF, 0); STAGE(SA(0, 1), A, nbrow + HALF, 0); }
#pragma unroll
  for (int ai = 0; ai < 2; ++ai)
#pragma unroll
    for (int bj = 0; bj < 2; ++bj)
#pragma unroll
      for (int m = 0; m < 4; ++m)
        epi.apply(brow + ai * HALF + wr * 64 + m * 16 + fq * 4, bcol + bj * HALF + wc * 32 + fr, fr, acc[ai][bj][m][0], acc[ai][bj][m][1]);
#undef SA
#undef SB
#undef STAGE
#undef LDA
#undef LDB
#undef MMA
}

template <class Epi>
__device__ __forceinline__ void gemm_phase(const u16* A, const u16* Bt, int M, int N, int K, const Epi& epi, LAS char* shm, int rot) {
  const int G = gridDim.x;
  int b = ((int)blockIdx.x + G - rot) % G;
  int vb = (G % 8 == 0) ? (b % 8) * (G / 8) + b / 8 : b;
  const int nM = M / BM, nN = N / BM, ntile = nM * nN;
  bool pre = false;
  for (int id = vb; id < ntile; id += G) {
    int nig = 8 * nN, gid = id / nig, fm = gid * 8, gsz = min(nM - fm, 8);
    int pm = fm + ((id % nig) % gsz), pn = (id % nig) / gsz;
    int nbrow = -1, nbcol = 0;
    if (id + G < ntile) { int id2 = id + G, gid2 = id2 / nig, fm2 = gid2 * 8, gsz2 = min(nM - fm2, 8); nbrow = (fm2 + ((id2 % nig) % gsz2)) * BM; nbcol = ((id2 % nig) / gsz2) * BM; }
    gemm_tile(A, Bt, K, pm * BM, pn * BM, epi, shm, pre, nbrow, nbcol);
    pre = nbrow >= 0;
    if (!pre) __syncthreads();
  }
}

DI int colmap(int kind, int n) {
  if (kind == 0) { if (n < 1792) return n; if (n < 3584) return n + 24; if (n < 3608) return n - 3584 + 1792; return -1; }
  if (kind == 2) { int jb = n >> 5, half = (n >> 4) & 1, jj = n & 15; return half * DFF + jb * 16 + jj; }
  return n;
}
DI void conv_tile(const float* __restrict__ src, int K, int N, u16* dst, int kind, int tile, LAS float* lds) {
  const int ntk = K >> 6, nt0 = tile / ntk, kt = tile - nt0 * ntk, n0 = nt0 * 256, k0 = kt * 64, tid = otid();
  { int nn = tid & 63, kr = tid >> 6; int sc[4];
#pragma unroll
    for (int q = 0; q < 4; ++q) sc[q] = colmap(kind, n0 + q * 64 + nn);
#pragma unroll
    for (int i = 0; i < 8; ++i) { int kk = kr + 8 * i;
#pragma unroll
      for (int q = 0; q < 4; ++q) lds[kk * 257 + q * 64 + nn] = sc[q] >= 0 ? src[(size_t)(k0 + kk) * N + sc[q]] : 0.f; } }
  __syncthreads();
#pragma unroll
  for (int j = 0; j < 4; ++j) { int v = tid + 512 * j, nn = v >> 3, kq = v & 7; bf16x8 o;
#pragma unroll
    for (int e = 0; e < 8; ++e) o[e] = (short)f2bf(lds[(kq * 8 + e) * 257 + nn]);
    *(bf16x8*)(dst + (size_t)(n0 + nn) * K + k0 + kq * 8) = o; }
  __syncthreads();
}

DI void ph_init(const P& p, LAS char* shm, int rep) {
  LAS float* lds = (LAS float*)shm;
  const int tid = otid();
  constexpr int N_MOD = 768, N_CV_L = 480 + 256 + 1408 + 704 + 16, N_CV = 2 * N_CV_L, N_TAB = 16, N_CACHE = 4096;
  constexpr int TOTAL = N_MOD + N_CV + N_TAB + N_CACHE;
  for (int it = blockIdx.x + (rep ? N_MOD : 0); it < TOTAL; it += gridDim.x) {
    if (it < N_MOD) {
      int l = it / 384, r = it % 384, jb = r >> 4, ks = r & 15, j = jb * 512 + tid, k0 = ks * 128;
      for (int e = tid; e < 5 * 128; e += 512) { int v = e >> 7, kk = e & 127; float c = v == 0 ? pin(p, I_CCTX)[k0 + kk] : pin(p, I_C)[(v - 1) * DM + k0 + kk]; lds[e] = siluf(c); }
      __syncthreads();
      float a0 = 0, a1 = 0, a2 = 0, a3 = 0, a4 = 0;
      const float* w = pin(p, I_WADA) + ((size_t)l * DM + k0) * 12288 + j;
#pragma unroll 16
      for (int kk = 0; kk < 128; ++kk) { float wv = w[(size_t)kk * 12288]; a0 += lds[kk] * wv; a1 += lds[128 + kk] * wv; a2 += lds[256 + kk] * wv; a3 += lds[384 + kk] * wv; a4 += lds[512 + kk] * wv; }
      float* part = (float*)(p.ws + O_XCT) + ((size_t)((l * 24 + jb) * 16 + ks) * 5) * 512 + tid;
      __hip_atomic_store(part, a0, __ATOMIC_RELAXED, __HIP_MEMORY_SCOPE_AGENT); __hip_atomic_store(part + 512, a1, __ATOMIC_RELAXED, __HIP_MEMORY_SCOPE_AGENT);
      __hip_atomic_store(part + 1024, a2, __ATOMIC_RELAXED, __HIP_MEMORY_SCOPE_AGENT); __hip_atomic_store(part + 1536, a3, __ATOMIC_RELAXED, __HIP_MEMORY_SCOPE_AGENT);
      __hip_atomic_store(part + 2048, a4, __ATOMIC_RELAXED, __HIP_MEMORY_SCOPE_AGENT);
      asm volatile("s_waitcnt vmcnt(0)" ::: "memory");
      __syncthreads();
      LAS unsigned* flag = (LAS unsigned*)(lds + 1024);
      if (tid == 0) { unsigned old = __hip_atomic_fetch_add((unsigned*)(p.ws + O_BAR + 14336) + (l * 24 + jb), 1u, __ATOMIC_RELAXED, __HIP_MEMORY_SCOPE_AGENT); *flag = (old == 15u) ? 1u : 0u; }
      __syncthreads();
      if (*flag) {
        const float bias = pin(p, I_BADA)[l * 12288 + j];
        float s0 = bias, s1 = bias, s2 = bias, s3 = bias, s4 = bias;
        float* pb = (float*)(p.ws + O_XCT) + ((size_t)((l * 24 + jb) * 16) * 5) * 512 + tid;
        for (int k2 = 0; k2 < 16; ++k2) { float* q = pb + (size_t)k2 * 5 * 512;
          s0 += __hip_atomic_load(q, __ATOMIC_RELAXED, __HIP_MEMORY_SCOPE_AGENT); s1 += __hip_atomic_load(q + 512, __ATOMIC_RELAXED, __HIP_MEMORY_SCOPE_AGENT);
          s2 += __hip_atomic_load(q + 1024, __ATOMIC_RELAXED, __HIP_MEMORY_SCOPE_AGENT); s3 += __hip_atomic_load(q + 1536, __ATOMIC_RELAXED, __HIP_MEMORY_SCOPE_AGENT);
          s4 += __hip_atomic_load(q + 2048, __ATOMIC_RELAXED, __HIP_MEMORY_SCOPE_AGENT); }
        float* mod = (float*)(p.ws + O_MOD) + (size_t)l * 5 * 12288 + j;
        mod[0] = s0; mod[12288] = s1; mod[2 * 12288] = s2; mod[3 * 12288] = s3; mod[4 * 12288] = s4;
      }
      __syncthreads();
    } else if (it < N_MOD + N_CV) {
      int r = it - N_MOD, l = r / N_CV_L; r -= l * N_CV_L;
      if (r < 480) conv_tile(pin(p, I_WIN) + (size_t)l * DM * DIN, DM, DIN, (u16*)(p.ws + O_WIN) + (size_t)l * NP * DM, 0, r, lds);
      else if ((r -= 480) < 256) conv_tile(pin(p, I_WOUT) + (size_t)l * DM * DM, DM, DM, (u16*)(p.ws + O_WOUT) + (size_t)l * DM * DM, 1, r, lds);
      else if ((r -= 256) < 1408) conv_tile(pin(p, I_WFFI) + (size_t)l * DM * 2 * DFF, DM, 2 * DFF, (u16*)(p.ws + O_WFFI) + (size_t)l * 2 * DFF * DM, 2, r, lds);
      else if ((r -= 1408) < 704) conv_tile(pin(p, I_WFFO) + (size_t)l * DFF * DM, DFF, DM, (u16*)(p.ws + O_WFFO) + (size_t)l * DM * DFF, 1, r, lds);
      else { r -= 704; conv_tile(pin(p, I_WGLU) + (size_t)l * 512 * 512, 512, 512, (u16*)(p.ws + O_WGLU) + (size_t)l * 512 * 512, 1, r, lds); }
    } else if (it < N_MOD + N_CV + N_TAB) {
      int idx = (it - N_MOD - N_CV) * 512 + tid;
      int l = idx >> 12, d = (idx >> 11) & 1, g = (idx >> 6) & 31, pp = idx & 63;
      int ai = ((l * 2 + d) * 32 + g) * 64 + pp;
      float are = pin(p, I_ARE)[ai], aim = pin(p, I_AIM)[ai];
      float step = __expf(pin(p, I_LOGDT)[(l * 2 + d) * 32 + g]);
      float er = __expf(are * step), sn, cs; sincos_acc(aim * step, sn, cs);
      float lbr = er * cs, lbi = er * sn;
      float qr = lbr, qi = lbi;
      for (int i = 0; i < 6; ++i) { float nr = qr * qr - qi * qi, ni = 2.f * qr * qi; qr = nr; qi = ni; }
      float den = are * are + aim * aim;
      float cr = ((lbr - 1.f) * are + lbi * aim) / den, ci = (lbi * are - (lbr - 1.f) * aim) / den;
      float* tab = (float*)(p.ws + O_S5T) + (size_t)l * S5T_L;
      int e = (d * 32 + g) * 64 + pp;
      tab[e * 2] = lbr; tab[e * 2 + 1] = lbi; tab[8192 + e * 2] = qr; tab[8192 + e * 2 + 1] = qi;
      const float* bre = pin(p, I_BRE) + ((size_t)(l * 32 + g) * 64 + pp) * 16;
      const float* bim = pin(p, I_BIM) + ((size_t)(l * 32 + g) * 64 + pp) * 16;
      u16* bb16 = (u16*)(tab + 16384) + (size_t)(d * 32 + g) * 4 * 32 * 16;
      u16* cc16 = (u16*)(tab + 81920) + (size_t)(d * 32 + g) * 16 * 128;
      const float* cre = pin(p, I_CRE) + (size_t)((l * 2 + d) * 32 + g) * 16 * 64 + pp;
      const float* cim = pin(p, I_CIM) + (size_t)((l * 2 + d) * 32 + g) * 16 * 64 + pp;
      for (int c = 0; c < 16; ++c) {
        float br = bre[c], bi = bim[c];
        bb16[(((pp >> 5)) * 32 + (pp & 31)) * 16 + c] = f2bf(cr * br - ci * bi);
        bb16[((2 + (pp >> 5)) * 32 + (pp & 31)) * 16 + c] = f2bf(cr * bi + ci * br);
        cc16[c * 128 + pp] = f2bf(cre[c * 64]); cc16[c * 128 + 64 + pp] = f2bf(-cim[c * 64]);
      }
    } else {
      int r = it - N_MOD - N_CV - N_TAB;
      if (r < 2048) { int e = r * 512 + tid; int d = e & 63, j = (e >> 6) & 511, kvh = (e >> 15) & 3, b = (e >> 17) & 3, l = e >> 19;
        ((u16*)(p.ws + O_KC))[e] = f2bf(pin(p, I_CK)[((size_t)((b * 2 + l) * 512 + j) * 4 + kvh) * 64 + d]); }
      else { int e = (r - 2048) * 512 + tid; int j = e & 511, d = (e >> 9) & 63, kvh = (e >> 15) & 3, b = (e >> 17) & 3, l = e >> 19;
        ((u16*)(p.ws + O_VCT))[e] = f2bf(pin(p, I_CV)[((size_t)((b * 2 + l) * 512 + j) * 4 + kvh) * 64 + d]); }
    }
  }
}

DI void ph_prenorm(const P& p) {
  const int tid_ = otid(), lane = tid_ & 63, wave = __builtin_amdgcn_readfirstlane(tid_ >> 6);
  const float* mod = (const float*)(p.ws + O_MOD);
  const float* gw = pin(p, I_NMPRE);
  u16* H = (u16*)(p.ws + O_H);
  for (int r = blockIdx.x * 8 + wave; r < T; r += gridDim.x * 8) {
    const float* x = r < TC ? pin(p, I_XP) + (size_t)r * DM : pin(p, I_XS) + (size_t)(r - TC) * DM;
    const float* mr = mod + (size_t)modrow(r) * 12288;
    float4 v[8]; float ss = 0.f;
#pragma unroll
    for (int i = 0; i < 8; ++i) { v[i] = *(const float4*)(x + i * 256 + lane * 4); ss += v[i].x * v[i].x + v[i].y * v[i].y + v[i].z * v[i].z + v[i].w * v[i].w; }
    ss = wsum(ss); float rs = rsqrtf(ss * (1.f / DM) + 1e-6f);
#pragma unroll
    for (int i = 0; i < 8; ++i) {
      int c = i * 256 + lane * 4;
      float4 g = *(const float4*)(gw + c), sh = *(const float4*)(mr + c), sc = *(const float4*)(mr + 2048 + c);
      s16x4 o; o[0] = (short)f2bf(v[i].x * rs * g.x * (1.f + sc.x) + sh.x); o[1] = (short)f2bf(v[i].y * rs * g.y * (1.f + sc.y) + sh.y);
      o[2] = (short)f2bf(v[i].z * rs * g.z * (1.f + sc.z) + sh.z); o[3] = (short)f2bf(v[i].w * rs * g.w * (1.f + sc.w) + sh.w);
      *(s16x4*)(H + (size_t)r * DM + c) = o;
    }
  }
}
constexpr size_t O_XB = O_SST;
template <int XIN, int XOUT>
DI void ph_row(const P& p, const float* wpost, int gate_off, const float* wpre, const float* modn, int sh_off, int sc_off, const float* modg) {
  const int tid_ = otid(), lane = tid_ & 63, wave = __builtin_amdgcn_readfirstlane(tid_ >> 6);
  u16* H = (u16*)(p.ws + O_H);
  u16* XB = (u16*)(p.ws + O_XB);
  const int stride = gridDim.x * 8;
  int r = blockIdx.x * 8 + wave;
  bf16x8 nh[4]; float4 nx[8]; bf16x8 nxb[4];
#define ROW_LOAD(rr) do { const u16* hr_ = H + (size_t)(rr) * DM + lane * 8; \
    _Pragma("unroll") for (int i_ = 0; i_ < 4; ++i_) nh[i_] = *(const bf16x8*)(hr_ + i_ * 512); \
    if (XIN == 2) { const u16* xb_ = XB + (size_t)(rr) * DM + lane * 8; _Pragma("unroll") for (int i_ = 0; i_ < 4; ++i_) nxb[i_] = *(const bf16x8*)(xb_ + i_ * 512); } \
    else { const float* xs_ = (XIN == 1 ? ((rr) < TC ? pin(p, I_XP) + (size_t)(rr) * DM : pin(p, I_XS) + (size_t)((rr) - TC) * DM) : p.out + OUT_X + (size_t)(rr) * DM) + lane * 8; \
      _Pragma("unroll") for (int i_ = 0; i_ < 4; ++i_) { nx[2 * i_] = *(const float4*)(xs_ + i_ * 512); nx[2 * i_ + 1] = *(const float4*)(xs_ + i_ * 512 + 4); } } } while (0)
  if (r < T) ROW_LOAD(r);
  for (; r < T; r += stride) {
    bf16x8 ch[4]; float4 cx[8];
#pragma unroll
    for (int i = 0; i < 4; ++i) {
      ch[i] = nh[i];
      if (XIN == 2) { cx[2 * i] = make_float4(bfs(nxb[i][0]), bfs(nxb[i][1]), bfs(nxb[i][2]), bfs(nxb[i][3])); cx[2 * i + 1] = make_float4(bfs(nxb[i][4]), bfs(nxb[i][5]), bfs(nxb[i][6]), bfs(nxb[i][7])); }
      else { cx[2 * i] = nx[2 * i]; cx[2 * i + 1] = nx[2 * i + 1]; }
    }
    if (r + stride < T) ROW_LOAD(r + stride);
    const int mrow = modrow(r);
    const float* mg = modg + (size_t)mrow * 12288 + gate_off;
    float* xr = p.out + OUT_X + (size_t)r * DM;
    u16* hr = H + (size_t)r * DM;
    float o[32]; float ss = 0.f;
#pragma unroll
    for (int i = 0; i < 4; ++i)
#pragma unroll
      for (int e = 0; e < 8; ++e) { o[i * 8 + e] = bfs(ch[i][e]); ss += o[i * 8 + e] * o[i * 8 + e]; }
    ss = wsum(ss); float rs = rsqrtf(ss * (1.f / DM) + 1e-6f);
    float ss2 = 0.f;
#pragma unroll
    for (int i = 0; i < 4; ++i) {
#pragma unroll
      for (int q = 0; q < 2; ++q) {
        int c = i * 512 + lane * 8 + q * 4;
        float4 xv = cx[2 * i + q], w = *(const float4*)(wpost + c), g = *(const float4*)(mg + c);
        xv.x += g.x * o[i * 8 + q * 4 + 0] * rs * w.x; xv.y += g.y * o[i * 8 + q * 4 + 1] * rs * w.y;
        xv.z += g.z * o[i * 8 + q * 4 + 2] * rs * w.z; xv.w += g.w * o[i * 8 + q * 4 + 3] * rs * w.w;
        if (XOUT == 0) *(float4*)(xr + c) = xv;
        o[i * 8 + q * 4 + 0] = xv.x; o[i * 8 + q * 4 + 1] = xv.y; o[i * 8 + q * 4 + 2] = xv.z; o[i * 8 + q * 4 + 3] = xv.w;
        ss2 += xv.x * xv.x + xv.y * xv.y + xv.z * xv.z + xv.w * xv.w;
      }
      if (XOUT == 1) { const float* oo = &o[i * 8]; *(bf16x8*)(XB + (size_t)r * DM + i * 512 + lane * 8) = pack8(oo[0], oo[1], oo[2], oo[3], oo[4], oo[5], oo[6], oo[7]); }
    }
    if (wpre) {
      ss2 = wsum(ss2); float rs2 = rsqrtf(ss2 * (1.f / DM) + 1e-6f);
      const float* mn = modn + (size_t)mrow * 12288;
#pragma unroll
      for (int i = 0; i < 4; ++i) {
        int c = i * 512 + lane * 8;
        float4 w0 = *(const float4*)(wpre + c), w1 = *(const float4*)(wpre + c + 4), sh0 = *(const float4*)(mn + sh_off + c), sh1 = *(const float4*)(mn + sh_off + c + 4), sc0 = *(const float4*)(mn + sc_off + c), sc1 = *(const float4*)(mn + sc_off + c + 4);
        const float* oo = &o[i * 8];
        bf16x8 v = pack8(oo[0] * rs2 * w0.x * (1.f + sc0.x) + sh0.x, oo[1] * rs2 * w0.y * (1.f + sc0.y) + sh0.y, oo[2] * rs2 * w0.z * (1.f + sc0.z) + sh0.z, oo[3] * rs2 * w0.w * (1.f + sc0.w) + sh0.w,
                         oo[4] * rs2 * w1.x * (1.f + sc1.x) + sh1.x, oo[5] * rs2 * w1.y * (1.f + sc1.y) + sh1.y, oo[6] * rs2 * w1.z * (1.f + sc1.z) + sh1.z, oo[7] * rs2 * w1.w * (1.f + sc1.w) + sh1.w);
        *(bf16x8*)(hr + c) = v;
      }
    }
  }
#undef ROW_LOAD
}

DI void prep_item(const P& p, int l, int it, LAS char* shm) {
  LAS u16* tile = (LAS u16*)shm;
  const int tid = otid(), tb = it >> 4, c0 = (it & 15) * 64, t0 = tb * 64;
  const u16* proj = (const u16*)(p.ws + O_PROJ);
  { const int tt = tid >> 3, ch0 = c0 + (tid & 7) * 8, t = t0 + tt;
    int i, L; if (t < TC) { i = t & 255; L = 256; } else { i = (t - TC) & 4095; L = 4096; }
    const u16* px = proj + (size_t)t * NP + C_X + ch0;
    bf16x8 x1 = *(const bf16x8*)px, x0, x2;
    if (i > 0) x0 = *(const bf16x8*)(px - NP); else x0 = (bf16x8){0, 0, 0, 0, 0, 0, 0, 0};
    if (i < L - 1) x2 = *(const bf16x8*)(px + NP); else x2 = (bf16x8){0, 0, 0, 0, 0, 0, 0, 0};
    const float* cw = pin(p, I_CONVW) + (size_t)l * 3 * 1024 + ch0;
    const float* cb = pin(p, I_CONVB) + (size_t)l * 1024 + ch0;
    bf16x8 o;
#pragma unroll
    for (int e = 0; e < 8; ++e) { float y = cb[e] + cw[e] * bfs(x0[e]) + cw[1024 + e] * bfs(x1[e]) + cw[2048 + e] * bfs(x2[e]); o[e] = (short)f2bf(siluf(y)); }
    *(bf16x8*)((u16*)(p.ws + O_XC) + (size_t)t * 1024 + ch0) = o;
    *(LAS bf16x8*)(tile + tt * 72 + (tid & 7) * 8) = o; }
  __syncthreads();
  { const int cc = tid >> 3, tv = tid & 7; bf16x8 o;
#pragma unroll
    for (int e = 0; e < 8; ++e) o[e] = (short)tile[(tv * 8 + e) * 72 + cc];
    *(bf16x8*)((u16*)(p.ws + O_XCT) + (size_t)(c0 + cc) * T + t0 + tv * 8) = o; }
  __syncthreads();
}
DI void cum_item(const P& p, int l, int gc) {
  const int tid = otid(), lane = tid & 63, wave = __builtin_amdgcn_readfirstlane(tid >> 6), t0 = gc * 128;
  const float* dtr = (const float*)(p.ws + O_DT);
  for (int hd = wave; hd < 24; hd += 8) {
    const float bias = pin(p, I_DTB)[l * 24 + hd], a = -__expf(pin(p, I_ALOG)[l * 24 + hd]);
    float x0 = dtr[(size_t)(t0 + 2 * lane) * 32 + hd] + bias, x1 = dtr[(size_t)(t0 + 2 * lane + 1) * 32 + hd] + bias;
    float d0 = x0 > 15.f ? x0 : __logf(1.f + __expf(x0)), d1 = x1 > 15.f ? x1 : __logf(1.f + __expf(x1));
    float v0 = d0 * a, v1 = d1 * a, ps = v0 + v1, inc = ps;
#pragma unroll
    for (int o = 1; o < 64; o <<= 1) { float y = __shfl_up(inc, o); if (lane >= o) inc += y; }
    float total = __shfl(inc, 63), exc = inc - ps;
    float c0, c1;
    if (hd < 12) { c0 = exc + v0; c1 = inc; } else { c0 = total - exc; c1 = total - exc - v0; }
    float* cum = (float*)(p.ws + O_CUM) + ((size_t)gc * 24 + hd) * 128 + 2 * lane;
    float* dtw = (float*)(p.ws + O_DTW) + ((size_t)gc * 24 + hd) * 128 + 2 * lane;
    *(float2*)cum = make_float2(c0, c1); *(float2*)dtw = make_float2(d0, d1);
    if (lane == 0) ((float*)(p.ws + O_CDEC))[gc * 24 + hd] = __expf(total);
  }
}
DI void rope_item(const P& p, int it) {
  int idx = it * 512 + otid(), j = idx & 31, tl = idx >> 5, t = TC + tl, i = tl & 4095;
  float pos = (j < 16) ? (float)(i >> 6) : (float)(i & 63);
  float inv = __expf(-(float)(j & 15) * (9.210340371976184f / 16.f));
  float sn, cs; sincos_acc(pos * inv, sn, cs);
  u16* row = (u16*)(p.ws + O_PROJ) + (size_t)t * NP;
#pragma unroll 4
  for (int hh = 0; hh < 16; ++hh) {
    int base = (hh < 12 ? C_Q + hh * 64 : C_K + (hh - 12) * 64) + j;
    float x1 = bf2f(row[base]), x2 = bf2f(row[base + 32]);
    row[base] = f2bf(x1 * cs - x2 * sn); row[base + 32] = f2bf(x2 * cs + x1 * sn);
  }
}
DI void vt_item(const P& p, int it, LAS char* shm) {
  LAS u16* tile = (LAS u16*)shm;
  const int tid = otid(), t0 = (it >> 2) * 64, c0 = (it & 3) * 64;
  const u16* proj = (const u16*)(p.ws + O_PROJ);
  { int cc = tid & 63, tr = tid >> 6;
#pragma unroll
    for (int i = 0; i < 8; ++i) tile[(tr + 8 * i) * 66 + cc] = proj[(size_t)(t0 + tr + 8 * i) * NP + C_V + c0 + cc]; }
  __syncthreads();
  { int tt = tid & 63, cr = tid >> 6; u16* vt = (u16*)(p.ws + O_VT);
#pragma unroll
    for (int i = 0; i < 8; ++i) vt[(size_t)(c0 + cr + 8 * i) * T + t0 + tt] = tile[tt * 66 + cr + 8 * i]; }
  __syncthreads();
}
DI int s5_tok(int hh, int stp, int dir) { return hh * 64 + (dir ? 63 - stp : stp); }
#define S5_SCAN_STEP(i) do { float n0r = s0r * lr0 - s0i * li0 + a0[i], n0i = s0r * li0 + s0i * lr0 + a2[i]; s0r = n0r; s0i = n0i; \
    float n1r = s1r * lr1 - s1i * li1 + a1[i], n1i = s1r * li1 + s1i * lr1 + a3[i]; s1r = n1r; s1i = n1i; } while (0)
DI void s5p1_item(const P& p, int l, int it) {
  const int tid_ = otid(), lane = tid_ & 63, wave = __builtin_amdgcn_readfirstlane(tid_ >> 6), r = lane & 31, h = lane >> 5;
  const int gc = it >> 3, g = (it & 7) * 4 + (wave >> 1), dir = wave & 1, t0 = gc * 128;
  const float* tab = (const float*)(p.ws + O_S5T) + (size_t)l * S5T_L;
  const int e0 = (dir * 32 + g) * 64 + r;
  const float lr0 = tab[e0 * 2], li0 = tab[e0 * 2 + 1], lr1 = tab[(e0 + 32) * 2], li1 = tab[(e0 + 32) * 2 + 1];
  const u16* bb16 = (const u16*)(tab + 16384) + (size_t)(dir * 32 + g) * 4 * 32 * 16;
  bf16x8 bop[4];
#pragma unroll
  for (int nt = 0; nt < 4; ++nt) bop[nt] = *(const bf16x8*)(bb16 + (nt * 32 + r) * 16 + 8 * h);
  const u16* up = (const u16*)(p.ws + O_PROJ) + C_U + g * 16 + 8 * h;
  const int mh = (r >> 2) & 1, mi = (r & 3) + 4 * (r >> 3);
  float s0r = 0.f, s0i = 0.f, s1r = 0.f, s1i = 0.f;
  f32x16 zero;
#pragma unroll
  for (int i = 0; i < 16; ++i) zero[i] = 0.f;
#pragma unroll 1
  for (int it4 = 0; it4 < 4; ++it4) {
    bf16x8 af = *(const bf16x8*)(up + (size_t)(t0 + s5_tok(mh, 16 * it4 + mi, dir)) * NP);
    f32x16 a0 = __builtin_amdgcn_mfma_f32_32x32x16_bf16(af, bop[0], zero, 0, 0, 0);
    f32x16 a1 = __builtin_amdgcn_mfma_f32_32x32x16_bf16(af, bop[1], zero, 0, 0, 0);
    f32x16 a2 = __builtin_amdgcn_mfma_f32_32x32x16_bf16(af, bop[2], zero, 0, 0, 0);
    f32x16 a3 = __builtin_amdgcn_mfma_f32_32x32x16_bf16(af, bop[3], zero, 0, 0, 0);
#pragma unroll
    for (int i = 0; i < 16; ++i) S5_SCAN_STEP(i);
  }
  float* sh = (float*)(p.ws + O_S5H) + ((size_t)((2 * gc + h) * 32 + g) * 2 + dir) * 128;
  *(float2*)(sh + r * 2) = make_float2(s0r, s0i); *(float2*)(sh + (32 + r) * 2) = make_float2(s1r, s1i);
}
DI void s5comb_item(const P& p, int l, int it) {
  int idx = it * 512 + otid(), pp = idx & 63, dir = (idx >> 6) & 1, g = (idx >> 7) & 31, seq = idx >> 12;
  const float* tab = (const float*)(p.ws + O_S5T) + (size_t)l * S5T_L;
  int e = (dir * 32 + g) * 64 + pp;
  float qr = tab[8192 + e * 2], qi = tab[8192 + e * 2 + 1];
  float hr = 0.f, hi = 0.f; int nc = 4, hc0 = seq * 4;
  if (seq >= 32) { int b = seq - 32; nc = 64; hc0 = 128 + b * 64; size_t o = (size_t)((b * 2 + l) * 2 + dir) * 2048 + g * 64 + pp; hr = pin(p, I_S5R)[o]; hi = pin(p, I_S5I)[o]; }
  float* s5h = (float*)(p.ws + O_S5H);
#pragma unroll 1
  for (int kb = 0; kb < nc; kb += 16) {
    float2 v[16];
#pragma unroll
    for (int k = 0; k < 16; ++k) if (kb + k < nc) {
      int hc = hc0 + (dir ? nc - 1 - (kb + k) : kb + k);
      v[k] = *(const float2*)(s5h + ((size_t)(hc * 32 + g) * 2 + dir) * 128 + pp * 2); }
#pragma unroll
    for (int k = 0; k < 16; ++k) if (kb + k < nc) {
      int hc = hc0 + (dir ? nc - 1 - (kb + k) : kb + k);
      *(float2*)(s5h + ((size_t)(hc * 32 + g) * 2 + dir) * 128 + pp * 2) = make_float2(hr, hi);
      float nr = hr * qr - hi * qi + v[k].x, ni = hr * qi + hi * qr + v[k].y; hr = nr; hi = ni; }
  }
  if (seq < 32) { size_t o = (size_t)((seq * 2 + l) * 2 + dir) * 2048 + g * 64 + pp; p.out[OUT_S5R + o] = hr; p.out[OUT_S5I + o] = hi; }
}
DI void s5p2_item(const P& p, int l, int it, LAS char* shm) {
  const int tid_ = otid(), lane = tid_ & 63, wave = __builtin_amdgcn_readfirstlane(tid_ >> 6), r = lane & 31, h = lane >> 5;
  const int gc = it >> 2, g = (it & 3) * 8 + wave, t0 = gc * 128;
  LAS u16* HT = (LAS u16*)(shm + wave * 17408);
  LAS float* ybuf = (LAS float*)(shm + wave * 17408 + 8704);
  const float* tab = (const float*)(p.ws + O_S5T) + (size_t)l * S5T_L;
  const u16* up = (const u16*)(p.ws + O_PROJ) + C_U + g * 16;
  const int mh = (r >> 2) & 1, mi = (r & 3) + 4 * (r >> 3);
  const float Dv = pin(p, I_S5D)[l * 512 + g * 16 + (r & 15)];
  f32x16 zero;
#pragma unroll
  for (int i = 0; i < 16; ++i) zero[i] = 0.f;
#pragma unroll 1
  for (int dd = 0; dd < 2; ++dd) {
    const int dir = 1 - dd;
    const int e0 = (dir * 32 + g) * 64 + r;
    const float lr0 = tab[e0 * 2], li0 = tab[e0 * 2 + 1], lr1 = tab[(e0 + 32) * 2], li1 = tab[(e0 + 32) * 2 + 1];
    const u16* bb16 = (const u16*)(tab + 16384) + (size_t)(dir * 32 + g) * 4 * 32 * 16;
    const u16* cc16 = (const u16*)(tab + 81920) + (size_t)(dir * 32 + g) * 16 * 128;
    bf16x8 bop[4], cop[8];
#pragma unroll
    for (int nt = 0; nt < 4; ++nt) bop[nt] = *(const bf16x8*)(bb16 + (nt * 32 + r) * 16 + 8 * h);
#pragma unroll
    for (int ks = 0; ks < 8; ++ks) { if (r < 16) cop[ks] = *(const bf16x8*)(cc16 + r * 128 + ks * 16 + 8 * h); else cop[ks] = (bf16x8){0, 0, 0, 0, 0, 0, 0, 0}; }
    const float* sh = (const float*)(p.ws + O_S5H) + ((size_t)((2 * gc + h) * 32 + g) * 2 + dir) * 128;
    float s0r = sh[r * 2], s0i = sh[r * 2 + 1], s1r = sh[(32 + r) * 2], s1i = sh[(32 + r) * 2 + 1];
#pragma unroll 1
    for (int it4 = 0; it4 < 4; ++it4) {
      bf16x8 af = *(const bf16x8*)(up + 8 * h + (size_t)(t0 + s5_tok(mh, 16 * it4 + mi, dir)) * NP);
      f32x16 a0 = __builtin_amdgcn_mfma_f32_32x32x16_bf16(af, bop[0], zero, 0, 0, 0);
      f32x16 a1 = __builtin_amdgcn_mfma_f32_32x32x16_bf16(af, bop[1], zero, 0, 0, 0);
      f32x16 a2 = __builtin_amdgcn_mfma_f32_32x32x16_bf16(af, bop[2], zero, 0, 0, 0);
      f32x16 a3 = __builtin_amdgcn_mfma_f32_32x32x16_bf16(af, bop[3], zero, 0, 0, 0);
#pragma unroll
      for (int i = 0; i < 16; ++i) { S5_SCAN_STEP(i); a0[i] = s0r; a1[i] = s1r; a2[i] = s0i; a3[i] = s1i; }
#pragma unroll
      for (int i = 0; i < 16; i += 2) {
        LAS u16* row = HT + (16 * h + i) * 136 + r;
        unsigned k0 = cvt_pk_bf16(a0[i], a0[i + 1]), k1 = cvt_pk_bf16(a1[i], a1[i + 1]), k2 = cvt_pk_bf16(a2[i], a2[i + 1]), k3 = cvt_pk_bf16(a3[i], a3[i + 1]);
        row[0] = (u16)k0; row[136] = (u16)(k0 >> 16); row[32] = (u16)k1; row[136 + 32] = (u16)(k1 >> 16);
        row[64] = (u16)k2; row[136 + 64] = (u16)(k2 >> 16); row[96] = (u16)k3; row[136 + 96] = (u16)(k3 >> 16);
      }
      asm volatile("s_waitcnt lgkmcnt(0)" ::: "memory");
      f32x16 y2 = zero;
#pragma unroll
      for (int ks = 0; ks < 8; ++ks) {
        bf16x8 a2f = *(const LAS bf16x8*)(HT + r * 136 + ks * 16 + 8 * h);
        y2 = __builtin_amdgcn_mfma_f32_32x32x16_bf16(a2f, cop[ks], y2, 0, 0, 0);
      }
      if (r < 16) {
#pragma unroll
        for (int i2 = 0; i2 < 16; ++i2) {
          const int m2 = crow(i2, h), tok = s5_tok(m2 >> 4, 16 * it4 + (m2 & 15), dir);
          if (dd == 0) ybuf[tok * 16 + r] = y2[i2];
          else {
            float u = bf2f(up[(size_t)(t0 + tok) * NP + r]);
            float y = ybuf[tok * 16 + r] + y2[i2] + Dv * u;
            float gl = y / (1.f + __expf(-1.5957691216057308f * (y + 0.044715f * y * y * y)));
            ((u16*)(p.ws + O_G5))[(size_t)(t0 + tok) * 512 + g * 16 + r] = f2bf(gl);
          }
        }
      }
      asm volatile("s_waitcnt lgkmcnt(0)" ::: "memory");
    }
  }
}
DI void ssd_p1_item(const P& p, int l, int it, LAS char* shm) {
  const int tid = otid(), lane = tid & 63, wave = __builtin_amdgcn_readfirstlane(tid >> 6), r = lane & 31, h = lane >> 5;
  const int gc = it / 3, rr = it - gc * 3, t0 = gc * 128, hd = rr * 8 + wave, dir = hd / 12, head = hd - dir * 12, g = head / 6;
  LAS float* wb = (LAS float*)(shm + wave * 512);
  const float* cum = (const float*)(p.ws + O_CUM) + ((size_t)gc * 24 + hd) * 128;
  const float* dtw = (const float*)(p.ws + O_DTW) + ((size_t)gc * 24 + hd) * 128;
  const float total = dir ? cum[0] : cum[127];
  wb[lane] = dtw[lane] * __expf(total - cum[lane]); wb[lane + 64] = dtw[lane + 64] * __expf(total - cum[lane + 64]);
  asm volatile("s_waitcnt lgkmcnt(0)" ::: "memory");
  const u16* xct = (const u16*)(p.ws + O_XCT);
  const u16* xa0 = xct + (size_t)(head * 64 + r) * T + t0 + 8 * h;
  const u16* xa1 = xa0 + (size_t)32 * T;
  const u16* xb0 = xct + (size_t)(768 + g * 64 + r) * T + t0 + 8 * h;
  const u16* xb1 = xb0 + (size_t)32 * T;
  f32x16 a00, a01, a10, a11;
#pragma unroll
  for (int i = 0; i < 16; ++i) { a00[i] = 0.f; a01[i] = 0.f; a10[i] = 0.f; a11[i] = 0.f; }
#pragma unroll 2
  for (int ks = 0; ks < 8; ++ks) {
    bf16x8 r0 = *(const bf16x8*)(xa0 + ks * 16), r1 = *(const bf16x8*)(xa1 + ks * 16);
    bf16x8 b0 = *(const bf16x8*)(xb0 + ks * 16), b1 = *(const bf16x8*)(xb1 + ks * 16);
    f32x4 w0 = *(const LAS f32x4*)(wb + ks * 16 + 8 * h), w1 = *(const LAS f32x4*)(wb + ks * 16 + 8 * h + 4);
    bf16x8 f0, f1;
#pragma unroll
    for (int j = 0; j < 8; ++j) { float w = j < 4 ? w0[j & 3] : w1[j & 3]; f0[j] = (short)f2bf(bfs(r0[j]) * w); f1[j] = (short)f2bf(bfs(r1[j]) * w); }
    a00 = __builtin_amdgcn_mfma_f32_32x32x16_bf16(f0, b0, a00, 0, 0, 0);
    a01 = __builtin_amdgcn_mfma_f32_32x32x16_bf16(f0, b1, a01, 0, 0, 0);
    a10 = __builtin_amdgcn_mfma_f32_32x32x16_bf16(f1, b0, a10, 0, 0, 0);
    a11 = __builtin_amdgcn_mfma_f32_32x32x16_bf16(f1, b1, a11, 0, 0, 0);
  }
  float* sst = (float*)(p.ws + O_SST) + ((size_t)(gc * 2 + dir) * 12 + head) * 4096;
#pragma unroll
  for (int i = 0; i < 16; ++i) {
    int pr = crow(i, h);
    sst[pr * 64 + r] = a00[i]; sst[pr * 64 + 32 + r] = a01[i]; sst[(32 + pr) * 64 + r] = a10[i]; sst[(32 + pr) * 64 + 32 + r] = a11[i];
  }
  asm volatile("s_waitcnt lgkmcnt(0)" ::: "memory");
}
DI void ssd_p2_item(const P& p, int l, int it, LAS char* shm) {
  const int tid = otid(), lane = tid & 63, wave = __builtin_amdgcn_readfirstlane(tid >> 6), r = lane & 31, h = lane >> 5;
  const int task = it * 8 + wave, lb = task & 3, head = (task >> 2) % 12, gc = task / 48, g = head / 6, t0 = gc * 128;
  LAS float* lf = (LAS float*)(shm + wave * 2048);
  { const float* cumf = (const float*)(p.ws + O_CUM) + ((size_t)gc * 24 + head) * 128;
    const float* dtf = (const float*)(p.ws + O_DTW) + ((size_t)gc * 24 + head) * 128;
    lf[lane] = cumf[lane]; lf[64 + lane] = cumf[64 + lane]; lf[128 + lane] = cumf[12 * 128 + lane]; lf[192 + lane] = cumf[12 * 128 + 64 + lane];
    lf[256 + lane] = dtf[lane]; lf[320 + lane] = dtf[64 + lane]; lf[384 + lane] = dtf[12 * 128 + lane]; lf[448 + lane] = dtf[12 * 128 + 64 + lane]; }
  asm volatile("s_waitcnt lgkmcnt(0)" ::: "memory");
  const int lq = lb * 32 + r;
  const float cfl = lf[lq], cbl = lf[128 + lq];
  const float Dh = pin(p, I_SSDD)[l * 12 + head];
  const u16* xc = (const u16*)(p.ws + O_XC);
  bf16x8 cq[4];
  { const u16* crowp = xc + (size_t)(t0 + lq) * 1024 + 896 + g * 64 + 8 * h;
#pragma unroll
    for (int ks = 0; ks < 4; ++ks) cq[ks] = *(const bf16x8*)(crowp + ks * 16); }
  f32x16 o0, o1;
#pragma unroll
  for (int i = 0; i < 16; ++i) { o0[i] = 0.f; o1[i] = 0.f; }
#pragma unroll
  for (int dir = 0; dir < 2; ++dir) {
    const float* hs = (const float*)(p.ws + O_SST) + ((size_t)(gc * 2 + dir) * 12 + head) * 4096;
    f32x16 u0, u1;
#pragma unroll
    for (int i = 0; i < 16; ++i) { u0[i] = 0.f; u1[i] = 0.f; }
#pragma unroll
    for (int ks = 0; ks < 4; ++ks) {
      const float* h0 = hs + (size_t)r * 64 + ks * 16 + 8 * h; const float* h1 = h0 + 32 * 64;
      float4 x0 = *(const float4*)h0, x1 = *(const float4*)(h0 + 4), y0 = *(const float4*)h1, y1 = *(const float4*)(h1 + 4);
      bf16x8 fa = pack8(x0.x, x0.y, x0.z, x0.w, x1.x, x1.y, x1.z, x1.w), fb = pack8(y0.x, y0.y, y0.z, y0.w, y1.x, y1.y, y1.z, y1.w);
      u0 = __builtin_amdgcn_mfma_f32_32x32x16_bf16(fa, cq[ks], u0, 0, 0, 0);
      u1 = __builtin_amdgcn_mfma_f32_32x32x16_bf16(fb, cq[ks], u1, 0, 0, 0);
    }
    const float sc = __expf(dir ? cbl : cfl);
#pragma unroll
    for (int i = 0; i < 16; ++i) { o0[i] += sc * u0[i]; o1[i] += sc * u1[i]; }
  }
  const u16* xct = (const u16*)(p.ws + O_XCT);
  const u16* vrow0 = xct + (size_t)(head * 64 + r) * T + t0 + 8 * h;
  const u16* vrow1 = vrow0 + (size_t)32 * T;
  const u16* brow = xc + (size_t)(t0 + pi23(r)) * 1024 + 768 + g * 64 + 8 * h;
#pragma unroll 1
  for (int st = 0; st < 4; ++st) {
    f32x16 sg;
#pragma unroll
    for (int i = 0; i < 16; ++i) sg[i] = 0.f;
#pragma unroll
    for (int ks = 0; ks < 4; ++ks) {
      bf16x8 kf = *(const bf16x8*)(brow + (size_t)st * 32 * 1024 + ks * 16);
      sg = __builtin_amdgcn_mfma_f32_32x32x16_bf16(kf, cq[ks], sg, 0, 0, 0);
    }
#pragma unroll
    for (int q = 0; q < 4; ++q) {
      const int sb = st * 32 + 16 * (q >> 1) + 8 * h + 4 * (q & 1);
      f32x4 cf4 = *(const LAS f32x4*)(lf + sb), cb4 = *(const LAS f32x4*)(lf + 128 + sb), df4 = *(const LAS f32x4*)(lf + 256 + sb), db4 = *(const LAS f32x4*)(lf + 384 + sb);
#pragma unroll
      for (int e = 0; e < 4; ++e) {
        const int si = sb + e;
        float wf = (si <= lq) ? df4[e] * __expf(fminf(cfl - cf4[e], 0.f)) : 0.f;
        float wbk = (si >= lq) ? db4[e] * __expf(fminf(cbl - cb4[e], 0.f)) : 0.f;
        float v = sg[q * 4 + e] * (wf + wbk);
        if (si == lq) v += Dh;
        sg[q * 4 + e] = v;
      }
    }
#pragma unroll
    for (int sp = 0; sp < 2; ++sp) {
      bf16x8 pf = pack8(sg[8 * sp], sg[8 * sp + 1], sg[8 * sp + 2], sg[8 * sp + 3], sg[8 * sp + 4], sg[8 * sp + 5], sg[8 * sp + 6], sg[8 * sp + 7]);
      bf16x8 va = *(const bf16x8*)(vrow0 + st * 32 + 16 * sp), vb = *(const bf16x8*)(vrow1 + st * 32 + 16 * sp);
      o0 = __builtin_amdgcn_mfma_f32_32x32x16_bf16(va, pf, o0, 0, 0, 0);
      o1 = __builtin_amdgcn_mfma_f32_32x32x16_bf16(vb, pf, o1, 0, 0, 0);
    }
  }
  u16* yrow = (u16*)(p.ws + O_Y) + (size_t)(t0 + lq) * 768 + head * 64;
#pragma unroll
  for (int gq = 0; gq < 4; ++gq) {
    s16x4 a, bq;
#pragma unroll
    for (int e = 0; e < 4; ++e) { a[e] = (short)f2bf(o0[gq * 4 + e]); bq[e] = (short)f2bf(o1[gq * 4 + e]); }
    *(s16x4*)(yrow + 8 * gq + 4 * h) = a; *(s16x4*)(yrow + 32 + 8 * gq + 4 * h) = bq;
  }
  asm volatile("s_waitcnt lgkmcnt(0)" ::: "memory");
}
DI void ssdcomb_item(const P& p, int l, int it) {
  int idx = it * 512 + otid();
  int pn = idx & 4095, hd = (idx >> 12) % 24, seq = idx / (24 * 4096), dir = hd / 12, head = hd - dir * 12;
  float hs = 0.f; int nc = 2;
  if (seq >= 32) { nc = 32; hs = pin(p, I_SSD)[((size_t)(((seq - 32) * 2 + l) * 2 + dir) * 12 + head) * 4096 + pn]; }
  float* sst = (float*)(p.ws + O_SST); const float* cdec = (const float*)(p.ws + O_CDEC);
#pragma unroll 1
  for (int kb = 0; kb < nc; kb += 16) {
    float v[16], dc[16];
#pragma unroll
    for (int k = 0; k < 16; ++k) if (kb + k < nc) {
      int c = dir ? nc - 1 - (kb + k) : kb + k, gc = chunk_of(seq, c); size_t o = ((size_t)(gc * 2 + dir) * 12 + head);
      v[k] = sst[o * 4096 + pn]; dc[k] = cdec[o]; }
#pragma unroll
    for (int k = 0; k < 16; ++k) if (kb + k < nc) {
      int c = dir ? nc - 1 - (kb + k) : kb + k, gc = chunk_of(seq, c); size_t o = ((size_t)(gc * 2 + dir) * 12 + head);
      sst[o * 4096 + pn] = hs; hs = hs * dc[k] + v[k]; }
  }
  if (seq < 32) p.out[OUT_SSD + ((size_t)((seq * 2 + l) * 2 + dir) * 12 + head) * 4096 + pn] = hs;
}
DI void ph_ssdfinal(const P& p, int l) {
  const int tid_ = otid(), lane = tid_ & 63, wave = __builtin_amdgcn_readfirstlane(tid_ >> 6);
  const u16* proj = (const u16*)(p.ws + O_PROJ);
  const u16* yf = (const u16*)(p.ws + O_Y);
  u16* mix = (u16*)(p.ws + O_MIX);
  for (int r = blockIdx.x * 8 + wave; r < T; r += gridDim.x * 8) {
    float y[12]; float ss = 0.f;
#pragma unroll
    for (int i = 0; i < 3; ++i) {
      int c = i * 256 + lane * 4;
      s16x4 a = *(const s16x4*)(yf + (size_t)r * 768 + c);
      s16x4 z = *(const s16x4*)(proj + (size_t)r * NP + C_Z + c);
#pragma unroll
      for (int e = 0; e < 4; ++e) { float v = bfs(a[e]) * siluf(bfs(z[e])); y[i * 4 + e] = v; ss += v * v; }
    }
    ss = wsum(ss); float rs = rsqrtf(ss * (1.f / 768.f) + 1e-6f);
#pragma unroll
    for (int i = 0; i < 3; ++i) {
      int c = i * 256 + lane * 4;
      float4 w = *(const float4*)(pin(p, I_SSDN) + l * 768 + c);
      s16x4 o; o[0] = (short)f2bf(y[i * 4] * rs * w.x); o[1] = (short)f2bf(y[i * 4 + 1] * rs * w.y); o[2] = (short)f2bf(y[i * 4 + 2] * rs * w.z); o[3] = (short)f2bf(y[i * 4 + 3] * rs * w.w);
      *(s16x4*)(mix + (size_t)r * DM + c) = o;
    }
  }
}
struct AttState { float m, lsum; f32x16 o0, o1; };
struct AttKV { bf16x8 k[4]; bf16x8 v[4]; };

constexpr int ATT_KS = 72, ATT_VS = 264, ATT_VOFF = 256 * ATT_KS;
DI void attn_load_lds(AttKV& t, const LAS u16* sk, const LAS u16* sv, int j, int r, int h) {
  const LAS u16* kp = sk + (j * 32 + pi23(r)) * ATT_KS + 8 * h;
#pragma unroll
  for (int ks = 0; ks < 4; ++ks) t.k[ks] = *(const LAS bf16x8*)(kp + ks * 16);
  const LAS u16* vp = sv + r * ATT_VS + j * 32 + 8 * h;
#pragma unroll
  for (int sp = 0; sp < 2; ++sp) { t.v[sp * 2 + 0] = *(const LAS bf16x8*)(vp + 16 * sp); t.v[sp * 2 + 1] = *(const LAS bf16x8*)(vp + 32 * ATT_VS + 16 * sp); }
}
DI void attn_compute(AttState& st, const bf16x8 (&qf)[4], const AttKV& t, bool mask, int h, int qi, int k0) {
  f32x16 s;
#pragma unroll
  for (int i = 0; i < 16; ++i) s[i] = 0.f;
#pragma unroll
  for (int ks = 0; ks < 4; ++ks) s = __builtin_amdgcn_mfma_f32_32x32x16_bf16(t.k[ks], qf[ks], s, 0, 0, 0);
  float mt = -1e30f;
#pragma unroll
  for (int i = 0; i < 16; ++i) {
    float v = s[i] * 0.125f;
    if (mask) { int d = qi - (k0 + pi23(crow(i, h))); if (d > 128 || d < -128) v = -1e30f; }
    s[i] = v; mt = fmaxf(mt, v);
  }
  mt = fmaxf(mt, __shfl_xor(mt, 32));
  float mn = fmaxf(st.m, mt), alpha = __expf(st.m - mn);
  st.m = mn;
  float ps = 0.f;
#pragma unroll
  for (int i = 0; i < 16; ++i) { float e = __expf(s[i] - mn); s[i] = e; ps += e; }
  st.lsum = st.lsum * alpha + ps;
#pragma unroll
  for (int i = 0; i < 16; ++i) { st.o0[i] *= alpha; st.o1[i] *= alpha; }
#pragma unroll
  for (int sp = 0; sp < 2; ++sp) {
    bf16x8 pf = pack8(s[8 * sp], s[8 * sp + 1], s[8 * sp + 2], s[8 * sp + 3], s[8 * sp + 4], s[8 * sp + 5], s[8 * sp + 6], s[8 * sp + 7]);
    st.o0 = __builtin_amdgcn_mfma_f32_32x32x16_bf16(t.v[sp * 2 + 0], pf, st.o0, 0, 0, 0);
    st.o1 = __builtin_amdgcn_mfma_f32_32x32x16_bf16(t.v[sp * 2 + 1], pf, st.o1, 0, 0, 0);
  }
}
DI void attn_item(const P& p, int l, int item, LAS char* shm) {
  const int tid_ = otid(), lane = tid_ & 63, wave = __builtin_amdgcn_readfirstlane(tid_ >> 6), r = lane & 31, h = lane >> 5;
  int seq, head, q0b, b = 0; bool lat;
  if (item < 768) { lat = true; b = item / 192; head = (item >> 4) % 12; q0b = (item & 15) * 256; seq = 32 + b; }
  else { int it2 = item - 768; lat = false; seq = it2 / 12; head = it2 % 12; q0b = 0; }
  const int q0 = q0b + wave * 32, kvh = head / 3, L = lat ? 4096 : 256;
  const int seqstart = seq < 32 ? seq * 256 : TC + (seq - 32) * 4096;
  const u16* proj = (const u16*)(p.ws + O_PROJ);
  bf16x8 qf[4];
  { const u16* qrow = proj + (size_t)(seqstart + q0 + r) * NP + C_Q + head * 64;
#pragma unroll
    for (int ks = 0; ks < 4; ++ks) qf[ks] = *(const bf16x8*)(qrow + ks * 16 + 8 * h); }
  AttState st; st.m = pin(p, I_SINK)[l * 12 + head]; st.lsum = h == 0 ? 1.f : 0.f;
#pragma unroll
  for (int i = 0; i < 16; ++i) { st.o0[i] = 0.f; st.o1[i] = 0.f; }
  const u16* kself = proj + (size_t)seqstart * NP + C_K + kvh * 64;
  const u16* vself = (const u16*)(p.ws + O_VT) + (size_t)(kvh * 64) * T + seqstart;
  const u16* kc = (const u16*)(p.ws + O_KC) + (size_t)((l * 4 + b) * 4 + kvh) * 512 * 64;
  const u16* vc = (const u16*)(p.ws + O_VCT) + (size_t)((l * 4 + b) * 4 + kvh) * 64 * 512;
  LAS u16* sk = (LAS u16*)shm; LAS u16* sv = sk + ATT_VOFF;
  const int ns = lat ? 4 : 1, kb0 = lat ? q0b - 128 : 0, qi = q0 + r;
  const int krow = tid_ >> 1, khalf = tid_ & 1, vd = tid_ >> 3, vseg = tid_ & 7;
  bf16x8 kreg[4], vreg[4];
#define ATT_STAGE_LOAD(s_) do { const int s__ = (s_); \
    if (lat && s__ < 2) { const u16* kp_ = kc + (size_t)(s__ * 256 + krow) * 64 + khalf * 32; const u16* vp_ = vc + (size_t)vd * 512 + s__ * 256 + vseg * 32; \
      _Pragma("unroll") for (int q_ = 0; q_ < 4; ++q_) { kreg[q_] = *(const bf16x8*)(kp_ + q_ * 8); vreg[q_] = *(const bf16x8*)(vp_ + q_ * 8); } } \
    else { const int kb_ = kb0 + 256 * (lat ? s__ - 2 : 0); const int key_ = kb_ + krow, vk_ = kb_ + vseg * 32; \
      if (key_ >= 0 && key_ < L) { const u16* kp_ = kself + (size_t)key_ * NP + khalf * 32; _Pragma("unroll") for (int q_ = 0; q_ < 4; ++q_) kreg[q_] = *(const bf16x8*)(kp_ + q_ * 8); } \
      if (vk_ >= 0 && vk_ < L) { const u16* vp_ = vself + (size_t)vd * T + vk_; _Pragma("unroll") for (int q_ = 0; q_ < 4; ++q_) vreg[q_] = *(const bf16x8*)(vp_ + q_ * 8); } } } while (0)
  ATT_STAGE_LOAD(0);
#pragma unroll 1
  for (int s = 0; s < ns; ++s) {
    __syncthreads();
#pragma unroll
    for (int q = 0; q < 4; ++q) { *(LAS bf16x8*)(sk + krow * ATT_KS + khalf * 32 + q * 8) = kreg[q]; *(LAS bf16x8*)(sv + vd * ATT_VS + vseg * 32 + q * 8) = vreg[q]; }
    __syncthreads();
    if (s + 1 < ns) ATT_STAGE_LOAD(s + 1);
    const bool band = lat && s >= 2;
    const int kb = band ? kb0 + 256 * (s - 2) : 0;
    int j0 = 0, j1 = 8;
    if (band) { int lo = max(max(0, q0 - 128), kb), hi = min(min(4096, q0 + 160), kb + 256); j0 = (lo - kb) >> 5; j1 = (hi - kb) >> 5; if (j1 < j0) j1 = j0; }
    AttKV ta, tb;
    if (j0 < j1) attn_load_lds(ta, sk, sv, j0, r, h);
#pragma unroll 1
    for (int j = j0; j < j1; j += 2) {
      if (j + 1 < j1) attn_load_lds(tb, sk, sv, j + 1, r, h);
      attn_compute(st, qf, ta, band, h, qi, kb + 32 * j);
      if (j + 1 < j1) {
        if (j + 2 < j1) attn_load_lds(ta, sk, sv, j + 2, r, h);
        attn_compute(st, qf, tb, band, h, qi, kb + 32 * (j + 1));
      }
    }
  }
#undef ATT_STAGE_LOAD
  float lt = st.lsum + __shfl_xor(st.lsum, 32), inv = 1.f / lt;
  u16* orow = (u16*)(p.ws + O_MIX) + (size_t)(seqstart + q0 + r) * DM + 768 + head * 64;
#pragma unroll
  for (int gq = 0; gq < 4; ++gq) {
    s16x4 a, bq;
#pragma unroll
    for (int e = 0; e < 4; ++e) { a[e] = (short)f2bf(st.o0[gq * 4 + e] * inv); bq[e] = (short)f2bf(st.o1[gq * 4 + e] * inv); }
    *(s16x4*)(orow + 8 * gq + 4 * h) = a; *(s16x4*)(orow + 32 + 8 * gq + 4 * h) = bq;
  }
  __syncthreads();
}

#ifdef TPROBE
#define TSTAMP(k) do { if (blockIdx.x == 0 && otid() == 0) ((unsigned long long*)(p0.ws + O_END2))[(k)] = wall_clock64(); } while (0)
#else
#define TSTAMP(k) do { } while (0)
#endif
#define PH_BEGIN(k) if (p0.lo <= (k) && (k) < p0.hi) { P p; p.inp = p0.in; p.out = p0.out; p.ws = p0.ws; p.lo = p0.lo; p.hi = p0.hi; \
    asm volatile("" : "+s"(p.out), "+s"(p.ws)); const int G = gridDim.x, bid = blockIdx.x; (void)G; (void)bid;
#define PH_END(k) if ((k) + 1 < p0.hi) { if ((k) == 0) grid.sync(); else xcd_barrier(xb); } TSTAMP((k) + 1); }

template <int l>
DI void layer_phases(const P& p0, cg::grid_group& grid, const XcdBarrier& xb, LAS char* shm) {
  constexpr int B = 2 + 11 * l;
  PH_BEGIN(B + 0) for (int rep = 0; rep < NREP(0); ++rep) { EpiProj e{(u16*)(p.ws + O_PROJ), (float*)(p.ws + O_DT), p.out, l};
    gemm_phase((const u16*)(p.ws + O_H), (const u16*)(p.ws + O_WIN) + (size_t)l * NP * DM, T, NP, DM, e, shm, 0); } PH_END(B + 0)
  PH_BEGIN(B + 1) for (int rep = 0; rep < NREP(1); ++rep) {
    constexpr int N0 = 1536, N1 = N0 + 6144, N2 = N1 + 1024, N3 = N2 + 1536, N4 = N3 + 192;
    for (int it = bid; it < N4; it += G) {
      if (it < N0) s5p1_item(p, l, it); else if (it < N1) prep_item(p, l, it - N0, shm); else if (it < N2) { if (rep == 0) rope_item(p, it - N1); } else if (it < N3) vt_item(p, it - N2, shm); else cum_item(p, l, it - N3);
    } } PH_END(B + 1)
  PH_BEGIN(B + 2) for (int rep = 0; rep < NREP(2); ++rep) {
    constexpr int N0 = 576, N1 = N0 + 768 + 384, N2 = N1 + 288;
    for (int it = bid; it < N2; it += G) {
      if (it < N0) ssd_p1_item(p, l, it, shm); else if (it < N1) attn_item(p, l, it - N0, shm); else if (rep == 0) s5comb_item(p, l, it - N1);
    } } PH_END(B + 2)
  PH_BEGIN(B + 3) for (int rep = 0; rep < NREP(3); ++rep) {
    constexpr int N0 = 768, N1 = N0 + 6912;
    for (int it = bid; it < N1; it += G) { if (it < N0) s5p2_item(p, l, it, shm); else if (rep == 0) ssdcomb_item(p, l, it - N0); }
    } PH_END(B + 3)
  PH_BEGIN(B + 4) for (int rep = 0; rep < NREP(4); ++rep) {
    for (int it = bid; it < 1152; it += G) ssd_p2_item(p, l, it, shm);
    __syncthreads();
    EpiGlu e{(const u16*)(p.ws + O_G5), pin(p, I_BGLU) + l * 512, (u16*)(p.ws + O_MIX)};
    gemm_phase((const u16*)(p.ws + O_G5), (const u16*)(p.ws + O_WGLU) + (size_t)l * 512 * 512, T, 512, 512, e, shm, 64);
    } PH_END(B + 4)
  PH_BEGIN(B + 5) for (int rep = 0; rep < NREP(5); ++rep) { ph_ssdfinal(p, l); } PH_END(B + 5)
  PH_BEGIN(B + 6) for (int rep = 0; rep < NREP(6); ++rep) { EpiBf16 e{(u16*)(p.ws + O_H)};
    gemm_phase((const u16*)(p.ws + O_MIX), (const u16*)(p.ws + O_WOUT) + (size_t)l * DM * DM, T, DM, DM, e, shm, 0); } PH_END(B + 6)
  PH_BEGIN(B + 7) { const float* modl = (const float*)(p.ws + O_MOD) + (size_t)l * 5 * 12288;
    ph_row<(l == 0 ? 1 : 0), 1>(p, pin(p, I_NMPOST) + l * DM, 4096, pin(p, I_NFPRE) + l * DM, modl, 6144, 8192, modl); } PH_END(B + 7)
  PH_BEGIN(B + 8) for (int rep = 0; rep < NREP(8); ++rep) { EpiSwiglu e{(u16*)(p.ws + O_ACT)};
    gemm_phase((const u16*)(p.ws + O_H), (const u16*)(p.ws + O_WFFI) + (size_t)l * 2 * DFF * DM, T, 2 * DFF, DM, e, shm, 0); } PH_END(B + 8)
  PH_BEGIN(B + 9) for (int rep = 0; rep < NREP(9); ++rep) { EpiBf16 e{(u16*)(p.ws + O_H)};
    gemm_phase((const u16*)(p.ws + O_ACT), (const u16*)(p.ws + O_WFFO) + (size_t)l * DM * DFF, T, DM, DFF, e, shm, 0); } PH_END(B + 9)
  PH_BEGIN(B + 10) { const float* modl = (const float*)(p.ws + O_MOD) + (size_t)l * 5 * 12288;
    constexpr bool last = (l == 1);
    ph_row<2, 0>(p, pin(p, I_NFPOST) + l * DM, 10240, last ? nullptr : pin(p, I_NMPRE) + (l + 1) * DM, last ? modl : modl + 5 * 12288, 0, 2048, modl);
    } PH_END(B + 10)
}

__global__ void __launch_bounds__(512) mega(P p0) {
  extern __shared__ __attribute__((aligned(16))) char dyn_smem[];
  LAS char* shm = (LAS char*)dyn_smem;
  cg::grid_group grid = cg::this_grid();
  volatile LAS unsigned* xst = (volatile LAS unsigned*)(shm + 139264);
  if (threadIdx.x < 4) xst[threadIdx.x] = 0u;
  __syncthreads();
  XcdBarrier xb = xcd_barrier_post((unsigned*)(p0.ws + O_BAR), xst);
  TSTAMP(0);
  PH_BEGIN(0) for (int rep = 0; rep < NREP(11); ++rep) { ph_init(p, shm, rep); } PH_END(0)
  PH_BEGIN(1) for (int rep = 0; rep < NREP(12); ++rep) { ph_prenorm(p); } PH_END(1)
  layer_phases<0>(p0, grid, xb, shm);
  layer_phases<1>(p0, grid, xb, shm);
#ifdef TPROBE
  PH_BEGIN(NPH) {
#define TFILL(a, o0, o1) do { const unsigned long long* ts = (const unsigned long long*)(p.ws + O_END2); \
    unsigned long long d = ((a) >= 0) ? ts[(a) + 1] - ts[(a)] : ts[NPH - 1] - ts[0]; size_t n = (size_t)(d / 2); if (n > (size_t)(o1) - (o0)) n = (size_t)(o1) - (o0); \
    for (size_t i = (size_t)blockIdx.x * 512 + otid(); i < n; i += (size_t)gridDim.x * 512) ((unsigned*)p.out)[(o0) + i] = 0xAAAAAAAAu; } while (0)
    TFILL(TP0, 0, 16777216); TFILL(TP1, 16777216, OUT_CK); TFILL(TP2, OUT_CK, OUT_CV); TFILL(TP3, OUT_CV, OUT_SSD);
    TFILL(TP4, OUT_SSD, OUT_S5R); TFILL(TP5, OUT_S5R, OUT_S5I); TFILL(TP6, OUT_S5I, 65536000);
  } }
#endif
}

extern "C" void kernel_launch(void* const* d_in, const int* in_sizes, int n_in, void* d_out, int out_size, void* d_ws, size_t ws_size, hipStream_t stream) {
  static int grid_blocks = 0;
  if (!grid_blocks) {
    if (n_in != N_IN || ws_size < O_END3) { fprintf(stderr, "kernel_launch: bad n_in %d or ws %zu < %zu\n", n_in, ws_size, (size_t)O_END); grid_blocks = -1; return; }
    int dev = 0, cus = 0, per_cu = 0;
    hipGetDevice(&dev);
    hipDeviceGetAttribute(&cus, hipDeviceAttributeMultiprocessorCount, dev);
    hipFuncSetAttribute((const void*)mega, hipFuncAttributeMaxDynamicSharedMemorySize, DYN_LDS);
    hipOccupancyMaxActiveBlocksPerMultiprocessor(&per_cu, (const void*)mega, 512, DYN_LDS);
    if (per_cu < 1) per_cu = 1;
    grid_blocks = cus * per_cu;
    if (grid_blocks % 8) grid_blocks -= grid_blocks % 8;
  }
  if (grid_blocks < 0) return;
  hipMemsetAsync((char*)d_ws + O_MOD, 0, 491520 + 16384, stream);
  P p{};
  for (int i = 0; i < N_IN; ++i) p.in[i] = (const float*)d_in[i];
  p.out = (float*)d_out; p.ws = (char*)d_ws;
#if MULTI_LAUNCH
  for (int ph = 0; ph < NPH_RUN; ++ph) {
    p.lo = ph; p.hi = ph + 1;
    hipLaunchKernelGGL(mega, dim3(grid_blocks), dim3(512), DYN_LDS, stream, p);
  }
#else
#ifdef TPROBE
  p.lo = 0; p.hi = NPH + 1;
#else
  p.lo = 0; p.hi = NPH;
#endif
  void* args[] = {&p};
  hipError_t e = hipLaunchCooperativeKernel((const void*)mega, dim3(grid_blocks), dim3(512), args, DYN_LDS, stream);
  if (e != hipSuccess) fprintf(stderr, "cooperative launch failed: %s (grid %d)\n", hipGetErrorString(e), grid_blocks);
#endif
}
```

```cpp
#include <hip/hip_runtime.h>
#include <hip/hip_bf16.h>
#include <hip/hip_cooperative_groups.h>
#include <cstdio>
namespace cg = cooperative_groups;

#ifndef PHMASK
#define PHMASK 0xFFFFu
#endif
#define PHON(b) ((PHMASK >> (b)) & 1u)
#ifndef DUPMASK
#define DUPMASK 0u
#endif
#define NREP(b) (1 + (int)((DUPMASK >> (b)) & 1u))
#ifndef MULTI_LAUNCH
#define MULTI_LAUNCH 0
#endif

typedef unsigned short u16;
using bf16x8 = __attribute__((ext_vector_type(8))) short;
using s16x4 = __attribute__((ext_vector_type(4))) short;
using f32x4 = __attribute__((ext_vector_type(4))) float;
using f32x16 = __attribute__((ext_vector_type(16))) float;
#define DI __device__ __forceinline__
#define LAS __attribute__((address_space(3)))

constexpr int T = 24576, TC = 8192, DM = 2048, NP = 3840, DFF = 5632, DIN = 3608;
constexpr int C_Z = 0, C_X = 768, C_B = 1536, C_C = 1664, C_Q = 1792, C_K = 2560, C_V = 2816, C_U = 3072, C_DT = 3584;
constexpr int NPH = 24;
#ifndef NPH_RUN
#define NPH_RUN NPH
#endif
constexpr int DYN_LDS = 139264 + 16;

constexpr size_t OUT_X = 0, OUT_CK = 50331648, OUT_CV = 54525952, OUT_SSD = 58720256, OUT_S5R = 65011712, OUT_S5I = 65273856;

constexpr size_t O_WIN = 0;
constexpr size_t O_WOUT = O_WIN + 31457280;
constexpr size_t O_WFFI = O_WOUT + 16777216;
constexpr size_t O_WFFO = O_WFFI + 92274688;
constexpr size_t O_WGLU = O_WFFO + 46137344;
constexpr size_t O_MOD = O_WGLU + 1048576;
constexpr size_t O_BAR = O_MOD + 491520;
constexpr size_t O_S5T = O_BAR + 16384;
constexpr size_t O_KC = O_S5T + 1179648;
constexpr size_t O_VCT = O_KC + 2097152;
constexpr size_t O_DT = O_VCT + 2097152;
constexpr size_t O_DTV = O_DT + 3145728;
constexpr size_t O_CDEC = O_DTV + 3145728;
constexpr size_t O_S5S = O_CDEC + 32768;
constexpr size_t O_SST = O_S5S + 6291456;
constexpr size_t O_G5 = O_SST + 75497472;
constexpr size_t O_VT = O_G5 + 25165824;
constexpr size_t O_PROJ = O_VT + 12582912;
constexpr size_t O_MIX = O_PROJ + 188743680;
constexpr size_t O_H = O_MIX + 100663296;
constexpr size_t O_XC = O_H;
constexpr size_t O_YF = O_XC + 50331648;
constexpr size_t O_YB = O_YF + 37748736;
constexpr size_t O_END = O_YB + 37748736;
constexpr size_t O_DTW = O_END;
constexpr size_t O_XCT = O_DTW + 2359296;
constexpr size_t O_END2 = O_XCT + 50331648;
constexpr size_t O_END3 = O_END2 + 4096;
constexpr size_t O_CUM = O_DTV;
constexpr size_t O_Y = O_YF;
constexpr size_t O_S5H = O_YB;
constexpr size_t O_ACT = O_PROJ;
constexpr int S5T_L = 147456;

enum { I_XP = 0, I_XS, I_C, I_CK, I_CV, I_SSD, I_S5R, I_S5I, I_CCTX, I_WADA, I_BADA, I_NMPRE, I_NMPOST, I_NFPRE, I_NFPOST,
       I_WIN, I_WOUT, I_CONVW, I_CONVB, I_DTB, I_ALOG, I_SSDD, I_SSDN, I_SINK, I_ARE, I_AIM, I_LOGDT, I_BRE, I_BIM, I_CRE, I_CIM,
       I_S5D, I_WGLU, I_BGLU, I_WFFI, I_WFFO, N_IN };

struct P {
  const float* in[N_IN];
  float* out;
  char* ws;
  int lo, hi;
  const float* const* inp;
};

DI const float* pin(const P& p, int i) { asm volatile("" : "+s"(i)); return p.inp[i]; }
DI int otid() { int t = threadIdx.x; asm volatile("" : "+v"(t)); return t; }
DI u16 f2bf(float x) { unsigned u = __float_as_uint(x); u += 0x7fffu + ((u >> 16) & 1u); return (u16)(u >> 16); }
DI unsigned cvt_pk_bf16(float a, float b) { unsigned r; asm("v_cvt_pk_bf16_f32 %0, %1, %2" : "=v"(r) : "v"(a), "v"(b)); return r; }
using u32x4 = __attribute__((ext_vector_type(4))) unsigned;
DI bf16x8 pack8(float a0, float a1, float a2, float a3, float a4, float a5, float a6, float a7) {
  u32x4 q;
  asm volatile("v_cvt_pk_bf16_f32 %0, %4, %5\n\tv_cvt_pk_bf16_f32 %1, %6, %7\n\tv_cvt_pk_bf16_f32 %2, %8, %9\n\tv_cvt_pk_bf16_f32 %3, %10, %11\n\ts_nop 1"
               : "=&v"(q[0]), "=&v"(q[1]), "=&v"(q[2]), "=&v"(q[3]) : "v"(a0), "v"(a1), "v"(a2), "v"(a3), "v"(a4), "v"(a5), "v"(a6), "v"(a7));
  return __builtin_bit_cast(bf16x8, q);
}
DI float bf2f(u16 h) { return __uint_as_float(((unsigned)h) << 16); }
DI float bfs(short h) { return __uint_as_float(((unsigned)(u16)h) << 16); }
DI float wsum(float v) { for (int o = 32; o > 0; o >>= 1) v += __shfl_xor(v, o); return v; }
DI float siluf(float x) { return x * __builtin_amdgcn_rcpf(1.f + __expf(-x)); }
DI void sincos_acc(float x, float& sn, float& cs) {
  float n = rintf(x * 0.63661977236758f);
  float r = fmaf(n, -1.5707962513e+0f, x);
  r = fmaf(n, -7.5497899549e-8f, r);
  float r2 = r * r;
  float sp = fmaf(r * r2, fmaf(r2, fmaf(r2, -1.9515295891e-4f, 8.3321608736e-3f), -1.6666654611e-1f), r);
  float cp = fmaf(r2, fmaf(r2, fmaf(r2, fmaf(r2, 2.443315711809948e-5f, -1.388731625493765e-3f), 4.166664568298827e-2f), -0.5f), 1.f);
  int q = ((int)n) & 3;
  sn = (q == 0) ? sp : (q == 1) ? cp : (q == 2) ? -sp : -cp;
  cs = (q == 0) ? cp : (q == 1) ? -sp : (q == 2) ? -cp : sp;
}
DI int crow(int i, int h) { return (i & 3) + 8 * (i >> 2) + 4 * h; }
DI int pi23(int m) { return (m & ~12) | ((m & 4) << 1) | ((m & 8) >> 1); }
DI int modrow(int t) { return t < TC ? 0 : 1 + ((t - TC) >> 12); }
DI void chunk_info(int gc, int& seq, int& c, int& nc) {
  if (gc < 64) { seq = gc >> 1; c = gc & 1; nc = 2; } else { seq = 32 + ((gc - 64) >> 5); c = (gc - 64) & 31; nc = 32; }
}
DI int chunk_of(int seq, int c) { return seq < 32 ? seq * 2 + c : 64 + (seq - 32) * 32 + c; }


#define XB_TMO      128
#define XB_XCNT(j)  (256  + 64 * (j))
#define XB_XSUB(j)  (1280 + 64 * (j))
#define XB_XGEN(j)  (2304 + 64 * (j))
#define XB_TOP      3328
#define XB_TOPGEN   3392
#define XCD_BAR_WORDS 3456
#define XB_SPIN_CAP (1u << 21)
DI unsigned xb_ld(unsigned* p) { return __hip_atomic_load(p, __ATOMIC_RELAXED, __HIP_MEMORY_SCOPE_AGENT); }
DI unsigned xb_add(unsigned* p, unsigned v) { return __hip_atomic_fetch_add(p, v, __ATOMIC_RELAXED, __HIP_MEMORY_SCOPE_AGENT); }
DI unsigned xb_xcc_id() { return (unsigned)__builtin_amdgcn_s_getreg((3 << 11) | 20) & 0xFu; }
#define XB_SPIN(cond, bar) do { unsigned _sp = 0; while (cond) { __builtin_amdgcn_s_sleep(1); \
    if ((++_sp & 255u) == 0u) { if (xb_ld(&(bar)[XB_TMO])) break; if (_sp > XB_SPIN_CAP) { atomicAdd(&(bar)[XB_TMO], 1u); break; } } } } while (0)
struct XcdBarrier { unsigned* bar; unsigned x; volatile LAS unsigned* st; };
DI XcdBarrier xcd_barrier_post(unsigned* bar, volatile LAS unsigned* st) {
  XcdBarrier b; b.bar = bar; b.x = xb_xcc_id(); b.st = st;
  if (threadIdx.x == 0) (void)xb_add(&bar[XB_XCNT(b.x)], 1u);
  return b;
}
DI void xcd_barrier_complete(unsigned* bar, unsigned x, unsigned& nloc, unsigned& nx) {
  const unsigned G = gridDim.x * gridDim.y * gridDim.z;
  unsigned sum, cnt, mine, sp = 0u;
  for (;;) {
    sum = 0u; cnt = 0u; mine = 0u;
#pragma unroll
    for (unsigned j = 0; j < 16; ++j) { const unsigned c = xb_ld(&bar[XB_XCNT(j)]); sum += c; cnt += (c > 0u) ? 1u : 0u; mine = (j == x) ? c : mine; }
    if (sum == G) break;
    __builtin_amdgcn_s_sleep(1);
    if ((++sp & 255u) == 0u) { if (xb_ld(&bar[XB_TMO])) break; if (sp > XB_SPIN_CAP) { atomicAdd(&bar[XB_TMO], 1u); break; } }
  }
  nloc = mine > 0u ? mine : 1u; nx = cnt > 0u ? cnt : 1u;
}
DI void xcd_barrier(const XcdBarrier& b) {
  asm volatile("s_waitcnt vmcnt(0)" ::: "memory");
  __syncthreads();
  if (threadIdx.x == 0) {
    unsigned* bar = b.bar;
    __builtin_amdgcn_s_waitcnt(0);
    unsigned nloc = b.st[0], nx = b.st[1];
    if (nloc == 0u) { xcd_barrier_complete(bar, b.x, nloc, nx); b.st[0] = nloc; b.st[1] = nx; }
    const unsigned old = xb_add(&bar[XB_XSUB(b.x)], 1u);
    const unsigned gen = old / nloc;
    if (old + 1u == (gen + 1u) * nloc) {
      __builtin_amdgcn_fence(__ATOMIC_RELEASE, "agent");
      asm volatile("s_waitcnt vmcnt(0)" ::: "memory");
      const unsigned og = xb_add(&bar[XB_TOP], 1u);
      const unsigned tg = og / nx;
      if (og + 1u == (tg + 1u) * nx) xb_add(&bar[XB_TOPGEN], 1u);
      else XB_SPIN(xb_ld(&bar[XB_TOPGEN]) == tg, bar);
      __builtin_amdgcn_fence(__ATOMIC_ACQUIRE, "agent");
      xb_add(&bar[XB_XGEN(b.x)], 1u);
      asm volatile("s_waitcnt vmcnt(0)" ::: "memory");
    } else {
      XB_SPIN(xb_ld(&bar[XB_XGEN(b.x)]) == gen, bar);
      __builtin_amdgcn_fence(__ATOMIC_ACQUIRE, "agent");
      asm volatile("s_waitcnt vmcnt(0)" ::: "memory");
    }
  }
  __syncthreads();
}

constexpr int BM = 256, BK = 64, HALF = 128, HT = HALF * BK;
DI int lds_byte(int r, int c) {
  int st = (r >> 4) * 2 + (c >> 5), rr = r & 15, cc = c & 31, ob = rr * 64 + cc * 2;
  return st * 1024 + (ob ^ (((ob >> 9) & 1) << 5));
}
DI void stage_rc(int b, int& R, int& C) {
  int st = b / 1024, sb = b % 1024, swz = sb ^ (((sb >> 9) & 1) << 5);
  R = (st >> 1) * 16 + swz / 64; C = (st & 1) * 32 + (swz % 64) / 2;
}

struct EpiProj {
  u16* proj; float* dt; float* out; int l;
  DI void apply(int row0, int col0, int fr, const f32x4& v0, const f32x4& v1) const {
#pragma unroll
    for (int n = 0; n < 2; ++n) {
      const f32x4& v = n ? v1 : v0;
      int col = col0 + n * 16;
      { unsigned a = cvt_pk_bf16(v[0], v[1]), b = cvt_pk_bf16(v[2], v[3]); u16* q = proj + (size_t)row0 * NP + col;
        q[0] = (u16)a; q[NP] = (u16)(a >> 16); q[2 * NP] = (u16)b; q[3 * NP] = (u16)(b >> 16); }
      if (col >= C_DT && col < C_DT + 24) {
#pragma unroll
        for (int j = 0; j < 4; ++j) dt[(size_t)(row0 + j) * 32 + (col - C_DT)] = v[j];
      }
      if (col >= C_K && col < C_U && row0 < TC) {
        float* o = out + (col < C_V ? OUT_CK : OUT_CV);
        int cc = (col - C_K) & 255;
#pragma unroll
        for (int j = 0; j < 4; ++j) { int r = row0 + j; o[(size_t)((r >> 8) * 512 + l * 256 + (r & 255)) * 256 + cc] = v[j]; }
      }
    }
  }
};
struct EpiBf16 {
  u16* dst;
  DI void apply(int row0, int col0, int fr, const f32x4& v0, const f32x4& v1) const {
    unsigned a = cvt_pk_bf16(v0[0], v0[1]), b = cvt_pk_bf16(v0[2], v0[3]), c = cvt_pk_bf16(v1[0], v1[1]), d = cvt_pk_bf16(v1[2], v1[3]);
    u16* q = dst + (size_t)row0 * DM + col0;
    q[0] = (u16)a; q[DM] = (u16)(a >> 16); q[2 * DM] = (u16)b; q[3 * DM] = (u16)(b >> 16);
    q[16] = (u16)c; q[DM + 16] = (u16)(c >> 16); q[2 * DM + 16] = (u16)d; q[3 * DM + 16] = (u16)(d >> 16);
  }
};
struct EpiSwiglu {
  u16* act;
  DI void apply(int row0, int col0, int fr, const f32x4& v0, const f32x4& v1) const {
    int ac = ((col0 - fr) >> 1) + fr;
    unsigned a = cvt_pk_bf16(siluf(v0[0]) * v1[0], siluf(v0[1]) * v1[1]), b = cvt_pk_bf16(siluf(v0[2]) * v1[2], siluf(v0[3]) * v1[3]);
    u16* q = act + (size_t)row0 * DFF + ac;
    q[0] = (u16)a; q[DFF] = (u16)(a >> 16); q[2 * DFF] = (u16)b; q[3 * DFF] = (u16)(b >> 16);
  }
};
struct EpiGlu {
  const u16* g5; const float* b; u16* mix;
  DI void apply(int row0, int col0, int fr, const f32x4& v0, const f32x4& v1) const {
#pragma unroll
    for (int n = 0; n < 2; ++n) {
      const f32x4& v = n ? v1 : v0;
      int col = col0 + n * 16; float bb = b[col];
#pragma unroll
      for (int j = 0; j < 4; ++j) {
        float g = bf2f(g5[(size_t)(row0 + j) * 512 + col]);
        mix[(size_t)(row0 + j) * DM + 1536 + col] = f2bf(g * __builtin_amdgcn_rcpf(1.f + __expf(-(v[j] + bb))));
      }
    }
  }
};

template <class Epi>
__device__ __forceinline__ void gemm_tile(const u16* __restrict__ A, const u16* __restrict__ Bt, int K, int brow, int bcol, const Epi& epi, LAS char* shm, bool prefetched, int nbrow, int nbcol) {
#define SA(b, h) (shm + ((b) * 2 + (h)) * (HT * 2))
#define SB(b, h) (shm + (4 + (b) * 2 + (h)) * (HT * 2))
#define STAGE(Pp, BASE, br, kt) do { const char* _gb = (const char*)(BASE) + ((long)(br) * K + (long)(kt) * BK) * 2; \
    __builtin_amdgcn_global_load_lds((const unsigned*)(_gb + voff0), (LAS unsigned*)((Pp) + ldsw), 16, 0, 0); \
    __builtin_amdgcn_global_load_lds((const unsigned*)(_gb + voff1), (LAS unsigned*)((Pp) + ldsw + 8192), 16, 0, 0); } while (0)
#define LDA(dst, b, h) _Pragma("unroll") for (int m = 0; m < 4; ++m) _Pragma("unroll") for (int k = 0; k < 2; ++k) \
    dst[m][k] = *(const LAS bf16x8*)(SA(b, h) + aoff + m * 2048 + k * 1024)
#define LDB(dst, b, h) _Pragma("unroll") for (int n = 0; n < 2; ++n) _Pragma("unroll") for (int k = 0; k < 2; ++k) \
    dst[n][k] = *(const LAS bf16x8*)(SB(b, h) + boff + n * 2048 + k * 1024)
#define MMA(ai, bj, At_, Bt_) do { __builtin_amdgcn_s_setprio(1); \
    _Pragma("unroll") for (int m = 0; m < 4; ++m) _Pragma("unroll") for (int n = 0; n < 2; ++n) _Pragma("unroll") for (int k = 0; k < 2; ++k) \
      acc[ai][bj][m][n] = __builtin_amdgcn_mfma_f32_16x16x32_bf16(At_[m][k], Bt_[n][k], acc[ai][bj][m][n], 0, 0, 0); \
    __builtin_amdgcn_s_setprio(0); } while (0)
#define WAIT_V(n) asm volatile("s_waitcnt vmcnt(" #n ")" ::: "memory")
#define WAIT_L(n) asm volatile("s_waitcnt lgkmcnt(" #n ")" ::: "memory")
#define BAR __builtin_amdgcn_s_barrier()
#define SCHED __builtin_amdgcn_sched_barrier(0)
  const int tid_ = otid(), wid = __builtin_amdgcn_readfirstlane(tid_ >> 6), lane = tid_ & 63, wr = wid >> 2, wc = wid & 3, fr = lane & 15, fq = lane >> 4;
  const int ldsw = tid_ * 16;
  unsigned voff0, voff1;
  { int r_, c_; stage_rc(ldsw, r_, c_); voff0 = (unsigned)(r_ * K + c_) * 2u; stage_rc(ldsw + 8192, r_, c_); voff1 = (unsigned)(r_ * K + c_) * 2u; }
  const int aoff = lds_byte(wr * 64 + fr, fq * 8), boff = lds_byte(wc * 32 + fr, fq * 8);
  f32x4 acc[2][2][4][2];
#pragma unroll
  for (int a = 0; a < 2; ++a)
#pragma unroll
    for (int b = 0; b < 2; ++b)
#pragma unroll
      for (int m = 0; m < 4; ++m)
#pragma unroll
        for (int n = 0; n < 2; ++n) acc[a][b][m][n] = (f32x4){0.f, 0.f, 0.f, 0.f};
  bf16x8 At[4][2], B0[2][2], B1[2][2];
  const int nt = K / BK;
  if (!prefetched) { STAGE(SB(0, 0), Bt, bcol, 0); STAGE(SA(0, 0), A, brow, 0);
    STAGE(SB(0, 1), Bt, bcol + HALF, 0); STAGE(SA(0, 1), A, brow + HALF, 0); }
  if (wr == 1) BAR;
  WAIT_V(4); BAR;
  STAGE(SB(1, 0), Bt, bcol, 1); STAGE(SA(1, 0), A, brow, 1); STAGE(SB(1, 1), Bt, bcol + HALF, 1);
  WAIT_V(6); BAR;
  for (int t = 0; t < nt - 2; t += 2) {
    LDB(B0, 0, 0); SCHED; LDA(At, 0, 0); STAGE(SA(1, 1), A, brow + HALF, t + 1);
    WAIT_L(8); BAR; WAIT_L(0); MMA(0, 0, At, B0); BAR; SCHED;
    LDB(B1, 0, 1); STAGE(SB(0, 0), Bt, bcol, t + 2);
    BAR; WAIT_L(0); MMA(0, 1, At, B1); BAR;
    LDA(At, 0, 1); STAGE(SA(0, 0), A, brow, t + 2);
    BAR; WAIT_L(0); MMA(1, 0, At, B0); BAR; SCHED;
    STAGE(SB(0, 1), Bt, bcol + HALF, t + 2);
    WAIT_V(6); BAR; MMA(1, 1, At, B1); BAR;
    LDB(B0, 1, 0); SCHED; LDA(At, 1, 0); STAGE(SA(0, 1), A, brow + HALF, t + 2);
    WAIT_L(8); BAR; WAIT_L(0); MMA(0, 0, At, B0); BAR; SCHED;
    LDB(B1, 1, 1); STAGE(SB(1, 0), Bt, bcol, t + 3);
    BAR; WAIT_L(0); MMA(0, 1, At, B1); BAR;
    LDA(At, 1, 1); STAGE(SA(1, 0), A, brow, t + 3);
    BAR; WAIT_L(0); MMA(1, 0, At, B0); BAR; SCHED;
    STAGE(SB(1, 1), Bt, bcol + HALF, t + 3);
    WAIT_V(6); BAR; MMA(1, 1, At, B1); BAR;
  }
  { LDB(B0, 0, 0); LDA(At, 0, 0); STAGE(SA(1, 1), A, brow + HALF, nt - 1);
    BAR; WAIT_L(0); MMA(0, 0, At, B0); BAR;
    LDB(B1, 0, 1); BAR; WAIT_L(0); MMA(0, 1, At, B1); BAR;
    LDA(At, 0, 1); WAIT_V(4); BAR; WAIT_L(0); MMA(1, 0, At, B0); MMA(1, 1, At, B1); BAR; }
  { LDB(B0, 1, 0); LDA(At, 1, 0); WAIT_V(2); BAR; WAIT_L(0); MMA(0, 0, At, B0); BAR;
    LDB(B1, 1, 1); WAIT_V(0); BAR; WAIT_L(0); MMA(0, 1, At, B1); BAR;
    LDA(At, 1, 1); BAR; WAIT_L(0); MMA(1, 0, At, B0); MMA(1, 1, At, B1); BAR; }
  if (wr == 0) BAR;
  if (nbrow >= 0) {
    STAGE(SB(0, 0), Bt, nbcol, 0); STAGE(SA(0, 0), A, nbrow, 0);
    STAGE(SB(0, 1), Bt, nbcol + HALF, 0); STAGE(SA(0, 1), A, nbrow + HALF, 0); }
#pragma unroll
  for (int ai = 0; ai < 2; ++ai)
#pragma unroll
    for (int bj = 0; bj < 2; ++bj)
#pragma unroll
      for (int m = 0; m < 4; ++m)
        epi.apply(brow + ai * HALF + wr * 64 + m * 16 + fq * 4, bcol + bj * HALF + wc * 32 + fr, fr, acc[ai][bj][m][0], acc[ai][bj][m][1]);
#undef SA
#undef SB
#undef STAGE
#undef LDA
#undef LDB
#undef MMA
}

template <class Epi>
__device__ __forceinline__ void gemm_phase(const u16* A, const u16* Bt, int M, int N, int K, const Epi& epi, LAS char* shm, int rot) {
  const int G = gridDim.x;
  int b = ((int)blockIdx.x + G - rot) % G;
  int vb = (G % 8 == 0) ? (b % 8) * (G / 8) + b / 8 : b;
  const int nM = M / BM, nN = N / BM, ntile = nM * nN;
  bool pre = false;
  for (int id = vb; id < ntile; id += G) {
    int nig = 8 * nN, gid = id / nig, fm = gid * 8, gsz = min(nM - fm, 8);
    int pm = fm + ((id % nig) % gsz), pn = (id % nig) / gsz;
    int nbrow = -1, nbcol = 0;
    if (id + G < ntile) { int id2 = id + G, gid2 = id2 / nig, fm2 = gid2 * 8, gsz2 = min(nM - fm2, 8); nbrow = (fm2 + ((id2 % nig) % gsz2)) * BM; nbcol = ((id2 % nig) / gsz2) * BM; }
    gemm_tile(A, Bt, K, pm * BM, pn * BM, epi, shm, pre, nbrow, nbcol);
    pre = nbrow >= 0;
    if (!pre) __syncthreads();
  }
}

DI int colmap(int kind, int n) {
  if (kind == 0) { if (n < 1792) return n; if (n < 3584) return n + 24; if (n < 3608) return n - 3584 + 1792; return -1; }
  if (kind == 2) { int jb = n >> 5, half = (n >> 4) & 1, jj = n & 15; return half * DFF + jb * 16 + jj; }
  return n;
}
DI void conv_tile(const float* __restrict__ src, int K, int N, u16* dst, int kind, int tile, LAS float* lds) {
  const int ntk = K >> 6, nt0 = tile / ntk, kt = tile - nt0 * ntk, n0 = nt0 * 256, k0 = kt * 64, tid = otid();
  { int nn = tid & 63, kr = tid >> 6; int sc[4];
#pragma unroll
    for (int q = 0; q < 4; ++q) sc[q] = colmap(kind, n0 + q * 64 + nn);
#pragma unroll
    for (int i = 0; i < 8; ++i) { int kk = kr + 8 * i;
#pragma unroll
      for (int q = 0; q < 4; ++q) lds[kk * 257 + q * 64 + nn] = sc[q] >= 0 ? src[(size_t)(k0 + kk) * N + sc[q]] : 0.f; } }
  __syncthreads();
#pragma unroll
  for (int j = 0; j < 4; ++j) { int v = tid + 512 * j, nn = v >> 3, kq = v & 7; bf16x8 o;
#pragma unroll
    for (int e = 0; e < 8; ++e) o[e] = (short)f2bf(lds[(kq * 8 + e) * 257 + nn]);
    *(bf16x8*)(dst + (size_t)(n0 + nn) * K + k0 + kq * 8) = o; }
  __syncthreads();
}

DI void ph_init(const P& p, LAS char* shm, int rep) {
  LAS float* lds = (LAS float*)shm;
  const int tid = otid();
  constexpr int N_MOD = 768, N_CV_L = 480 + 256 + 1408 + 704 + 16, N_CV = 2 * N_CV_L, N_TAB = 16, N_CACHE = 4096;
  constexpr int TOTAL = N_MOD + N_CV + N_TAB + N_CACHE;
  for (int it = blockIdx.x + (rep ? N_MOD : 0); it < TOTAL; it += gridDim.x) {
    if (it < N_MOD) {
      int l = it / 384, r = it % 384, jb = r >> 4, ks = r & 15, j = jb * 512 + tid, k0 = ks * 128;
      for (int e = tid; e < 5 * 128; e += 512) { int v = e >> 7, kk = e & 127; float c = v == 0 ? pin(p, I_CCTX)[k0 + kk] : pin(p, I_C)[(v - 1) * DM + k0 + kk]; lds[e] = siluf(c); }
      __syncthreads();
      float a0 = 0, a1 = 0, a2 = 0, a3 = 0, a4 = 0;
      const float* w = pin(p, I_WADA) + ((size_t)l * DM + k0) * 12288 + j;
#pragma unroll 16
      for (int kk = 0; kk < 128; ++kk) { float wv = w[(size_t)kk * 12288]; a0 += lds[kk] * wv; a1 += lds[128 + kk] * wv; a2 += lds[256 + kk] * wv; a3 += lds[384 + kk] * wv; a4 += lds[512 + kk] * wv; }
      float* part = (float*)(p.ws + O_XCT) + ((size_t)((l * 24 + jb) * 16 + ks) * 5) * 512 + tid;
      __hip_atomic_store(part, a0, __ATOMIC_RELAXED, __HIP_MEMORY_SCOPE_AGENT); __hip_atomic_store(part + 512, a1, __ATOMIC_RELAXED, __HIP_MEMORY_SCOPE_AGENT);
      __hip_atomic_store(part + 1024, a2, __ATOMIC_RELAXED, __HIP_MEMORY_SCOPE_AGENT); __hip_atomic_store(part + 1536, a3, __ATOMIC_RELAXED, __HIP_MEMORY_SCOPE_AGENT);
      __hip_atomic_store(part + 2048, a4, __ATOMIC_RELAXED, __HIP_MEMORY_SCOPE_AGENT);
      asm volatile("s_waitcnt vmcnt(0)" ::: "memory");
      __syncthreads();
      LAS unsigned* flag = (LAS unsigned*)(lds + 1024);
      if (tid == 0) { unsigned old = __hip_atomic_fetch_add((unsigned*)(p.ws + O_BAR + 14336) + (l * 24 + jb), 1u, __ATOMIC_RELAXED, __HIP_MEMORY_SCOPE_AGENT); *flag = (old == 15u) ? 1u : 0u; }
      __syncthreads();
      if (*flag) {
        const float bias = pin(p, I_BADA)[l * 12288 + j];
        float s0 = bias, s1 = bias, s2 = bias, s3 = bias, s4 = bias;
        float* pb = (float*)(p.ws + O_XCT) + ((size_t)((l * 24 + jb) * 16) * 5) * 512 + tid;
        for (int k2 = 0; k2 < 16; ++k2) { float* q = pb + (size_t)k2 * 5 * 512;
          s0 += __hip_atomic_load(q, __ATOMIC_RELAXED, __HIP_MEMORY_SCOPE_AGENT); s1 += __hip_atomic_load(q + 512, __ATOMIC_RELAXED, __HIP_MEMORY_SCOPE_AGENT);
          s2 += __hip_atomic_load(q + 1024, __ATOMIC_RELAXED, __HIP_MEMORY_SCOPE_AGENT); s3 += __hip_atomic_load(q + 1536, __ATOMIC_RELAXED, __HIP_MEMORY_SCOPE_AGENT);
          s4 += __hip_atomic_load(q + 2048, __ATOMIC_RELAXED, __HIP_MEMORY_SCOPE_AGENT); }
        float* mod = (float*)(p.ws + O_MOD) + (size_t)l * 5 * 12288 + j;
        mod[0] = s0; mod[12288] = s1; mod[2 * 12288] = s2; mod[3 * 12288] = s3; mod[4 * 12288] = s4;
      }
      __syncthreads();
    } else if (it < N_MOD + N_CV) {
      int r = it - N_MOD, l = r / N_CV_L; r -= l * N_CV_L;
      if (r < 480) conv_tile(pin(p, I_WIN) + (size_t)l * DM * DIN, DM, DIN, (u16*)(p.ws + O_WIN) + (size_t)l * NP * DM, 0, r, lds);
      else if ((r -= 480) < 256) conv_tile(pin(p, I_WOUT) + (size_t)l * DM * DM, DM, DM, (u16*)(p.ws + O_WOUT) + (size_t)l * DM * DM, 1, r, lds);
      else if ((r -= 256) < 1408) conv_tile(pin(p, I_WFFI) + (size_t)l * DM * 2 * DFF, DM, 2 * DFF, (u16*)(p.ws + O_WFFI) + (size_t)l * 2 * DFF * DM, 2, r, lds);
      else if ((r -= 1408) < 704) conv_tile(pin(p, I_WFFO) + (size_t)l * DFF * DM, DFF, DM, (u16*)(p.ws + O_WFFO) + (size_t)l * DM * DFF, 1, r, lds);
      else { r -= 704; conv_tile(pin(p, I_WGLU) + (size_t)l * 512 * 512, 512, 512, (u16*)(p.ws + O_WGLU) + (size_t)l * 512 * 512, 1, r, lds); }
    } else if (it < N_MOD + N_CV + N_TAB) {
      int idx = (it - N_MOD - N_CV) * 512 + tid;
      int l = idx >> 12, d = (idx >> 11) & 1, g = (idx >> 6) & 31, pp = idx & 63;
      int ai = ((l * 2 + d) * 32 + g) * 64 + pp;
      float are = pin(p, I_ARE)[ai], aim = pin(p, I_AIM)[ai];
      float step = __expf(pin(p, I_LOGDT)[(l * 2 + d) * 32 + g]);
      float er = __expf(are * step), sn, cs; sincos_acc(aim * step, sn, cs);
      float lbr = er * cs, lbi = er * sn;
      float qr = lbr, qi = lbi;
      for (int i = 0; i < 6; ++i) { float nr = qr * qr - qi * qi, ni = 2.f * qr * qi; qr = nr; qi = ni; }
      float den = are * are + aim * aim;
      float cr = ((lbr - 1.f) * are + lbi * aim) / den, ci = (lbi * are - (lbr - 1.f) * aim) / den;
      float* tab = (float*)(p.ws + O_S5T) + (size_t)l * S5T_L;
      int e = (d * 32 + g) * 64 + pp;
      tab[e * 2] = lbr; tab[e * 2 + 1] = lbi; tab[8192 + e * 2] = qr; tab[8192 + e * 2 + 1] = qi;
      const float* bre = pin(p, I_BRE) + ((size_t)(l * 32 + g) * 64 + pp) * 16;
      const float* bim = pin(p, I_BIM) + ((size_t)(l * 32 + g) * 64 + pp) * 16;
      u16* bb16 = (u16*)(tab + 16384) + (size_t)(d * 32 + g) * 4 * 32 * 16;
      u16* cc16 = (u16*)(tab + 81920) + (size_t)(d * 32 + g) * 16 * 128;
      const float* cre = pin(p, I_CRE) + (size_t)((l * 2 + d) * 32 + g) * 16 * 64 + pp;
      const float* cim = pin(p, I_CIM) + (size_t)((l * 2 + d) * 32 + g) * 16 * 64 + pp;
      for (int c = 0; c < 16; ++c) {
        float br = bre[c], bi = bim[c];
        bb16[(((pp >> 5)) * 32 + (pp & 31)) * 16 + c] = f2bf(cr * br - ci * bi);
        bb16[((2 + (pp >> 5)) * 32 + (pp & 31)) * 16 + c] = f2bf(cr * bi + ci * br);
        cc16[c * 128 + pp] = f2bf(cre[c * 64]); cc16[c * 128 + 64 + pp] = f2bf(-cim[c * 64]);
      }
    } else {
      int r = it - N_MOD - N_CV - N_TAB;
      if (r < 2048) { int e = r * 512 + tid; int d = e & 63, j = (e >> 6) & 511, kvh = (e >> 15) & 3, b = (e >> 17) & 3, l = e >> 19;
        ((u16*)(p.ws + O_KC))[e] = f2bf(pin(p, I_CK)[((size_t)((b * 2 + l) * 512 + j) * 4 + kvh) * 64 + d]); }
      else { int e = (r - 2048) * 512 + tid; int j = e & 511, d = (e >> 9) & 63, kvh = (e >> 15) & 3, b = (e >> 17) & 3, l = e >> 19;
        ((u16*)(p.ws + O_VCT))[e] = f2bf(pin(p, I_CV)[((size_t)((b * 2 + l) * 512 + j) * 4 + kvh) * 64 + d]); }
    }
  }
}

DI void ph_prenorm(const P& p) {
  const int tid_ = otid(), lane = tid_ & 63, wave = __builtin_amdgcn_readfirstlane(tid_ >> 6);
  const float* mod = (const float*)(p.ws + O_MOD);
  const float* gw = pin(p, I_NMPRE);
  u16* H = (u16*)(p.ws + O_H);
  for (int r = blockIdx.x * 8 + wave; r < T; r += gridDim.x * 8) {
    const float* x = r < TC ? pin(p, I_XP) + (size_t)r * DM : pin(p, I_XS) + (size_t)(r - TC) * DM;
    const float* mr = mod + (size_t)modrow(r) * 12288;
    float4 v[8]; float ss = 0.f;
#pragma unroll
    for (int i = 0; i < 8; ++i) { v[i] = *(const float4*)(x + i * 256 + lane * 4); ss += v[i].x * v[i].x + v[i].y * v[i].y + v[i].z * v[i].z + v[i].w * v[i].w; }
    ss = wsum(ss); float rs = rsqrtf(ss * (1.f / DM) + 1e-6f);
#pragma unroll
    for (int i = 0; i < 8; ++i) {
      int c = i * 256 + lane * 4;
      float4 g = *(const float4*)(gw + c), sh = *(const float4*)(mr + c), sc = *(const float4*)(mr + 2048 + c);
      s16x4 o; o[0] = (short)f2bf(v[i].x * rs * g.x * (1.f + sc.x) + sh.x); o[1] = (short)f2bf(v[i].y * rs * g.y * (1.f + sc.y) + sh.y);
      o[2] = (short)f2bf(v[i].z * rs * g.z * (1.f + sc.z) + sh.z); o[3] = (short)f2bf(v[i].w * rs * g.w * (1.f + sc.w) + sh.w);
      *(s16x4*)(H + (size_t)r * DM + c) = o;
    }
  }
}
constexpr size_t O_XB = O_SST;
template <int XIN, int XOUT>
DI void ph_row(const P& p, const float* wpost, int gate_off, const float* wpre, const float* modn, int sh_off, int sc_off, const float* modg, const u16* XBI, u16* XBO) {
  const int tid_ = otid(), lane = tid_ & 63, wave = __builtin_amdgcn_readfirstlane(tid_ >> 6);
  u16* H = (u16*)(p.ws + O_H);
  const int stride = gridDim.x * 8;
  int r = blockIdx.x * 8 + wave;
  bf16x8 nh[4]; float4 nx[8]; bf16x8 nxb[4];
#define ROW_LOAD(rr) do { const u16* hr_ = H + (size_t)(rr) * DM + lane * 8; \
    _Pragma("unroll") for (int i_ = 0; i_ < 4; ++i_) nh[i_] = *(const bf16x8*)(hr_ + i_ * 512); \
    if (XIN == 2) { const u16* xb_ = XBI + (size_t)(rr) * DM + lane * 8; _Pragma("unroll") for (int i_ = 0; i_ < 4; ++i_) nxb[i_] = *(const bf16x8*)(xb_ + i_ * 512); } \
    else { const float* xs_ = (XIN == 1 ? ((rr) < TC ? pin(p, I_XP) + (size_t)(rr) * DM : pin(p, I_XS) + (size_t)((rr) - TC) * DM) : p.out + OUT_X + (size_t)(rr) * DM) + lane * 8; \
      _Pragma("unroll") for (int i_ = 0; i_ < 4; ++i_) { nx[2 * i_] = *(const float4*)(xs_ + i_ * 512); nx[2 * i_ + 1] = *(const float4*)(xs_ + i_ * 512 + 4); } } } while (0)
  if (r < T) ROW_LOAD(r);
  for (; r < T; r += stride) {
    bf16x8 ch[4]; float4 cx[8];
#pragma unroll
    for (int i = 0; i < 4; ++i) {
      ch[i] = nh[i];
      if (XIN == 2) { cx[2 * i] = make_float4(bfs(nxb[i][0]), bfs(nxb[i][1]), bfs(nxb[i][2]), bfs(nxb[i][3])); cx[2 * i + 1] = make_float4(bfs(nxb[i][4]), bfs(nxb[i][5]), bfs(nxb[i][6]), bfs(nxb[i][7])); }
      else { cx[2 * i] = nx[2 * i]; cx[2 * i + 1] = nx[2 * i + 1]; }
    }
    if (r + stride < T) ROW_LOAD(r + stride);
    const int mrow = modrow(r);
    const float* mg = modg + (size_t)mrow * 12288 + gate_off;
    float* xr = p.out + OUT_X + (size_t)r * DM;
    u16* hr = H + (size_t)r * DM;
    float o[32]; float ss = 0.f;
#pragma unroll
    for (int i = 0; i < 4; ++i)
#pragma unroll
      for (int e = 0; e < 8; ++e) { o[i * 8 + e] = bfs(ch[i][e]); ss += o[i * 8 + e] * o[i * 8 + e]; }
    ss = wsum(ss); float rs = rsqrtf(ss * (1.f / DM) + 1e-6f);
    float ss2 = 0.f;
#pragma unroll
    for (int i = 0; i < 4; ++i) {
#pragma unroll
      for (int q = 0; q < 2; ++q) {
        int c = i * 512 + lane * 8 + q * 4;
        float4 xv = cx[2 * i + q], w = *(const float4*)(wpost + c), g = *(const float4*)(mg + c);
        xv.x += g.x * o[i * 8 + q * 4 + 0] * rs * w.x; xv.y += g.y * o[i * 8 + q * 4 + 1] * rs * w.y;
        xv.z += g.z * o[i * 8 + q * 4 + 2] * rs * w.z; xv.w += g.w * o[i * 8 + q * 4 + 3] * rs * w.w;
        if (XOUT == 0) *(float4*)(xr + c) = xv;
        o[i * 8 + q * 4 + 0] = xv.x; o[i * 8 + q * 4 + 1] = xv.y; o[i * 8 + q * 4 + 2] = xv.z; o[i * 8 + q * 4 + 3] = xv.w;
        ss2 += xv.x * xv.x + xv.y * xv.y + xv.z * xv.z + xv.w * xv.w;
      }
      if (XOUT == 1) { const float* oo = &o[i * 8]; *(bf16x8*)(XBO + (size_t)r * DM + i * 512 + lane * 8) = pack8(oo[0], oo[1], oo[2], oo[3], oo[4], oo[5], oo[6], oo[7]); }
    }
    if (wpre) {
      ss2 = wsum(ss2); float rs2 = rsqrtf(ss2 * (1.f / DM) + 1e-6f);
      const float* mn = modn + (size_t)mrow * 12288;
#pragma unroll
      for (int i = 0; i < 4; ++i) {
        int c = i * 512 + lane * 8;
        float4 w0 = *(const float4*)(wpre + c), w1 = *(const float4*)(wpre + c + 4), sh0 = *(const float4*)(mn + sh_off + c), sh1 = *(const float4*)(mn + sh_off + c + 4), sc0 = *(const float4*)(mn + sc_off + c), sc1 = *(const float4*)(mn + sc_off + c + 4);
        const float* oo = &o[i * 8];
        bf16x8 v = pack8(oo[0] * rs2 * w0.x * (1.f + sc0.x) + sh0.x, oo[1] * rs2 * w0.y * (1.f + sc0.y) + sh0.y, oo[2] * rs2 * w0.z * (1.f + sc0.z) + sh0.z, oo[3] * rs2 * w0.w * (1.f + sc0.w) + sh0.w,
                         oo[4] * rs2 * w1.x * (1.f + sc1.x) + sh1.x, oo[5] * rs2 * w1.y * (1.f + sc1.y) + sh1.y, oo[6] * rs2 * w1.z * (1.f + sc1.z) + sh1.z, oo[7] * rs2 * w1.w * (1.f + sc1.w) + sh1.w);
        *(bf16x8*)(hr + c) = v;
      }
    }
  }
#undef ROW_LOAD
}

DI void prep_item(const P& p, int l, int it, LAS char* shm) {
  LAS u16* tile = (LAS u16*)shm;
  const int tid = otid(), tb = it >> 4, c0 = (it & 15) * 64, t0 = tb * 64;
  const u16* proj = (const u16*)(p.ws + O_PROJ);
  { const int tt = tid >> 3, ch0 = c0 + (tid & 7) * 8, t = t0 + tt;
    int i, L; if (t < TC) { i = t & 255; L = 256; } else { i = (t - TC) & 4095; L = 4096; }
    const u16* px = proj + (size_t)t * NP + C_X + ch0;
    bf16x8 x1 = *(const bf16x8*)px, x0, x2;
    if (i > 0) x0 = *(const bf16x8*)(px - NP); else x0 = (bf16x8){0, 0, 0, 0, 0, 0, 0, 0};
    if (i < L - 1) x2 = *(const bf16x8*)(px + NP); else x2 = (bf16x8){0, 0, 0, 0, 0, 0, 0, 0};
    const float* cw = pin(p, I_CONVW) + (size_t)l * 3 * 1024 + ch0;
    const float* cb = pin(p, I_CONVB) + (size_t)l * 1024 + ch0;
    bf16x8 o;
#pragma unroll
    for (int e = 0; e < 8; ++e) { float y = cb[e] + cw[e] * bfs(x0[e]) + cw[1024 + e] * bfs(x1[e]) + cw[2048 + e] * bfs(x2[e]); o[e] = (short)f2bf(siluf(y)); }
    *(bf16x8*)((u16*)(p.ws + O_XC) + (size_t)t * 1024 + ch0) = o;
    *(LAS bf16x8*)(tile + tt * 72 + (tid & 7) * 8) = o; }
  __syncthreads();
  { const int cc = tid >> 3, tv = tid & 7; bf16x8 o;
#pragma unroll
    for (int e = 0; e < 8; ++e) o[e] = (short)tile[(tv * 8 + e) * 72 + cc];
    *(bf16x8*)((u16*)(p.ws + O_XCT) + (size_t)(c0 + cc) * T + t0 + tv * 8) = o; }
  __syncthreads();
}
DI void cum_item(const P& p, int l, int gc) {
  const int tid = otid(), lane = tid & 63, wave = __builtin_amdgcn_readfirstlane(tid >> 6), t0 = gc * 128;
  const float* dtr = (const float*)(p.ws + O_DT);
  for (int hd = wave; hd < 24; hd += 8) {
    const float bias = pin(p, I_DTB)[l * 24 + hd], a = -__expf(pin(p, I_ALOG)[l * 24 + hd]);
    float x0 = dtr[(size_t)(t0 + 2 * lane) * 32 + hd] + bias, x1 = dtr[(size_t)(t0 + 2 * lane + 1) * 32 + hd] + bias;
    float d0 = x0 > 15.f ? x0 : __logf(1.f + __expf(x0)), d1 = x1 > 15.f ? x1 : __logf(1.f + __expf(x1));
    float v0 = d0 * a, v1 = d1 * a, ps = v0 + v1, inc = ps;
#pragma unroll
    for (int o = 1; o < 64; o <<= 1) { float y = __shfl_up(inc, o); if (lane >= o) inc += y; }
    float total = __shfl(inc, 63), exc = inc - ps;
    float c0, c1;
    if (hd < 12) { c0 = exc + v0; c1 = inc; } else { c0 = total - exc; c1 = total - exc - v0; }
    float* cum = (float*)(p.ws + O_CUM) + ((size_t)gc * 24 + hd) * 128 + 2 * lane;
    float* dtw = (float*)(p.ws + O_DTW) + ((size_t)gc * 24 + hd) * 128 + 2 * lane;
    *(float2*)cum = make_float2(c0, c1); *(float2*)dtw = make_float2(d0, d1);
    if (lane == 0) ((float*)(p.ws + O_CDEC))[gc * 24 + hd] = __expf(total);
  }
}
DI void rope_item(const P& p, int it) {
  int idx = it * 512 + otid(), j = idx & 31, tl = idx >> 5, t = TC + tl, i = tl & 4095;
  float pos = (j < 16) ? (float)(i >> 6) : (float)(i & 63);
  float inv = __expf(-(float)(j & 15) * (9.210340371976184f / 16.f));
  float sn, cs; sincos_acc(pos * inv, sn, cs);
  u16* row = (u16*)(p.ws + O_PROJ) + (size_t)t * NP;
#pragma unroll 4
  for (int hh = 0; hh < 16; ++hh) {
    int base = (hh < 12 ? C_Q + hh * 64 : C_K + (hh - 12) * 64) + j;
    float x1 = bf2f(row[base]), x2 = bf2f(row[base + 32]);
    row[base] = f2bf(x1 * cs - x2 * sn); row[base + 32] = f2bf(x2 * cs + x1 * sn);
  }
}
DI void vt_item(const P& p, int it, LAS char* shm) {
  LAS u16* tile = (LAS u16*)shm;
  const int tid = otid(), t0 = (it >> 2) * 64, c0 = (it & 3) * 64;
  const u16* proj = (const u16*)(p.ws + O_PROJ);
  { int cc = tid & 63, tr = tid >> 6;
#pragma unroll
    for (int i = 0; i < 8; ++i) tile[(tr + 8 * i) * 66 + cc] = proj[(size_t)(t0 + tr + 8 * i) * NP + C_V + c0 + cc]; }
  __syncthreads();
  { int tt = tid & 63, cr = tid >> 6; u16* vt = (u16*)(p.ws + O_VT);
#pragma unroll
    for (int i = 0; i < 8; ++i) vt[(size_t)(c0 + cr + 8 * i) * T + t0 + tt] = tile[tt * 66 + cr + 8 * i]; }
  __syncthreads();
}
DI int s5_tok(int hh, int stp, int dir) { return hh * 64 + (dir ? 63 - stp : stp); }
#define S5_SCAN_STEP(i) do { float n0r = s0r * lr0 - s0i * li0 + a0[i], n0i = s0r * li0 + s0i * lr0 + a2[i]; s0r = n0r; s0i = n0i; \
    float n1r = s1r * lr1 - s1i * li1 + a1[i], n1i = s1r * li1 + s1i * lr1 + a3[i]; s1r = n1r; s1i = n1i; } while (0)
DI void s5p1_item(const P& p, int l, int it) {
  const int tid_ = otid(), lane = tid_ & 63, wave = __builtin_amdgcn_readfirstlane(tid_ >> 6), r = lane & 31, h = lane >> 5;
  const int gc = it >> 3, g = (it & 7) * 4 + (wave >> 1), dir = wave & 1, t0 = gc * 128;
  const float* tab = (const float*)(p.ws + O_S5T) + (size_t)l * S5T_L;
  const int e0 = (dir * 32 + g) * 64 + r;
  const float lr0 = tab[e0 * 2], li0 = tab[e0 * 2 + 1], lr1 = tab[(e0 + 32) * 2], li1 = tab[(e0 + 32) * 2 + 1];
  const u16* bb16 = (const u16*)(tab + 16384) + (size_t)(dir * 32 + g) * 4 * 32 * 16;
  bf16x8 bop[4];
#pragma unroll
  for (int nt = 0; nt < 4; ++nt) bop[nt] = *(const bf16x8*)(bb16 + (nt * 32 + r) * 16 + 8 * h);
  const u16* up = (const u16*)(p.ws + O_PROJ) + C_U + g * 16 + 8 * h;
  const int mh = (r >> 2) & 1, mi = (r & 3) + 4 * (r >> 3);
  float s0r = 0.f, s0i = 0.f, s1r = 0.f, s1i = 0.f;
  f32x16 zero;
#pragma unroll
  for (int i = 0; i < 16; ++i) zero[i] = 0.f;
#pragma unroll 1
  for (int it4 = 0; it4 < 4; ++it4) {
    bf16x8 af = *(const bf16x8*)(up + (size_t)(t0 + s5_tok(mh, 16 * it4 + mi, dir)) * NP);
    f32x16 a0 = __builtin_amdgcn_mfma_f32_32x32x16_bf16(af, bop[0], zero, 0, 0, 0);
    f32x16 a1 = __builtin_amdgcn_mfma_f32_32x32x16_bf16(af, bop[1], zero, 0, 0, 0);
    f32x16 a2 = __builtin_amdgcn_mfma_f32_32x32x16_bf16(af, bop[2], zero, 0, 0, 0);
    f32x16 a3 = __builtin_amdgcn_mfma_f32_32x32x16_bf16(af, bop[3], zero, 0, 0, 0);
#pragma unroll
    for (int i = 0; i < 16; ++i) S5_SCAN_STEP(i);
  }
  float* sh = (float*)(p.ws + O_S5H) + ((size_t)((2 * gc + h) * 32 + g) * 2 + dir) * 128;
  *(float2*)(sh + r * 2) = make_float2(s0r, s0i); *(float2*)(sh + (32 + r) * 2) = make_float2(s1r, s1i);
}
DI void s5comb_item(const P& p, int l, int it) {
  int idx = it * 512 + otid(), pp = idx & 63, dir = (idx >> 6) & 1, g = (idx >> 7) & 31, seq = idx >> 12;
  const float* tab = (const float*)(p.ws + O_S5T) + (size_t)l * S5T_L;
  int e = (dir * 32 + g) * 64 + pp;
  float qr = tab[8192 + e * 2], qi = tab[8192 + e * 2 + 1];
  float hr = 0.f, hi = 0.f; int nc = 4, hc0 = seq * 4;
  if (seq >= 32) { int b = seq - 32; nc = 64; hc0 = 128 + b * 64; size_t o = (size_t)((b * 2 + l) * 2 + dir) * 2048 + g * 64 + pp; hr = pin(p, I_S5R)[o]; hi = pin(p, I_S5I)[o]; }
  float* s5h = (float*)(p.ws + O_S5H);
#pragma unroll 1
  for (int kb = 0; kb < nc; kb += 16) {
    float2 v[16];
#pragma unroll
    for (int k = 0; k < 16; ++k) if (kb + k < nc) {
      int hc = hc0 + (dir ? nc - 1 - (kb + k) : kb + k);
      v[k] = *(const float2*)(s5h + ((size_t)(hc * 32 + g) * 2 + dir) * 128 + pp * 2); }
#pragma unroll
    for (int k = 0; k < 16; ++k) if (kb + k < nc) {
      int hc = hc0 + (dir ? nc - 1 - (kb + k) : kb + k);
      *(float2*)(s5h + ((size_t)(hc * 32 + g) * 2 + dir) * 128 + pp * 2) = make_float2(hr, hi);
      float nr = hr * qr - hi * qi + v[k].x, ni = hr * qi + hi * qr + v[k].y; hr = nr; hi = ni; }
  }
  if (seq < 32) { size_t o = (size_t)((seq * 2 + l) * 2 + dir) * 2048 + g * 64 + pp; p.out[OUT_S5R + o] = hr; p.out[OUT_S5I + o] = hi; }
}
DI void s5p2_item(const P& p, int l, int it, LAS char* shm) {
  const int tid_ = otid(), lane = tid_ & 63, wave = __builtin_amdgcn_readfirstlane(tid_ >> 6), r = lane & 31, h = lane >> 5;
  const int gc = it >> 2, g = (it & 3) * 8 + wave, t0 = gc * 128;
  LAS u16* HT = (LAS u16*)(shm + wave * 17408);
  LAS float* ybuf = (LAS float*)(shm + wave * 17408 + 8704);
  const float* tab = (const float*)(p.ws + O_S5T) + (size_t)l * S5T_L;
  const u16* up = (const u16*)(p.ws + O_PROJ) + C_U + g * 16;
  const int mh = (r >> 2) & 1, mi = (r & 3) + 4 * (r >> 3);
  const float Dv = pin(p, I_S5D)[l * 512 + g * 16 + (r & 15)];
  f32x16 zero;
#pragma unroll
  for (int i = 0; i < 16; ++i) zero[i] = 0.f;
#pragma unroll 1
  for (int dd = 0; dd < 2; ++dd) {
    const int dir = 1 - dd;
    const int e0 = (dir * 32 + g) * 64 + r;
    const float lr0 = tab[e0 * 2], li0 = tab[e0 * 2 + 1], lr1 = tab[(e0 + 32) * 2], li1 = tab[(e0 + 32) * 2 + 1];
    const u16* bb16 = (const u16*)(tab + 16384) + (size_t)(dir * 32 + g) * 4 * 32 * 16;
    const u16* cc16 = (const u16*)(tab + 81920) + (size_t)(dir * 32 + g) * 16 * 128;
    bf16x8 bop[4], cop[8];
#pragma unroll
    for (int nt = 0; nt < 4; ++nt) bop[nt] = *(const bf16x8*)(bb16 + (nt * 32 + r) * 16 + 8 * h);
#pragma unroll
    for (int ks = 0; ks < 8; ++ks) { if (r < 16) cop[ks] = *(const bf16x8*)(cc16 + r * 128 + ks * 16 + 8 * h); else cop[ks] = (bf16x8){0, 0, 0, 0, 0, 0, 0, 0}; }
    const float* sh = (const float*)(p.ws + O_S5H) + ((size_t)((2 * gc + h) * 32 + g) * 2 + dir) * 128;
    float s0r = sh[r * 2], s0i = sh[r * 2 + 1], s1r = sh[(32 + r) * 2], s1i = sh[(32 + r) * 2 + 1];
#pragma unroll 1
    for (int it4 = 0; it4 < 4; ++it4) {
      bf16x8 af = *(const bf16x8*)(up + 8 * h + (size_t)(t0 + s5_tok(mh, 16 * it4 + mi, dir)) * NP);
      f32x16 a0 = __builtin_amdgcn_mfma_f32_32x32x16_bf16(af, bop[0], zero, 0, 0, 0);
      f32x16 a1 = __builtin_amdgcn_mfma_f32_32x32x16_bf16(af, bop[1], zero, 0, 0, 0);
      f32x16 a2 = __builtin_amdgcn_mfma_f32_32x32x16_bf16(af, bop[2], zero, 0, 0, 0);
      f32x16 a3 = __builtin_amdgcn_mfma_f32_32x32x16_bf16(af, bop[3], zero, 0, 0, 0);
#pragma unroll
      for (int i = 0; i < 16; ++i) { S5_SCAN_STEP(i); a0[i] = s0r; a1[i] = s1r; a2[i] = s0i; a3[i] = s1i; }
#pragma unroll
      for (int i = 0; i < 16; i += 2) {
        LAS u16* row = HT + (16 * h + i) * 136 + r;
        unsigned k0 = cvt_pk_bf16(a0[i], a0[i + 1]), k1 = cvt_pk_bf16(a1[i], a1[i + 1]), k2 = cvt_pk_bf16(a2[i], a2[i + 1]), k3 = cvt_pk_bf16(a3[i], a3[i + 1]);
        row[0] = (u16)k0; row[136] = (u16)(k0 >> 16); row[32] = (u16)k1; row[136 + 32] = (u16)(k1 >> 16);
        row[64] = (u16)k2; row[136 + 64] = (u16)(k2 >> 16); row[96] = (u16)k3; row[136 + 96] = (u16)(k3 >> 16);
      }
      asm volatile("s_waitcnt lgkmcnt(0)" ::: "memory");
      f32x16 y2 = zero;
#pragma unroll
      for (int ks = 0; ks < 8; ++ks) {
        bf16x8 a2f = *(const LAS bf16x8*)(HT + r * 136 + ks * 16 + 8 * h);
        y2 = __builtin_amdgcn_mfma_f32_32x32x16_bf16(a2f, cop[ks], y2, 0, 0, 0);
      }
      if (r < 16) {
#pragma unroll
        for (int i2 = 0; i2 < 16; ++i2) {
          const int m2 = crow(i2, h), tok = s5_tok(m2 >> 4, 16 * it4 + (m2 & 15), dir);
          if (dd == 0) ybuf[tok * 16 + r] = y2[i2];
          else {
            float u = bf2f(up[(size_t)(t0 + tok) * NP + r]);
            float y = ybuf[tok * 16 + r] + y2[i2] + Dv * u;
            float gl = y / (1.f + __expf(-1.5957691216057308f * (y + 0.044715f * y * y * y)));
            ((u16*)(p.ws + O_G5))[(size_t)(t0 + tok) * 512 + g * 16 + r] = f2bf(gl);
          }
        }
      }
      asm volatile("s_waitcnt lgkmcnt(0)" ::: "memory");
    }
  }
}
DI void ssd_p1_item(const P& p, int l, int it, LAS char* shm) {
  const int tid = otid(), lane = tid & 63, wave = __builtin_amdgcn_readfirstlane(tid >> 6), r = lane & 31, h = lane >> 5;
  const int gc = it / 3, rr = it - gc * 3, t0 = gc * 128, hd = rr * 8 + wave, dir = hd / 12, head = hd - dir * 12, g = head / 6;
  LAS float* wb = (LAS float*)(shm + wave * 512);
  const float* cum = (const float*)(p.ws + O_CUM) + ((size_t)gc * 24 + hd) * 128;
  const float* dtw = (const float*)(p.ws + O_DTW) + ((size_t)gc * 24 + hd) * 128;
  const float total = dir ? cum[0] : cum[127];
  wb[lane] = dtw[lane] * __expf(total - cum[lane]); wb[lane + 64] = dtw[lane + 64] * __expf(total - cum[lane + 64]);
  asm volatile("s_waitcnt lgkmcnt(0)" ::: "memory");
  const u16* xct = (const u16*)(p.ws + O_XCT);
  const u16* xa0 = xct + (size_t)(head * 64 + r) * T + t0 + 8 * h;
  const u16* xa1 = xa0 + (size_t)32 * T;
  const u16* xb0 = xct + (size_t)(768 + g * 64 + r) * T + t0 + 8 * h;
  const u16* xb1 = xb0 + (size_t)32 * T;
  f32x16 a00, a01, a10, a11;
#pragma unroll
  for (int i = 0; i < 16; ++i) { a00[i] = 0.f; a01[i] = 0.f; a10[i] = 0.f; a11[i] = 0.f; }
#pragma unroll 2
  for (int ks = 0; ks < 8; ++ks) {
    bf16x8 r0 = *(const bf16x8*)(xa0 + ks * 16), r1 = *(const bf16x8*)(xa1 + ks * 16);
    bf16x8 b0 = *(const bf16x8*)(xb0 + ks * 16), b1 = *(const bf16x8*)(xb1 + ks * 16);
    f32x4 w0 = *(const LAS f32x4*)(wb + ks * 16 + 8 * h), w1 = *(const LAS f32x4*)(wb + ks * 16 + 8 * h + 4);
    bf16x8 f0, f1;
#pragma unroll
    for (int j = 0; j < 8; ++j) { float w = j < 4 ? w0[j & 3] : w1[j & 3]; f0[j] = (short)f2bf(bfs(r0[j]) * w); f1[j] = (short)f2bf(bfs(r1[j]) * w); }
    a00 = __builtin_amdgcn_mfma_f32_32x32x16_bf16(f0, b0, a00, 0, 0, 0);
    a01 = __builtin_amdgcn_mfma_f32_32x32x16_bf16(f0, b1, a01, 0, 0, 0);
    a10 = __builtin_amdgcn_mfma_f32_32x32x16_bf16(f1, b0, a10, 0, 0, 0);
    a11 = __builtin_amdgcn_mfma_f32_32x32x16_bf16(f1, b1, a11, 0, 0, 0);
  }
  float* sst = (float*)(p.ws + O_SST) + ((size_t)(gc * 2 + dir) * 12 + head) * 4096;
#pragma unroll
  for (int i = 0; i < 16; ++i) {
    int pr = crow(i, h);
    sst[pr * 64 + r] = a00[i]; sst[pr * 64 + 32 + r] = a01[i]; sst[(32 + pr) * 64 + r] = a10[i]; sst[(32 + pr) * 64 + 32 + r] = a11[i];
  }
  asm volatile("s_waitcnt lgkmcnt(0)" ::: "memory");
}
DI void ssd_p2_item(const P& p, int l, int it, LAS char* shm) {
  const int tid = otid(), lane = tid & 63, wave = __builtin_amdgcn_readfirstlane(tid >> 6), r = lane & 31, h = lane >> 5;
  const int task = it * 8 + wave, lb = task & 3, head = (task >> 2) % 12, gc = task / 48, g = head / 6, t0 = gc * 128;
  LAS float* lf = (LAS float*)(shm + wave * 2048);
  { const float* cumf = (const float*)(p.ws + O_CUM) + ((size_t)gc * 24 + head) * 128;
    const float* dtf = (const float*)(p.ws + O_DTW) + ((size_t)gc * 24 + head) * 128;
    lf[lane] = cumf[lane]; lf[64 + lane] = cumf[64 + lane]; lf[128 + lane] = cumf[12 * 128 + lane]; lf[192 + lane] = cumf[12 * 128 + 64 + lane];
    lf[256 + lane] = dtf[lane]; lf[320 + lane] = dtf[64 + lane]; lf[384 + lane] = dtf[12 * 128 + lane]; lf[448 + lane] = dtf[12 * 128 + 64 + lane]; }
  asm volatile("s_waitcnt lgkmcnt(0)" ::: "memory");
  const int lq = lb * 32 + r;
  const float cfl = lf[lq], cbl = lf[128 + lq];
  const float Dh = pin(p, I_SSDD)[l * 12 + head];
  const u16* xc = (const u16*)(p.ws + O_XC);
  bf16x8 cq[4];
  { const u16* crowp = xc + (size_t)(t0 + lq) * 1024 + 896 + g * 64 + 8 * h;
#pragma unroll
    for (int ks = 0; ks < 4; ++ks) cq[ks] = *(const bf16x8*)(crowp + ks * 16); }
  f32x16 o0, o1;
#pragma unroll
  for (int i = 0; i < 16; ++i) { o0[i] = 0.f; o1[i] = 0.f; }
#pragma unroll
  for (int dir = 0; dir < 2; ++dir) {
    const float* hs = (const float*)(p.ws + O_SST) + ((size_t)(gc * 2 + dir) * 12 + head) * 4096;
    f32x16 u0, u1;
#pragma unroll
    for (int i = 0; i < 16; ++i) { u0[i] = 0.f; u1[i] = 0.f; }
#pragma unroll
    for (int ks = 0; ks < 4; ++ks) {
      const float* h0 = hs + (size_t)r * 64 + ks * 16 + 8 * h; const float* h1 = h0 + 32 * 64;
      float4 x0 = *(const float4*)h0, x1 = *(const float4*)(h0 + 4), y0 = *(const float4*)h1, y1 = *(const float4*)(h1 + 4);
      bf16x8 fa = pack8(x0.x, x0.y, x0.z, x0.w, x1.x, x1.y, x1.z, x1.w), fb = pack8(y0.x, y0.y, y0.z, y0.w, y1.x, y1.y, y1.z, y1.w);
      u0 = __builtin_amdgcn_mfma_f32_32x32x16_bf16(fa, cq[ks], u0, 0, 0, 0);
      u1 = __builtin_amdgcn_mfma_f32_32x32x16_bf16(fb, cq[ks], u1, 0, 0, 0);
    }
    const float sc = __expf(dir ? cbl : cfl);
#pragma unroll
    for (int i = 0; i < 16; ++i) { o0[i] += sc * u0[i]; o1[i] += sc * u1[i]; }
  }
  const u16* xct = (const u16*)(p.ws + O_XCT);
  const u16* vrow0 = xct + (size_t)(head * 64 + r) * T + t0 + 8 * h;
  const u16* vrow1 = vrow0 + (size_t)32 * T;
  const u16* brow = xc + (size_t)(t0 + pi23(r)) * 1024 + 768 + g * 64 + 8 * h;
#pragma unroll 1
  for (int st = 0; st < 4; ++st) {
    f32x16 sg;
#pragma unroll
    for (int i = 0; i < 16; ++i) sg[i] = 0.f;
#pragma unroll
    for (int ks = 0; ks < 4; ++ks) {
      bf16x8 kf = *(const bf16x8*)(brow + (size_t)st * 32 * 1024 + ks * 16);
      sg = __builtin_amdgcn_mfma_f32_32x32x16_bf16(kf, cq[ks], sg, 0, 0, 0);
    }
#pragma unroll
    for (int q = 0; q < 4; ++q) {
      const int sb = st * 32 + 16 * (q >> 1) + 8 * h + 4 * (q & 1);
      f32x4 cf4 = *(const LAS f32x4*)(lf + sb), cb4 = *(const LAS f32x4*)(lf + 128 + sb), df4 = *(const LAS f32x4*)(lf + 256 + sb), db4 = *(const LAS f32x4*)(lf + 384 + sb);
#pragma unroll
      for (int e = 0; e < 4; ++e) {
        const int si = sb + e;
        float wf = (si <= lq) ? df4[e] * __expf(fminf(cfl - cf4[e], 0.f)) : 0.f;
        float wbk = (si >= lq) ? db4[e] * __expf(fminf(cbl - cb4[e], 0.f)) : 0.f;
        float v = sg[q * 4 + e] * (wf + wbk);
        if (si == lq) v += Dh;
        sg[q * 4 + e] = v;
      }
    }
#pragma unroll
    for (int sp = 0; sp < 2; ++sp) {
      bf16x8 pf = pack8(sg[8 * sp], sg[8 * sp + 1], sg[8 * sp + 2], sg[8 * sp + 3], sg[8 * sp + 4], sg[8 * sp + 5], sg[8 * sp + 6], sg[8 * sp + 7]);
      bf16x8 va = *(const bf16x8*)(vrow0 + st * 32 + 16 * sp), vb = *(const bf16x8*)(vrow1 + st * 32 + 16 * sp);
      o0 = __builtin_amdgcn_mfma_f32_32x32x16_bf16(va, pf, o0, 0, 0, 0);
      o1 = __builtin_amdgcn_mfma_f32_32x32x16_bf16(vb, pf, o1, 0, 0, 0);
    }
  }
  u16* yrow = (u16*)(p.ws + O_Y) + (size_t)(t0 + lq) * 768 + head * 64;
#pragma unroll
  for (int gq = 0; gq < 4; ++gq) {
    s16x4 a, bq;
#pragma unroll
    for (int e = 0; e < 4; ++e) { a[e] = (short)f2bf(o0[gq * 4 + e]); bq[e] = (short)f2bf(o1[gq * 4 + e]); }
    *(s16x4*)(yrow + 8 * gq + 4 * h) = a; *(s16x4*)(yrow + 32 + 8 * gq + 4 * h) = bq;
  }
  asm volatile("s_waitcnt lgkmcnt(0)" ::: "memory");
}
DI void ssdcomb_item(const P& p, int l, int it) {
  int idx = it * 512 + otid();
  int pn = idx & 4095, hd = (idx >> 12) % 24, seq = idx / (24 * 4096), dir = hd / 12, head = hd - dir * 12;
  float hs = 0.f; int nc = 2;
  if (seq >= 32) { nc = 32; hs = pin(p, I_SSD)[((size_t)(((seq - 32) * 2 + l) * 2 + dir) * 12 + head) * 4096 + pn]; }
  float* sst = (float*)(p.ws + O_SST); const float* cdec = (const float*)(p.ws + O_CDEC);
#pragma unroll 1
  for (int kb = 0; kb < nc; kb += 16) {
    float v[16], dc[16];
#pragma unroll
    for (int k = 0; k < 16; ++k) if (kb + k < nc) {
      int c = dir ? nc - 1 - (kb + k) : kb + k, gc = chunk_of(seq, c); size_t o = ((size_t)(gc * 2 + dir) * 12 + head);
      v[k] = sst[o * 4096 + pn]; dc[k] = cdec[o]; }
#pragma unroll
    for (int k = 0; k < 16; ++k) if (kb + k < nc) {
      int c = dir ? nc - 1 - (kb + k) : kb + k, gc = chunk_of(seq, c); size_t o = ((size_t)(gc * 2 + dir) * 12 + head);
      sst[o * 4096 + pn] = hs; hs = hs * dc[k] + v[k]; }
  }
  if (seq < 32) p.out[OUT_SSD + ((size_t)((seq * 2 + l) * 2 + dir) * 12 + head) * 4096 + pn] = hs;
}
DI void ph_ssdfinal(const P& p, int l) {
  const int tid_ = otid(), lane = tid_ & 63, wave = __builtin_amdgcn_readfirstlane(tid_ >> 6);
  const u16* proj = (const u16*)(p.ws + O_PROJ);
  const u16* yf = (const u16*)(p.ws + O_Y);
  u16* mix = (u16*)(p.ws + O_MIX);
  for (int r = blockIdx.x * 8 + wave; r < T; r += gridDim.x * 8) {
    float y[12]; float ss = 0.f;
#pragma unroll
    for (int i = 0; i < 3; ++i) {
      int c = i * 256 + lane * 4;
      s16x4 a = *(const s16x4*)(yf + (size_t)r * 768 + c);
      s16x4 z = *(const s16x4*)(proj + (size_t)r * NP + C_Z + c);
#pragma unroll
      for (int e = 0; e < 4; ++e) { float v = bfs(a[e]) * siluf(bfs(z[e])); y[i * 4 + e] = v; ss += v * v; }
    }
    ss = wsum(ss); float rs = rsqrtf(ss * (1.f / 768.f) + 1e-6f);
#pragma unroll
    for (int i = 0; i < 3; ++i) {
      int c = i * 256 + lane * 4;
      float4 w = *(const float4*)(pin(p, I_SSDN) + l * 768 + c);
      s16x4 o; o[0] = (short)f2bf(y[i * 4] * rs * w.x); o[1] = (short)f2bf(y[i * 4 + 1] * rs * w.y); o[2] = (short)f2bf(y[i * 4 + 2] * rs * w.z); o[3] = (short)f2bf(y[i * 4 + 3] * rs * w.w);
      *(s16x4*)(mix + (size_t)r * DM + c) = o;
    }
  }
}
struct AttState { float m, lsum; f32x16 o0, o1; };
struct AttKV { bf16x8 k[4]; bf16x8 v[4]; };

constexpr int ATT_KS = 72, ATT_VS = 264, ATT_VOFF = 256 * ATT_KS;
DI void attn_load_lds(AttKV& t, const LAS u16* sk, const LAS u16* sv, int j, int r, int h) {
  const LAS u16* kp = sk + (j * 32 + pi23(r)) * ATT_KS + 8 * h;
#pragma unroll
  for (int ks = 0; ks < 4; ++ks) t.k[ks] = *(const LAS bf16x8*)(kp + ks * 16);
  const LAS u16* vp = sv + r * ATT_VS + j * 32 + 8 * h;
#pragma unroll
  for (int sp = 0; sp < 2; ++sp) { t.v[sp * 2 + 0] = *(const LAS bf16x8*)(vp + 16 * sp); t.v[sp * 2 + 1] = *(const LAS bf16x8*)(vp + 32 * ATT_VS + 16 * sp); }
}
DI void attn_compute(AttState& st, const bf16x8 (&qf)[4], const AttKV& t, bool mask, int h, int qi, int k0) {
  f32x16 s;
#pragma unroll
  for (int i = 0; i < 16; ++i) s[i] = 0.f;
#pragma unroll
  for (int ks = 0; ks < 4; ++ks) s = __builtin_amdgcn_mfma_f32_32x32x16_bf16(t.k[ks], qf[ks], s, 0, 0, 0);
  float mt = -1e30f;
#pragma unroll
  for (int i = 0; i < 16; ++i) {
    float v = s[i] * 0.125f;
    if (mask) { int d = qi - (k0 + pi23(crow(i, h))); if (d > 128 || d < -128) v = -1e30f; }
    s[i] = v; mt = fmaxf(mt, v);
  }
  mt = fmaxf(mt, __shfl_xor(mt, 32));
  float mn = fmaxf(st.m, mt), alpha = __expf(st.m - mn);
  st.m = mn;
  float ps = 0.f;
#pragma unroll
  for (int i = 0; i < 16; ++i) { float e = __expf(s[i] - mn); s[i] = e; ps += e; }
  st.lsum = st.lsum * alpha + ps;
#pragma unroll
  for (int i = 0; i < 16; ++i) { st.o0[i] *= alpha; st.o1[i] *= alpha; }
#pragma unroll
  for (int sp = 0; sp < 2; ++sp) {
    bf16x8 pf = pack8(s[8 * sp], s[8 * sp + 1], s[8 * sp + 2], s[8 * sp + 3], s[8 * sp + 4], s[8 * sp + 5], s[8 * sp + 6], s[8 * sp + 7]);
    st.o0 = __builtin_amdgcn_mfma_f32_32x32x16_bf16(t.v[sp * 2 + 0], pf, st.o0, 0, 0, 0);
    st.o1 = __builtin_amdgcn_mfma_f32_32x32x16_bf16(t.v[sp * 2 + 1], pf, st.o1, 0, 0, 0);
  }
}
DI void attn_item(const P& p, int l, int item, LAS char* shm) {
  const int tid_ = otid(), lane = tid_ & 63, wave = __builtin_amdgcn_readfirstlane(tid_ >> 6), r = lane & 31, h = lane >> 5;
  int seq, head, q0b, b = 0; bool lat;
  if (item < 768) { lat = true; b = item / 192; head = (item >> 4) % 12; q0b = (item & 15) * 256; seq = 32 + b; }
  else { int it2 = item - 768; lat = false; seq = it2 / 12; head = it2 % 12; q0b = 0; }
  const int q0 = q0b + wave * 32, kvh = head / 3, L = lat ? 4096 : 256;
  const int seqstart = seq < 32 ? seq * 256 : TC + (seq - 32) * 4096;
  const u16* proj = (const u16*)(p.ws + O_PROJ);
  bf16x8 qf[4];
  { const u16* qrow = proj + (size_t)(seqstart + q0 + r) * NP + C_Q + head * 64;
#pragma unroll
    for (int ks = 0; ks < 4; ++ks) qf[ks] = *(const bf16x8*)(qrow + ks * 16 + 8 * h); }
  AttState st; st.m = pin(p, I_SINK)[l * 12 + head]; st.lsum = h == 0 ? 1.f : 0.f;
#pragma unroll
  for (int i = 0; i < 16; ++i) { st.o0[i] = 0.f; st.o1[i] = 0.f; }
  const u16* kself = proj + (size_t)seqstart * NP + C_K + kvh * 64;
  const u16* vself = (const u16*)(p.ws + O_VT) + (size_t)(kvh * 64) * T + seqstart;
  const u16* kc = (const u16*)(p.ws + O_KC) + (size_t)((l * 4 + b) * 4 + kvh) * 512 * 64;
  const u16* vc = (const u16*)(p.ws + O_VCT) + (size_t)((l * 4 + b) * 4 + kvh) * 64 * 512;
  LAS u16* sk = (LAS u16*)shm; LAS u16* sv = sk + ATT_VOFF;
  const int ns = lat ? 4 : 1, kb0 = lat ? q0b - 128 : 0, qi = q0 + r;
  const int krow = tid_ >> 1, khalf = tid_ & 1, vd = tid_ >> 3, vseg = tid_ & 7;
  bf16x8 kreg[4], vreg[4];
#define ATT_STAGE_LOAD(s_) do { const int s__ = (s_); \
    if (lat && s__ < 2) { const u16* kp_ = kc + (size_t)(s__ * 256 + krow) * 64 + khalf * 32; const u16* vp_ = vc + (size_t)vd * 512 + s__ * 256 + vseg * 32; \
      _Pragma("unroll") for (int q_ = 0; q_ < 4; ++q_) { kreg[q_] = *(const bf16x8*)(kp_ + q_ * 8); vreg[q_] = *(const bf16x8*)(vp_ + q_ * 8); } } \
    else { const int kb_ = kb0 + 256 * (lat ? s__ - 2 : 0); const int key_ = kb_ + krow, vk_ = kb_ + vseg * 32; \
      if (key_ >= 0 && key_ < L) { const u16* kp_ = kself + (size_t)key_ * NP + khalf * 32; _Pragma("unroll") for (int q_ = 0; q_ < 4; ++q_) kreg[q_] = *(const bf16x8*)(kp_ + q_ * 8); } \
      if (vk_ >= 0 && vk_ < L) { const u16* vp_ = vself + (size_t)vd * T + vk_; _Pragma("unroll") for (int q_ = 0; q_ < 4; ++q_) vreg[q_] = *(const bf16x8*)(vp_ + q_ * 8); } } } while (0)
  ATT_STAGE_LOAD(0);
#pragma unroll 1
  for (int s = 0; s < ns; ++s) {
    __syncthreads();
#pragma unroll
    for (int q = 0; q < 4; ++q) { *(LAS bf16x8*)(sk + krow * ATT_KS + khalf * 32 + q * 8) = kreg[q]; *(LAS bf16x8*)(sv + vd * ATT_VS + vseg * 32 + q * 8) = vreg[q]; }
    __syncthreads();
    if (s + 1 < ns) ATT_STAGE_LOAD(s + 1);
    const bool band = lat && s >= 2;
    const int kb = band ? kb0 + 256 * (s - 2) : 0;
    int j0 = 0, j1 = 8;
    if (band) { int lo = max(max(0, q0 - 128), kb), hi = min(min(4096, q0 + 160), kb + 256); j0 = (lo - kb) >> 5; j1 = (hi - kb) >> 5; if (j1 < j0) j1 = j0; }
    AttKV ta, tb;
    if (j0 < j1) attn_load_lds(ta, sk, sv, j0, r, h);
#pragma unroll 1
    for (int j = j0; j < j1; j += 2) {
      if (j + 1 < j1) attn_load_lds(tb, sk, sv, j + 1, r, h);
      attn_compute(st, qf, ta, band, h, qi, kb + 32 * j);
      if (j + 1 < j1) {
        if (j + 2 < j1) attn_load_lds(ta, sk, sv, j + 2, r, h);
        attn_compute(st, qf, tb, band, h, qi, kb + 32 * (j + 1));
      }
    }
  }
#undef ATT_STAGE_LOAD
  float lt = st.lsum + __shfl_xor(st.lsum, 32), inv = 1.f / lt;
  u16* orow = (u16*)(p.ws + O_MIX) + (size_t)(seqstart + q0 + r) * DM + 768 + head * 64;
#pragma unroll
  for (int gq = 0; gq < 4; ++gq) {
    s16x4 a, bq;
#pragma unroll
    for (int e = 0; e < 4; ++e) { a[e] = (short)f2bf(st.o0[gq * 4 + e] * inv); bq[e] = (short)f2bf(st.o1[gq * 4 + e] * inv); }
    *(s16x4*)(orow + 8 * gq + 4 * h) = a; *(s16x4*)(orow + 32 + 8 * gq + 4 * h) = bq;
  }
  __syncthreads();
}

#ifdef TPROBE
#define TSTAMP(k) do { if (blockIdx.x == 0 && otid() == 0) ((unsigned long long*)(p0.ws + O_END2))[(k)] = wall_clock64(); } while (0)
#else
#define TSTAMP(k) do { } while (0)
#endif
#define PH_BEGIN(k) if (p0.lo <= (k) && (k) < p0.hi) { P p; p.inp = p0.in; p.out = p0.out; p.ws = p0.ws; p.lo = p0.lo; p.hi = p0.hi; \
    asm volatile("" : "+s"(p.out), "+s"(p.ws)); const int G = gridDim.x, bid = blockIdx.x; (void)G; (void)bid;
#define PH_END(k) if ((k) + 1 < p0.hi) { if ((k) == 0) grid.sync(); else xcd_barrier(xb); } TSTAMP((k) + 1); }

template <int l>
DI void layer_phases(const P& p0, cg::grid_group& grid, const XcdBarrier& xb, LAS char* shm) {
  constexpr int B = 2 + 11 * l;
  PH_BEGIN(B + 0) for (int rep = 0; rep < NREP(0); ++rep) { EpiProj e{(u16*)(p.ws + O_PROJ), (float*)(p.ws + O_DT), p.out, l};
    gemm_phase((const u16*)(p.ws + O_H), (const u16*)(p.ws + O_WIN) + (size_t)l * NP * DM, T, NP, DM, e, shm, 0); } PH_END(B + 0)
  PH_BEGIN(B + 1) for (int rep = 0; rep < NREP(1); ++rep) {
    constexpr int N0 = 1536, N1 = N0 + 6144, N2 = N1 + 1024, N3 = N2 + 1536, N4 = N3 + 192;
    for (int it = bid; it < N4; it += G) {
      if (it < N0) s5p1_item(p, l, it); else if (it < N1) prep_item(p, l, it - N0, shm); else if (it < N2) { if (rep == 0) rope_item(p, it - N1); } else if (it < N3) vt_item(p, it - N2, shm); else cum_item(p, l, it - N3);
    } } PH_END(B + 1)
  PH_BEGIN(B + 2) for (int rep = 0; rep < NREP(2); ++rep) {
    constexpr int N0 = 576, N1 = N0 + 768 + 384, N2 = N1 + 288;
    for (int it = bid; it < N2; it += G) {
      if (it < N0) ssd_p1_item(p, l, it, shm); else if (it < N1) attn_item(p, l, it - N0, shm); else if (rep == 0) s5comb_item(p, l, it - N1);
    } } PH_END(B + 2)
  PH_BEGIN(B + 3) for (int rep = 0; rep < NREP(3); ++rep) {
    constexpr int N0 = 768, N1 = N0 + 6912;
    for (int it = bid; it < N1; it += G) { if (it < N0) s5p2_item(p, l, it, shm); else if (rep == 0) ssdcomb_item(p, l, it - N0); }
    } PH_END(B + 3)
  PH_BEGIN(B + 4) for (int rep = 0; rep < NREP(4); ++rep) {
    for (int it = bid; it < 1152; it += G) ssd_p2_item(p, l, it, shm);
    __syncthreads();
    EpiGlu e{(const u16*)(p.ws + O_G5), pin(p, I_BGLU) + l * 512, (u16*)(p.ws + O_MIX)};
    gemm_phase((const u16*)(p.ws + O_G5), (const u16*)(p.ws + O_WGLU) + (size_t)l * 512 * 512, T, 512, 512, e, shm, 64);
    } PH_END(B + 4)
  PH_BEGIN(B + 5) for (int rep = 0; rep < NREP(5); ++rep) { ph_ssdfinal(p, l); } PH_END(B + 5)
  PH_BEGIN(B + 6) for (int rep = 0; rep < NREP(6); ++rep) { EpiBf16 e{(u16*)(p.ws + O_H)};
    gemm_phase((const u16*)(p.ws + O_MIX), (const u16*)(p.ws + O_WOUT) + (size_t)l * DM * DM, T, DM, DM, e, shm, 0); } PH_END(B + 6)
  PH_BEGIN(B + 7) { const float* modl = (const float*)(p.ws + O_MOD) + (size_t)l * 5 * 12288;
    ph_row<(l == 0 ? 1 : 2), 1>(p, pin(p, I_NMPOST) + l * DM, 4096, pin(p, I_NFPRE) + l * DM, modl, 6144, 8192, modl, (const u16*)p.out, (u16*)(p.ws + O_XB)); } PH_END(B + 7)
  PH_BEGIN(B + 8) for (int rep = 0; rep < NREP(8); ++rep) { EpiSwiglu e{(u16*)(p.ws + O_ACT)};
    gemm_phase((const u16*)(p.ws + O_H), (const u16*)(p.ws + O_WFFI) + (size_t)l * 2 * DFF * DM, T, 2 * DFF, DM, e, shm, 0); } PH_END(B + 8)
  PH_BEGIN(B + 9) for (int rep = 0; rep < NREP(9); ++rep) { EpiBf16 e{(u16*)(p.ws + O_H)};
    gemm_phase((const u16*)(p.ws + O_ACT), (const u16*)(p.ws + O_WFFO) + (size_t)l * DM * DFF, T, DM, DFF, e, shm, 0); } PH_END(B + 9)
  PH_BEGIN(B + 10) { const float* modl = (const float*)(p.ws + O_MOD) + (size_t)l * 5 * 12288;
    constexpr bool last = (l == 1);
    ph_row<2, (last ? 0 : 1)>(p, pin(p, I_NFPOST) + l * DM, 10240, last ? nullptr : pin(p, I_NMPRE) + (l + 1) * DM, last ? modl : modl + 5 * 12288, 0, 2048, modl, (const u16*)(p.ws + O_XB), (u16*)p.out);
    } PH_END(B + 10)
}

__global__ void __launch_bounds__(512) mega(P p0) {
  extern __shared__ __attribute__((aligned(16))) char dyn_smem[];
  LAS char* shm = (LAS char*)dyn_smem;
  cg::grid_group grid = cg::this_grid();
  volatile LAS unsigned* xst = (volatile LAS unsigned*)(shm + 139264);
  if (threadIdx.x < 4) xst[threadIdx.x] = 0u;
  __syncthreads();
  XcdBarrier xb = xcd_barrier_post((unsigned*)(p0.ws + O_BAR), xst);
  TSTAMP(0);
  PH_BEGIN(0) for (int rep = 0; rep < NREP(11); ++rep) { ph_init(p, shm, rep); } PH_END(0)
  PH_BEGIN(1) for (int rep = 0; rep < NREP(12); ++rep) { ph_prenorm(p); } PH_END(1)
  layer_phases<0>(p0, grid, xb, shm);
  layer_phases<1>(p0, grid, xb, shm);
#ifdef TPROBE
  PH_BEGIN(NPH) {
#define TFILL(a, o0, o1) do { const unsigned long long* ts = (const unsigned long long*)(p.ws + O_END2); \
    unsigned long long d = ((a) >= 0) ? ts[(a) + 1] - ts[(a)] : ts[NPH - 1] - ts[0]; size_t n = (size_t)(d / 2); if (n > (size_t)(o1) - (o0)) n = (size_t)(o1) - (o0); \
    for (size_t i = (size_t)blockIdx.x * 512 + otid(); i < n; i += (size_t)gridDim.x * 512) ((unsigned*)p.out)[(o0) + i] = 0xAAAAAAAAu; } while (0)
    TFILL(TP0, 0, 16777216); TFILL(TP1, 16777216, OUT_CK); TFILL(TP2, OUT_CK, OUT_CV); TFILL(TP3, OUT_CV, OUT_SSD);
    TFILL(TP4, OUT_SSD, OUT_S5R); TFILL(TP5, OUT_S5R, OUT_S5I); TFILL(TP6, OUT_S5I, 65536000);
  } }
#endif
}

extern "C" void kernel_launch(void* const* d_in, const int* in_sizes, int n_in, void* d_out, int out_size, void* d_ws, size_t ws_size, hipStream_t stream) {
  static int grid_blocks = 0;
  if (!grid_blocks) {
    if (n_in != N_IN || ws_size < O_END3) { fprintf(stderr, "kernel_launch: bad n_in %d or ws %zu < %zu\n", n_in, ws_size, (size_t)O_END); grid_blocks = -1; return; }
    int dev = 0, cus = 0, per_cu = 0;
    hipGetDevice(&dev);
    hipDeviceGetAttribute(&cus, hipDeviceAttributeMultiprocessorCount, dev);
    hipFuncSetAttribute((const void*)mega, hipFuncAttributeMaxDynamicSharedMemorySize, DYN_LDS);
    hipOccupancyMaxActiveBlocksPerMultiprocessor(&per_cu, (const void*)mega, 512, DYN_LDS);
    if (per_cu < 1) per_cu = 1;
    grid_blocks = cus * per_cu;
    if (grid_blocks % 8) grid_blocks -= grid_blocks % 8;
  }
  if (grid_blocks < 0) return;
  hipMemsetAsync((char*)d_ws + O_MOD, 0, 491520 + 16384, stream);
  P p{};
  for (int i = 0; i < N_IN; ++i) p.in[i] = (const float*)d_in[i];
  p.out = (float*)d_out; p.ws = (char*)d_ws;
#if MULTI_LAUNCH
  for (int ph = 0; ph < NPH_RUN; ++ph) {
    p.lo = ph; p.hi = ph + 1;
    hipLaunchKernelGGL(mega, dim3(grid_blocks), dim3(512), DYN_LDS, stream, p);
  }
#else
#ifdef TPROBE
  p.lo = 0; p.hi = NPH + 1;
#else
  p.lo = 0; p.hi = NPH;
#endif
  void* args[] = {&p};
  hipError_t e = hipLaunchCooperativeKernel((const void*)mega, dim3(grid_blocks), dim3(512), args, DYN_LDS, stream);
  if (e != hipSuccess) fprintf(stderr, "cooperative launch failed: %s (grid %d)\n", hipGetErrorString(e), grid_blocks);
#endif
}
```

```cpp
#include <hip/hip_runtime.h>
#include <hip/hip_bf16.h>
#include <hip/hip_cooperative_groups.h>
#include <cstdio>
namespace cg = cooperative_groups;

#ifndef PHMASK
#define PHMASK 0xFFFFu
#endif
#define PHON(b) ((PHMASK >> (b)) & 1u)
#ifndef DUPMASK
#define DUPMASK 0u
#endif
#define NREP(b) (1 + (int)((DUPMASK >> (b)) & 1u))
#ifndef MULTI_LAUNCH
#define MULTI_LAUNCH 0
#endif

typedef unsigned short u16;
using bf16x8 = __attribute__((ext_vector_type(8))) short;
using s16x4 = __attribute__((ext_vector_type(4))) short;
using f32x4 = __attribute__((ext_vector_type(4))) float;
using f32x16 = __attribute__((ext_vector_type(16))) float;
#define DI __device__ __forceinline__
#define LAS __attribute__((address_space(3)))

constexpr int T = 24576, TC = 8192, DM = 2048, NP = 3840, DFF = 5632, DIN = 3608;
constexpr int C_Z = 0, C_X = 768, C_B = 1536, C_C = 1664, C_Q = 1792, C_K = 2560, C_V = 2816, C_U = 3072, C_DT = 3584;
constexpr int NPH = 24;
#ifndef NPH_RUN
#define NPH_RUN NPH
#endif
constexpr int DYN_LDS = 139264 + 16;

constexpr size_t OUT_X = 0, OUT_CK = 50331648, OUT_CV = 54525952, OUT_SSD = 58720256, OUT_S5R = 65011712, OUT_S5I = 65273856;

constexpr size_t O_WIN = 0;
constexpr size_t O_WOUT = O_WIN + 31457280;
constexpr size_t O_WFFI = O_WOUT + 16777216;
constexpr size_t O_WFFO = O_WFFI + 92274688;
constexpr size_t O_WGLU = O_WFFO + 46137344;
constexpr size_t O_MOD = O_WGLU + 1048576;
constexpr size_t O_BAR = O_MOD + 491520;
constexpr size_t O_S5T = O_BAR + 16384;
constexpr size_t O_KC = O_S5T + 1179648;
constexpr size_t O_VCT = O_KC + 2097152;
constexpr size_t O_DT = O_VCT + 2097152;
constexpr size_t O_DTV = O_DT + 3145728;
constexpr size_t O_CDEC = O_DTV + 3145728;
constexpr size_t O_S5S = O_CDEC + 32768;
constexpr size_t O_SST = O_S5S + 6291456;
constexpr size_t O_G5 = O_SST + 75497472;
constexpr size_t O_VT = O_G5 + 25165824;
constexpr size_t O_PROJ = O_VT + 12582912;
constexpr size_t O_MIX = O_PROJ + 188743680;
constexpr size_t O_H = O_MIX + 100663296;
constexpr size_t O_XC = O_H;
constexpr size_t O_YF = O_XC + 50331648;
constexpr size_t O_YB = O_YF + 37748736;
constexpr size_t O_END = O_YB + 37748736;
constexpr size_t O_DTW = O_END;
constexpr size_t O_XCT = O_DTW + 2359296;
constexpr size_t O_END2 = O_XCT + 50331648;
constexpr size_t O_END3 = O_END2 + 4096;
constexpr size_t O_CUM = O_DTV;
constexpr size_t O_Y = O_YF;
constexpr size_t O_S5H = O_YB;
constexpr size_t O_ACT = O_PROJ;
constexpr int S5T_L = 147456;

enum { I_XP = 0, I_XS, I_C, I_CK, I_CV, I_SSD, I_S5R, I_S5I, I_CCTX, I_WADA, I_BADA, I_NMPRE, I_NMPOST, I_NFPRE, I_NFPOST,
       I_WIN, I_WOUT, I_CONVW, I_CONVB, I_DTB, I_ALOG, I_SSDD, I_SSDN, I_SINK, I_ARE, I_AIM, I_LOGDT, I_BRE, I_BIM, I_CRE, I_CIM,
       I_S5D, I_WGLU, I_BGLU, I_WFFI, I_WFFO, N_IN };

struct P {
  const float* in[N_IN];
  float* out;
  char* ws;
  int lo, hi;
  const float* const* inp;
};

DI const float* pin(const P& p, int i) { asm volatile("" : "+s"(i)); return p.inp[i]; }
DI int otid() { int t = threadIdx.x; asm volatile("" : "+v"(t)); return t; }
DI u16 f2bf(float x) { unsigned u = __float_as_uint(x); u += 0x7fffu + ((u >> 16) & 1u); return (u16)(u >> 16); }
DI unsigned cvt_pk_bf16(float a, float b) { unsigned r; asm("v_cvt_pk_bf16_f32 %0, %1, %2" : "=v"(r) : "v"(a), "v"(b)); return r; }
using u32x4 = __attribute__((ext_vector_type(4))) unsigned;
DI bf16x8 pack8(float a0, float a1, float a2, float a3, float a4, float a5, float a6, float a7) {
  u32x4 q;
  asm volatile("v_cvt_pk_bf16_f32 %0, %4, %5\n\tv_cvt_pk_bf16_f32 %1, %6, %7\n\tv_cvt_pk_bf16_f32 %2, %8, %9\n\tv_cvt_pk_bf16_f32 %3, %10, %11\n\ts_nop 1"
               : "=&v"(q[0]), "=&v"(q[1]), "=&v"(q[2]), "=&v"(q[3]) : "v"(a0), "v"(a1), "v"(a2), "v"(a3), "v"(a4), "v"(a5), "v"(a6), "v"(a7));
  return __builtin_bit_cast(bf16x8, q);
}
DI float bf2f(u16 h) { return __uint_as_float(((unsigned)h) << 16); }
DI float bfs(short h) { return __uint_as_float(((unsigned)(u16)h) << 16); }
DI float wsum(float v) { for (int o = 32; o > 0; o >>= 1) v += __shfl_xor(v, o); return v; }
DI float siluf(float x) { return x * __builtin_amdgcn_rcpf(1.f + __expf(-x)); }
DI void sincos_acc(float x, float& sn, float& cs) {
  float n = rintf(x * 0.63661977236758f);
  float r = fmaf(n, -1.5707962513e+0f, x);
  r = fmaf(n, -7.5497899549e-8f, r);
  float r2 = r * r;
  float sp = fmaf(r * r2, fmaf(r2, fmaf(r2, -1.9515295891e-4f, 8.3321608736e-3f), -1.6666654611e-1f), r);
  float cp = fmaf(r2, fmaf(r2, fmaf(r2, fmaf(r2, 2.443315711809948e-5f, -1.388731625493765e-3f), 4.166664568298827e-2f), -0.5f), 1.f);
  int q = ((int)n) & 3;
  sn = (q == 0) ? sp : (q == 1) ? cp : (q == 2) ? -sp : -cp;
  cs = (q == 0) ? cp : (q == 1) ? -sp : (q == 2) ? -cp : sp;
}
DI int crow(int i, int h) { return (i & 3) + 8 * (i >> 2) + 4 * h; }
DI int pi23(int m) { return (m & ~12) | ((m & 4) << 1) | ((m & 8) >> 1); }
DI int modrow(int t) { return t < TC ? 0 : 1 + ((t - TC) >> 12); }
DI void chunk_info(int gc, int& seq, int& c, int& nc) {
  if (gc < 64) { seq = gc >> 1; c = gc & 1; nc = 2; } else { seq = 32 + ((gc - 64) >> 5); c = (gc - 64) & 31; nc = 32; }
}
DI int chunk_of(int seq, int c) { return seq < 32 ? seq * 2 + c : 64 + (seq - 32) * 32 + c; }


#define XB_TMO      128
#define XB_XCNT(j)  (256  + 64 * (j))
#define XB_XSUB(j)  (1280 + 64 * (j))
#define XB_XGEN(j)  (2304 + 64 * (j))
#define XB_TOP      3328
#define XB_TOPGEN   3392
#define XCD_BAR_WORDS 3456
#define XB_SPIN_CAP (1u << 21)
DI unsigned xb_ld(unsigned* p) { return __hip_atomic_load(p, __ATOMIC_RELAXED, __HIP_MEMORY_SCOPE_AGENT); }
DI unsigned xb_add(unsigned* p, unsigned v) { return __hip_atomic_fetch_add(p, v, __ATOMIC_RELAXED, __HIP_MEMORY_SCOPE_AGENT); }
DI unsigned xb_xcc_id() { return (unsigned)__builtin_amdgcn_s_getreg((3 << 11) | 20) & 0xFu; }
#define XB_SPIN(cond, bar) do { unsigned _sp = 0; while (cond) { __builtin_amdgcn_s_sleep(1); \
    if ((++_sp & 255u) == 0u) { if (xb_ld(&(bar)[XB_TMO])) break; if (_sp > XB_SPIN_CAP) { atomicAdd(&(bar)[XB_TMO], 1u); break; } } } } while (0)
struct XcdBarrier { unsigned* bar; unsigned x; volatile LAS unsigned* st; };
DI XcdBarrier xcd_barrier_post(unsigned* bar, volatile LAS unsigned* st) {
  XcdBarrier b; b.bar = bar; b.x = xb_xcc_id(); b.st = st;
  if (threadIdx.x == 0) (void)xb_add(&bar[XB_XCNT(b.x)], 1u);
  return b;
}
DI void xcd_barrier_complete(unsigned* bar, unsigned x, unsigned& nloc, unsigned& nx) {
  const unsigned G = gridDim.x * gridDim.y * gridDim.z;
  unsigned sum, cnt, mine, sp = 0u;
  for (;;) {
    sum = 0u; cnt = 0u; mine = 0u;
#pragma unroll
    for (unsigned j = 0; j < 16; ++j) { const unsigned c = xb_ld(&bar[XB_XCNT(j)]); sum += c; cnt += (c > 0u) ? 1u : 0u; mine = (j == x) ? c : mine; }
    if (sum == G) break;
    __builtin_amdgcn_s_sleep(1);
    if ((++sp & 255u) == 0u) { if (xb_ld(&bar[XB_TMO])) break; if (sp > XB_SPIN_CAP) { atomicAdd(&bar[XB_TMO], 1u); break; } }
  }
  nloc = mine > 0u ? mine : 1u; nx = cnt > 0u ? cnt : 1u;
}
DI void xcd_barrier(const XcdBarrier& b) {
  asm volatile("s_waitcnt vmcnt(0)" ::: "memory");
  __syncthreads();
  if (threadIdx.x == 0) {
    unsigned* bar = b.bar;
    __builtin_amdgcn_s_waitcnt(0);
    unsigned nloc = b.st[0], nx = b.st[1];
    if (nloc == 0u) { xcd_barrier_complete(bar, b.x, nloc, nx); b.st[0] = nloc; b.st[1] = nx; }
    const unsigned old = xb_add(&bar[XB_XSUB(b.x)], 1u);
    const unsigned gen = old / nloc;
    if (old + 1u == (gen + 1u) * nloc) {
      __builtin_amdgcn_fence(__ATOMIC_RELEASE, "agent");
      asm volatile("s_waitcnt vmcnt(0)" ::: "memory");
      const unsigned og = xb_add(&bar[XB_TOP], 1u);
      const unsigned tg = og / nx;
      if (og + 1u == (tg + 1u) * nx) xb_add(&bar[XB_TOPGEN], 1u);
      else XB_SPIN(xb_ld(&bar[XB_TOPGEN]) == tg, bar);
      __builtin_amdgcn_fence(__ATOMIC_ACQUIRE, "agent");
      xb_add(&bar[XB_XGEN(b.x)], 1u);
      asm volatile("s_waitcnt vmcnt(0)" ::: "memory");
    } else {
      XB_SPIN(xb_ld(&bar[XB_XGEN(b.x)]) == gen, bar);
      __builtin_amdgcn_fence(__ATOMIC_ACQUIRE, "agent");
      asm volatile("s_waitcnt vmcnt(0)" ::: "memory");
    }
  }
  __syncthreads();
}

constexpr int BM = 256, BK = 64, HALF = 128, HT = HALF * BK;
DI int lds_byte(int r, int c) {
  int st = (r >> 4) * 2 + (c >> 5), rr = r & 15, cc = c & 31, ob = rr * 64 + cc * 2;
  return st * 1024 + (ob ^ (((ob >> 9) & 1) << 5));
}
DI void stage_rc(int b, int& R, int& C) {
  int st = b / 1024, sb = b % 1024, swz = sb ^ (((sb >> 9) & 1) << 5);
  R = (st >> 1) * 16 + swz / 64; C = (st & 1) * 32 + (swz % 64) / 2;
}

struct EpiProj {
  u16* proj; float* dt; float* out; int l;
  DI void apply(int row0, int col0, int fr, const f32x4& v0, const f32x4& v1) const {
#pragma unroll
    for (int n = 0; n < 2; ++n) {
      const f32x4& v = n ? v1 : v0;
      int col = col0 + n * 16;
      { unsigned a = cvt_pk_bf16(v[0], v[1]), b = cvt_pk_bf16(v[2], v[3]); u16* q = proj + (size_t)row0 * NP + col;
        q[0] = (u16)a; q[NP] = (u16)(a >> 16); q[2 * NP] = (u16)b; q[3 * NP] = (u16)(b >> 16); }
      if (col >= C_DT && col < C_DT + 24) {
#pragma unroll
        for (int j = 0; j < 4; ++j) dt[(size_t)(row0 + j) * 32 + (col - C_DT)] = v[j];
      }
      if (col >= C_K && col < C_U && row0 < TC) {
        float* o = out + (col < C_V ? OUT_CK : OUT_CV);
        int cc = (col - C_K) & 255;
#pragma unroll
        for (int j = 0; j < 4; ++j) { int r = row0 + j; o[(size_t)((r >> 8) * 512 + l * 256 + (r & 255)) * 256 + cc] = v[j]; }
      }
    }
  }
};
struct EpiBf16 {
  u16* dst;
  DI void apply(int row0, int col0, int fr, const f32x4& v0, const f32x4& v1) const {
    unsigned a = cvt_pk_bf16(v0[0], v0[1]), b = cvt_pk_bf16(v0[2], v0[3]), c = cvt_pk_bf16(v1[0], v1[1]), d = cvt_pk_bf16(v1[2], v1[3]);
    u16* q = dst + (size_t)row0 * DM + col0;
    q[0] = (u16)a; q[DM] = (u16)(a >> 16); q[2 * DM] = (u16)b; q[3 * DM] = (u16)(b >> 16);
    q[16] = (u16)c; q[DM + 16] = (u16)(c >> 16); q[2 * DM + 16] = (u16)d; q[3 * DM + 16] = (u16)(d >> 16);
  }
};
struct EpiSwiglu {
  u16* act;
  DI void apply(int row0, int col0, int fr, const f32x4& v0, const f32x4& v1) const {
    int ac = ((col0 - fr) >> 1) + fr;
    unsigned a = cvt_pk_bf16(siluf(v0[0]) * v1[0], siluf(v0[1]) * v1[1]), b = cvt_pk_bf16(siluf(v0[2]) * v1[2], siluf(v0[3]) * v1[3]);
    u16* q = act + (size_t)row0 * DFF + ac;
    q[0] = (u16)a; q[DFF] = (u16)(a >> 16); q[2 * DFF] = (u16)b; q[3 * DFF] = (u16)(b >> 16);
  }
};
struct EpiGlu {
  const u16* g5; const float* b; u16* mix;
  DI void apply(int row0, int col0, int fr, const f32x4& v0, const f32x4& v1) const {
#pragma unroll
    for (int n = 0; n < 2; ++n) {
      const f32x4& v = n ? v1 : v0;
      int col = col0 + n * 16; float bb = b[col];
#pragma unroll
      for (int j = 0; j < 4; ++j) {
        float g = bf2f(g5[(size_t)(row0 + j) * 512 + col]);
        mix[(size_t)(row0 + j) * DM + 1536 + col] = f2bf(g * __builtin_amdgcn_rcpf(1.f + __expf(-(v[j] + bb))));
      }
    }
  }
};

template <class Epi>
__device__ __forceinline__ void gemm_tile(const u16* __restrict__ A, const u16* __restrict__ Bt, int K, int brow, int bcol, const Epi& epi, LAS char* shm, bool prefetched, int nbrow, int nbcol) {
#define SA(b, h) (shm + ((b) * 2 + (h)) * (HT * 2))
#define SB(b, h) (shm + (4 + (b) * 2 + (h)) * (HT * 2))
#define STAGE(Pp, BASE, br, kt) do { const char* _gb = (const char*)(BASE) + ((long)(br) * K + (long)(kt) * BK) * 2; \
    __builtin_amdgcn_global_load_lds((const unsigned*)(_gb + voff0), (LAS unsigned*)((Pp) + ldsw), 16, 0, 0); \
    __builtin_amdgcn_global_load_lds((const unsigned*)(_gb + voff1), (LAS unsigned*)((Pp) + ldsw + 8192), 16, 0, 0); } while (0)
#define LDA(dst, b, h) _Pragma("unroll") for (int m = 0; m < 4; ++m) _Pragma("unroll") for (int k = 0; k < 2; ++k) \
    dst[m][k] = *(const LAS bf16x8*)(SA(b, h) + aoff + m * 2048 + k * 1024)
#define LDB(dst, b, h) _Pragma("unroll") for (int n = 0; n < 2; ++n) _Pragma("unroll") for (int k = 0; k < 2; ++k) \
    dst[n][k] = *(const LAS bf16x8*)(SB(b, h) + boff + n * 2048 + k * 1024)
#define MMA(ai, bj, At_, Bt_) do { __builtin_amdgcn_s_setprio(1); \
    _Pragma("unroll") for (int m = 0; m < 4; ++m) _Pragma("unroll") for (int n = 0; n < 2; ++n) _Pragma("unroll") for (int k = 0; k < 2; ++k) \
      acc[ai][bj][m][n] = __builtin_amdgcn_mfma_f32_16x16x32_bf16(At_[m][k], Bt_[n][k], acc[ai][bj][m][n], 0, 0, 0); \
    __builtin_amdgcn_s_setprio(0); } while (0)
#define WAIT_V(n) asm volatile("s_waitcnt vmcnt(" #n ")" ::: "memory")
#define WAIT_L(n) asm volatile("s_waitcnt lgkmcnt(" #n ")" ::: "memory")
#define BAR __builtin_amdgcn_s_barrier()
#define SCHED __builtin_amdgcn_sched_barrier(0)
  const int tid_ = otid(), wid = __builtin_amdgcn_readfirstlane(tid_ >> 6), lane = tid_ & 63, wr = wid >> 2, wc = wid & 3, fr = lane & 15, fq = lane >> 4;
  const int ldsw = tid_ * 16;
  unsigned voff0, voff1;
  { int r_, c_; stage_rc(ldsw, r_, c_); voff0 = (unsigned)(r_ * K + c_) * 2u; stage_rc(ldsw + 8192, r_, c_); voff1 = (unsigned)(r_ * K + c_) * 2u; }
  const int aoff = lds_byte(wr * 64 + fr, fq * 8), boff = lds_byte(wc * 32 + fr, fq * 8);
  f32x4 acc[2][2][4][2];
#pragma unroll
  for (int a = 0; a < 2; ++a)
#pragma unroll
    for (int b = 0; b < 2; ++b)
#pragma unroll
      for (int m = 0; m < 4; ++m)
#pragma unroll
        for (int n = 0; n < 2; ++n) acc[a][b][m][n] = (f32x4){0.f, 0.f, 0.f, 0.f};
  bf16x8 At[4][2], B0[2][2], B1[2][2];
  const int nt = K / BK;
  if (!prefetched) { STAGE(SB(0, 0), Bt, bcol, 0); STAGE(SA(0, 0), A, brow, 0);
    STAGE(SB(0, 1), Bt, bcol + HALF, 0); STAGE(SA(0, 1), A, brow + HALF, 0); }
  if (wr == 1) BAR;
  WAIT_V(4); BAR;
  STAGE(SB(1, 0), Bt, bcol, 1); STAGE(SA(1, 0), A, brow, 1); STAGE(SB(1, 1), Bt, bcol + HALF, 1);
  WAIT_V(6); BAR;
  for (int t = 0; t < nt - 2; t += 2) {
    LDB(B0, 0, 0); SCHED; LDA(At, 0, 0); STAGE(SA(1, 1), A, brow + HALF, t + 1);
    WAIT_L(8); BAR; WAIT_L(0); MMA(0, 0, At, B0); BAR; SCHED;
    LDB(B1, 0, 1); STAGE(SB(0, 0), Bt, bcol, t + 2);
    BAR; WAIT_L(0); MMA(0, 1, At, B1); BAR;
    LDA(At, 0, 1); STAGE(SA(0, 0), A, brow, t + 2);
    BAR; WAIT_L(0); MMA(1, 0, At, B0); BAR; SCHED;
    STAGE(SB(0, 1), Bt, bcol + HALF, t + 2);
    WAIT_V(6); BAR; MMA(1, 1, At, B1); BAR;
    LDB(B0, 1, 0); SCHED; LDA(At, 1, 0); STAGE(SA(0, 1), A, brow + HALF, t + 2);
    WAIT_L(8); BAR; WAIT_L(0); MMA(0, 0, At, B0); BAR; SCHED;
    LDB(B1, 1, 1); STAGE(SB(1, 0), Bt, bcol, t + 3);
    BAR; WAIT_L(0); MMA(0, 1, At, B1); BAR;
    LDA(At, 1, 1); STAGE(SA(1, 0), A, brow, t + 3);
    BAR; WAIT_L(0); MMA(1, 0, At, B0); BAR; SCHED;
    STAGE(SB(1, 1), Bt, bcol + HALF, t + 3);
    WAIT_V(6); BAR; MMA(1, 1, At, B1); BAR;
  }
  { LDB(B0, 0, 0); LDA(At, 0, 0); STAGE(SA(1, 1), A, brow + HALF, nt - 1);
    BAR; WAIT_L(0); MMA(0, 0, At, B0); BAR;
    LDB(B1, 0, 1); BAR; WAIT_L(0); MMA(0, 1, At, B1); BAR;
    LDA(At, 0, 1); WAIT_V(4); BAR; WAIT_L(0); MMA(1, 0, At, B0); MMA(1, 1, At, B1); BAR; }
  { LDB(B0, 1, 0); LDA(At, 1, 0); WAIT_V(2); BAR; WAIT_L(0); MMA(0, 0, At, B0); BAR;
    LDB(B1, 1, 1); WAIT_V(0); BAR; WAIT_L(0); MMA(0, 1, At, B1); BAR;
    LDA(At, 1, 1); BAR; WAIT_L(0); MMA(1, 0, At, B0); MMA(1, 1, At, B1); BAR; }
  if (wr == 0) BAR;
  if (nbrow >= 0) {
    STAGE(SB(0, 0), Bt, nbcol, 0); STAGE(SA(0, 0), A, nbrow, 0);
    STAGE(SB(0, 1), Bt, nbcol + HALF, 0); STAGE(SA(0, 1), A, nbrow + HALF, 0); }
#pragma unroll
  for (int ai = 0; ai < 2; ++ai)
#pragma unroll
    for (int bj = 0; bj < 2; ++bj)
#pragma unroll
      for (int m = 0; m < 4; ++m)
        epi.apply(brow + ai * HALF + wr * 64 + m * 16 + fq * 4, bcol + bj * HALF + wc * 32 + fr, fr, acc[ai][bj][m][0], acc[ai][bj][m][1]);
#undef SA
#undef SB
#undef STAGE
#undef LDA
#undef LDB
#undef MMA
}

template <class Epi>
__device__ __forceinline__ void gemm_phase(const u16* A, const u16* Bt, int M, int N, int K, const Epi& epi, LAS char* shm, int rot) {
  const int G = gridDim.x;
  int b = ((int)blockIdx.x + G - rot) % G;
  int vb = (G % 8 == 0) ? (b % 8) * (G / 8) + b / 8 : b;
  const int nM = M / BM, nN = N / BM, ntile = nM * nN;
  bool pre = false;
  for (int id = vb; id < ntile; id += G) {
    int nig = 8 * nN, gid = id / nig, fm = gid * 8, gsz = min(nM - fm, 8);
    int pm = fm + ((id % nig) % gsz), pn = (id % nig) / gsz;
    int nbrow = -1, nbcol = 0;
    if (id + G < ntile) { int id2 = id + G, gid2 = id2 / nig, fm2 = gid2 * 8, gsz2 = min(nM - fm2, 8); nbrow = (fm2 + ((id2 % nig) % gsz2)) * BM; nbcol = ((id2 % nig) / gsz2) * BM; }
    gemm_tile(A, Bt, K, pm * BM, pn * BM, epi, shm, pre, nbrow, nbcol);
    pre = nbrow >= 0;
    if (!pre) __syncthreads();
  }
}

DI int colmap(int kind, int n) {
  if (kind == 0) { if (n < 1792) return n; if (n < 3584) return n + 24; if (n < 3608) return n - 3584 + 1792; return -1; }
  if (kind == 2) { int jb = n >> 5, half = (n >> 4) & 1, jj = n & 15; return half * DFF + jb * 16 + jj; }
  return n;
}
DI void conv_tile(const float* __restrict__ src, int K, int N, u16* dst, int kind, int tile, LAS float* lds) {
  const int ntk = K >> 6, nt0 = tile / ntk, kt = tile - nt0 * ntk, n0 = nt0 * 256, k0 = kt * 64, tid = otid();
  { int nn = tid & 63, kr = tid >> 6; int sc[4];
#pragma unroll
    for (int q = 0; q < 4; ++q) sc[q] = colmap(kind, n0 + q * 64 + nn);
#pragma unroll
    for (int i = 0; i < 8; ++i) { int kk = kr + 8 * i;
#pragma unroll
      for (int q = 0; q < 4; ++q) lds[kk * 257 + q * 64 + nn] = sc[q] >= 0 ? __builtin_nontemporal_load(&src[(size_t)(k0 + kk) * N + sc[q]]) : 0.f; } }
  __syncthreads();
#pragma unroll
  for (int j = 0; j < 4; ++j) { int v = tid + 512 * j, nn = v >> 3, kq = v & 7; bf16x8 o;
#pragma unroll
    for (int e = 0; e < 8; ++e) o[e] = (short)f2bf(lds[(kq * 8 + e) * 257 + nn]);
    *(bf16x8*)(dst + (size_t)(n0 + nn) * K + k0 + kq * 8) = o; }
  __syncthreads();
}

DI void ph_init(const P& p, LAS char* shm, int rep) {
  LAS float* lds = (LAS float*)shm;
  const int tid = otid();
  constexpr int N_MOD = 768, N_CV_L = 480 + 256 + 1408 + 704 + 16, N_CV = 2 * N_CV_L, N_TAB = 16, N_CACHE = 4096;
  constexpr int TOTAL = N_MOD + N_CV + N_TAB + N_CACHE;
  for (int it = blockIdx.x + (rep ? N_MOD : 0); it < TOTAL; it += gridDim.x) {
    if (it < N_MOD) {
      int l = it / 384, r = it % 384, jb = r >> 4, ks = r & 15, j = jb * 512 + tid, k0 = ks * 128;
      for (int e = tid; e < 5 * 128; e += 512) { int v = e >> 7, kk = e & 127; float c = v == 0 ? pin(p, I_CCTX)[k0 + kk] : pin(p, I_C)[(v - 1) * DM + k0 + kk]; lds[e] = siluf(c); }
      __syncthreads();
      float a0 = 0, a1 = 0, a2 = 0, a3 = 0, a4 = 0;
      const float* w = pin(p, I_WADA) + ((size_t)l * DM + k0) * 12288 + j;
#pragma unroll 16
      for (int kk = 0; kk < 128; ++kk) { float wv = __builtin_nontemporal_load(&w[(size_t)kk * 12288]); a0 += lds[kk] * wv; a1 += lds[128 + kk] * wv; a2 += lds[256 + kk] * wv; a3 += lds[384 + kk] * wv; a4 += lds[512 + kk] * wv; }
      float* part = (float*)(p.ws + O_XCT) + ((size_t)((l * 24 + jb) * 16 + ks) * 5) * 512 + tid;
      __hip_atomic_store(part, a0, __ATOMIC_RELAXED, __HIP_MEMORY_SCOPE_AGENT); __hip_atomic_store(part + 512, a1, __ATOMIC_RELAXED, __HIP_MEMORY_SCOPE_AGENT);
      __hip_atomic_store(part + 1024, a2, __ATOMIC_RELAXED, __HIP_MEMORY_SCOPE_AGENT); __hip_atomic_store(part + 1536, a3, __ATOMIC_RELAXED, __HIP_MEMORY_SCOPE_AGENT);
      __hip_atomic_store(part + 2048, a4, __ATOMIC_RELAXED, __HIP_MEMORY_SCOPE_AGENT);
      asm volatile("s_waitcnt vmcnt(0)" ::: "memory");
      __syncthreads();
      LAS unsigned* flag = (LAS unsigned*)(lds + 1024);
      if (tid == 0) { unsigned old = __hip_atomic_fetch_add((unsigned*)(p.ws + O_BAR + 14336) + (l * 24 + jb), 1u, __ATOMIC_RELAXED, __HIP_MEMORY_SCOPE_AGENT); *flag = (old == 15u) ? 1u : 0u; }
      __syncthreads();
      if (*flag) {
        const float bias = pin(p, I_BADA)[l * 12288 + j];
        float s0 = bias, s1 = bias, s2 = bias, s3 = bias, s4 = bias;
        float* pb = (float*)(p.ws + O_XCT) + ((size_t)((l * 24 + jb) * 16) * 5) * 512 + tid;
        for (int k2 = 0; k2 < 16; ++k2) { float* q = pb + (size_t)k2 * 5 * 512;
          s0 += __hip_atomic_load(q, __ATOMIC_RELAXED, __HIP_MEMORY_SCOPE_AGENT); s1 += __hip_atomic_load(q + 512, __ATOMIC_RELAXED, __HIP_MEMORY_SCOPE_AGENT);
          s2 += __hip_atomic_load(q + 1024, __ATOMIC_RELAXED, __HIP_MEMORY_SCOPE_AGENT); s3 += __hip_atomic_load(q + 1536, __ATOMIC_RELAXED, __HIP_MEMORY_SCOPE_AGENT);
          s4 += __hip_atomic_load(q + 2048, __ATOMIC_RELAXED, __HIP_MEMORY_SCOPE_AGENT); }
        float* mod = (float*)(p.ws + O_MOD) + (size_t)l * 5 * 12288 + j;
        mod[0] = s0; mod[12288] = s1; mod[2 * 12288] = s2; mod[3 * 12288] = s3; mod[4 * 12288] = s4;
      }
      __syncthreads();
    } else if (it < N_MOD + N_CV) {
      int r = it - N_MOD, l = r / N_CV_L; r -= l * N_CV_L;
      if (r < 480) conv_tile(pin(p, I_WIN) + (size_t)l * DM * DIN, DM, DIN, (u16*)(p.ws + O_WIN) + (size_t)l * NP * DM, 0, r, lds);
      else if ((r -= 480) < 256) conv_tile(pin(p, I_WOUT) + (size_t)l * DM * DM, DM, DM, (u16*)(p.ws + O_WOUT) + (size_t)l * DM * DM, 1, r, lds);
      else if ((r -= 256) < 1408) conv_tile(pin(p, I_WFFI) + (size_t)l * DM * 2 * DFF, DM, 2 * DFF, (u16*)(p.ws + O_WFFI) + (size_t)l * 2 * DFF * DM, 2, r, lds);
      else if ((r -= 1408) < 704) conv_tile(pin(p, I_WFFO) + (size_t)l * DFF * DM, DFF, DM, (u16*)(p.ws + O_WFFO) + (size_t)l * DM * DFF, 1, r, lds);
      else { r -= 704; conv_tile(pin(p, I_WGLU) + (size_t)l * 512 * 512, 512, 512, (u16*)(p.ws + O_WGLU) + (size_t)l * 512 * 512, 1, r, lds); }
    } else if (it < N_MOD + N_CV + N_TAB) {
      int idx = (it - N_MOD - N_CV) * 512 + tid;
      int l = idx >> 12, d = (idx >> 11) & 1, g = (idx >> 6) & 31, pp = idx & 63;
      int ai = ((l * 2 + d) * 32 + g) * 64 + pp;
      float are = pin(p, I_ARE)[ai], aim = pin(p, I_AIM)[ai];
      float step = __expf(pin(p, I_LOGDT)[(l * 2 + d) * 32 + g]);
      float er = __expf(are * step), sn, cs; sincos_acc(aim * step, sn, cs);
      float lbr = er * cs, lbi = er * sn;
      float qr = lbr, qi = lbi;
      for (int i = 0; i < 6; ++i) { float nr = qr * qr - qi * qi, ni = 2.f * qr * qi; qr = nr; qi = ni; }
      float den = are * are + aim * aim;
      float cr = ((lbr - 1.f) * are + lbi * aim) / den, ci = (lbi * are - (lbr - 1.f) * aim) / den;
      float* tab = (float*)(p.ws + O_S5T) + (size_t)l * S5T_L;
      int e = (d * 32 + g) * 64 + pp;
      tab[e * 2] = lbr; tab[e * 2 + 1] = lbi; tab[8192 + e * 2] = qr; tab[8192 + e * 2 + 1] = qi;
      const float* bre = pin(p, I_BRE) + ((size_t)(l * 32 + g) * 64 + pp) * 16;
      const float* bim = pin(p, I_BIM) + ((size_t)(l * 32 + g) * 64 + pp) * 16;
      u16* bb16 = (u16*)(tab + 16384) + (size_t)(d * 32 + g) * 4 * 32 * 16;
      u16* cc16 = (u16*)(tab + 81920) + (size_t)(d * 32 + g) * 16 * 128;
      const float* cre = pin(p, I_CRE) + (size_t)((l * 2 + d) * 32 + g) * 16 * 64 + pp;
      const float* cim = pin(p, I_CIM) + (size_t)((l * 2 + d) * 32 + g) * 16 * 64 + pp;
      for (int c = 0; c < 16; ++c) {
        float br = bre[c], bi = bim[c];
        bb16[(((pp >> 5)) * 32 + (pp & 31)) * 16 + c] = f2bf(cr * br - ci * bi);
        bb16[((2 + (pp >> 5)) * 32 + (pp & 31)) * 16 + c] = f2bf(cr * bi + ci * br);
        cc16[c * 128 + pp] = f2bf(cre[c * 64]); cc16[c * 128 + 64 + pp] = f2bf(-cim[c * 64]);
      }
    } else {
      int r = it - N_MOD - N_CV - N_TAB;
      if (r < 2048) { int e = r * 512 + tid; int d = e & 63, j = (e >> 6) & 511, kvh = (e >> 15) & 3, b = (e >> 17) & 3, l = e >> 19;
        ((u16*)(p.ws + O_KC))[e] = f2bf(pin(p, I_CK)[((size_t)((b * 2 + l) * 512 + j) * 4 + kvh) * 64 + d]); }
      else { int e = (r - 2048) * 512 + tid; int j = e & 511, d = (e >> 9) & 63, kvh = (e >> 15) & 3, b = (e >> 17) & 3, l = e >> 19;
        ((u16*)(p.ws + O_VCT))[e] = f2bf(pin(p, I_CV)[((size_t)((b * 2 + l) * 512 + j) * 4 + kvh) * 64 + d]); }
    }
  }
}

DI void ph_prenorm(const P& p) {
  const int tid_ = otid(), lane = tid_ & 63, wave = __builtin_amdgcn_readfirstlane(tid_ >> 6);
  const float* mod = (const float*)(p.ws + O_MOD);
  const float* gw = pin(p, I_NMPRE);
  u16* H = (u16*)(p.ws + O_H);
  for (int r = blockIdx.x * 8 + wave; r < T; r += gridDim.x * 8) {
    const float* x = r < TC ? pin(p, I_XP) + (size_t)r * DM : pin(p, I_XS) + (size_t)(r - TC) * DM;
    const float* mr = mod + (size_t)modrow(r) * 12288;
    float4 v[8]; float ss = 0.f;
#pragma unroll
    for (int i = 0; i < 8; ++i) { v[i] = *(const float4*)(x + i * 256 + lane * 4); ss += v[i].x * v[i].x + v[i].y * v[i].y + v[i].z * v[i].z + v[i].w * v[i].w; }
    ss = wsum(ss); float rs = rsqrtf(ss * (1.f / DM) + 1e-6f);
#pragma unroll
    for (int i = 0; i < 8; ++i) {
      int c = i * 256 + lane * 4;
      float4 g = *(const float4*)(gw + c), sh = *(const float4*)(mr + c), sc = *(const float4*)(mr + 2048 + c);
      s16x4 o; o[0] = (short)f2bf(v[i].x * rs * g.x * (1.f + sc.x) + sh.x); o[1] = (short)f2bf(v[i].y * rs * g.y * (1.f + sc.y) + sh.y);
      o[2] = (short)f2bf(v[i].z * rs * g.z * (1.f + sc.z) + sh.z); o[3] = (short)f2bf(v[i].w * rs * g.w * (1.f + sc.w) + sh.w);
      *(s16x4*)(H + (size_t)r * DM + c) = o;
    }
  }
}
constexpr size_t O_XB = O_SST;
template <int XIN, int XOUT>
DI void ph_row(const P& p, const float* wpost, int gate_off, const float* wpre, const float* modn, int sh_off, int sc_off, const float* modg, const u16* XBI, u16* XBO) {
  const int tid_ = otid(), lane = tid_ & 63, wave = __builtin_amdgcn_readfirstlane(tid_ >> 6);
  u16* H = (u16*)(p.ws + O_H);
  const int stride = gridDim.x * 8;
  int r = blockIdx.x * 8 + wave;
  bf16x8 nh[4]; float4 nx[8]; bf16x8 nxb[4];
#define ROW_LOAD(rr) do { const u16* hr_ = H + (size_t)(rr) * DM + lane * 8; \
    _Pragma("unroll") for (int i_ = 0; i_ < 4; ++i_) nh[i_] = *(const bf16x8*)(hr_ + i_ * 512); \
    if (XIN == 2) { const u16* xb_ = XBI + (size_t)(rr) * DM + lane * 8; _Pragma("unroll") for (int i_ = 0; i_ < 4; ++i_) nxb[i_] = *(const bf16x8*)(xb_ + i_ * 512); } \
    else { const float* xs_ = (XIN == 1 ? ((rr) < TC ? pin(p, I_XP) + (size_t)(rr) * DM : pin(p, I_XS) + (size_t)((rr) - TC) * DM) : p.out + OUT_X + (size_t)(rr) * DM) + lane * 8; \
      _Pragma("unroll") for (int i_ = 0; i_ < 4; ++i_) { nx[2 * i_] = *(const float4*)(xs_ + i_ * 512); nx[2 * i_ + 1] = *(const float4*)(xs_ + i_ * 512 + 4); } } } while (0)
  if (r < T) ROW_LOAD(r);
  for (; r < T; r += stride) {
    bf16x8 ch[4]; float4 cx[8];
#pragma unroll
    for (int i = 0; i < 4; ++i) {
      ch[i] = nh[i];
      if (XIN == 2) { cx[2 * i] = make_float4(bfs(nxb[i][0]), bfs(nxb[i][1]), bfs(nxb[i][2]), bfs(nxb[i][3])); cx[2 * i + 1] = make_float4(bfs(nxb[i][4]), bfs(nxb[i][5]), bfs(nxb[i][6]), bfs(nxb[i][7])); }
      else { cx[2 * i] = nx[2 * i]; cx[2 * i + 1] = nx[2 * i + 1]; }
    }
    if (r + stride < T) ROW_LOAD(r + stride);
    const int mrow = modrow(r);
    const float* mg = modg + (size_t)mrow * 12288 + gate_off;
    float* xr = p.out + OUT_X + (size_t)r * DM;
    u16* hr = H + (size_t)r * DM;
    float o[32]; float ss = 0.f;
#pragma unroll
    for (int i = 0; i < 4; ++i)
#pragma unroll
      for (int e = 0; e < 8; ++e) { o[i * 8 + e] = bfs(ch[i][e]); ss += o[i * 8 + e] * o[i * 8 + e]; }
    ss = wsum(ss); float rs = rsqrtf(ss * (1.f / DM) + 1e-6f);
    float ss2 = 0.f;
#pragma unroll
    for (int i = 0; i < 4; ++i) {
#pragma unroll
      for (int q = 0; q < 2; ++q) {
        int c = i * 512 + lane * 8 + q * 4;
        float4 xv = cx[2 * i + q], w = *(const float4*)(wpost + c), g = *(const float4*)(mg + c);
        xv.x += g.x * o[i * 8 + q * 4 + 0] * rs * w.x; xv.y += g.y * o[i * 8 + q * 4 + 1] * rs * w.y;
        xv.z += g.z * o[i * 8 + q * 4 + 2] * rs * w.z; xv.w += g.w * o[i * 8 + q * 4 + 3] * rs * w.w;
        if (XOUT == 0) *(float4*)(xr + c) = xv;
        o[i * 8 + q * 4 + 0] = xv.x; o[i * 8 + q * 4 + 1] = xv.y; o[i * 8 + q * 4 + 2] = xv.z; o[i * 8 + q * 4 + 3] = xv.w;
        ss2 += xv.x * xv.x + xv.y * xv.y + xv.z * xv.z + xv.w * xv.w;
      }
      if (XOUT == 1) { const float* oo = &o[i * 8]; *(bf16x8*)(XBO + (size_t)r * DM + i * 512 + lane * 8) = pack8(oo[0], oo[1], oo[2], oo[3], oo[4], oo[5], oo[6], oo[7]); }
    }
    if (wpre) {
      ss2 = wsum(ss2); float rs2 = rsqrtf(ss2 * (1.f / DM) + 1e-6f);
      const float* mn = modn + (size_t)mrow * 12288;
#pragma unroll
      for (int i = 0; i < 4; ++i) {
        int c = i * 512 + lane * 8;
        float4 w0 = *(const float4*)(wpre + c), w1 = *(const float4*)(wpre + c + 4), sh0 = *(const float4*)(mn + sh_off + c), sh1 = *(const float4*)(mn + sh_off + c + 4), sc0 = *(const float4*)(mn + sc_off + c), sc1 = *(const float4*)(mn + sc_off + c + 4);
        const float* oo = &o[i * 8];
        bf16x8 v = pack8(oo[0] * rs2 * w0.x * (1.f + sc0.x) + sh0.x, oo[1] * rs2 * w0.y * (1.f + sc0.y) + sh0.y, oo[2] * rs2 * w0.z * (1.f + sc0.z) + sh0.z, oo[3] * rs2 * w0.w * (1.f + sc0.w) + sh0.w,
                         oo[4] * rs2 * w1.x * (1.f + sc1.x) + sh1.x, oo[5] * rs2 * w1.y * (1.f + sc1.y) + sh1.y, oo[6] * rs2 * w1.z * (1.f + sc1.z) + sh1.z, oo[7] * rs2 * w1.w * (1.f + sc1.w) + sh1.w);
        *(bf16x8*)(hr + c) = v;
      }
    }
  }
#undef ROW_LOAD
}

DI void prep_item(const P& p, int l, int it, LAS char* shm) {
  LAS u16* tile = (LAS u16*)shm;
  const int tid = otid(), tb = it >> 4, c0 = (it & 15) * 64, t0 = tb * 64;
  const u16* proj = (const u16*)(p.ws + O_PROJ);
  { const int tt = tid >> 3, ch0 = c0 + (tid & 7) * 8, t = t0 + tt;
    int i, L; if (t < TC) { i = t & 255; L = 256; } else { i = (t - TC) & 4095; L = 4096; }
    const u16* px = proj + (size_t)t * NP + C_X + ch0;
    bf16x8 x1 = *(const bf16x8*)px, x0, x2;
    if (i > 0) x0 = *(const bf16x8*)(px - NP); else x0 = (bf16x8){0, 0, 0, 0, 0, 0, 0, 0};
    if (i < L - 1) x2 = *(const bf16x8*)(px + NP); else x2 = (bf16x8){0, 0, 0, 0, 0, 0, 0, 0};
    const float* cw = pin(p, I_CONVW) + (size_t)l * 3 * 1024 + ch0;
    const float* cb = pin(p, I_CONVB) + (size_t)l * 1024 + ch0;
    bf16x8 o;
#pragma unroll
    for (int e = 0; e < 8; ++e) { float y = cb[e] + cw[e] * bfs(x0[e]) + cw[1024 + e] * bfs(x1[e]) + cw[2048 + e] * bfs(x2[e]); o[e] = (short)f2bf(siluf(y)); }
    *(bf16x8*)((u16*)(p.ws + O_XC) + (size_t)t * 1024 + ch0) = o;
    *(LAS bf16x8*)(tile + tt * 72 + (tid & 7) * 8) = o; }
  __syncthreads();
  { const int cc = tid >> 3, tv = tid & 7; bf16x8 o;
#pragma unroll
    for (int e = 0; e < 8; ++e) o[e] = (short)tile[(tv * 8 + e) * 72 + cc];
    *(bf16x8*)((u16*)(p.ws + O_XCT) + (size_t)(c0 + cc) * T + t0 + tv * 8) = o; }
  __syncthreads();
}
DI void cum_item(const P& p, int l, int gc) {
  const int tid = otid(), lane = tid & 63, wave = __builtin_amdgcn_readfirstlane(tid >> 6), t0 = gc * 128;
  const float* dtr = (const float*)(p.ws + O_DT);
  for (int hd = wave; hd < 24; hd += 8) {
    const float bias = pin(p, I_DTB)[l * 24 + hd], a = -__expf(pin(p, I_ALOG)[l * 24 + hd]);
    float x0 = dtr[(size_t)(t0 + 2 * lane) * 32 + hd] + bias, x1 = dtr[(size_t)(t0 + 2 * lane + 1) * 32 + hd] + bias;
    float d0 = x0 > 15.f ? x0 : __logf(1.f + __expf(x0)), d1 = x1 > 15.f ? x1 : __logf(1.f + __expf(x1));
    float v0 = d0 * a, v1 = d1 * a, ps = v0 + v1, inc = ps;
#pragma unroll
    for (int o = 1; o < 64; o <<= 1) { float y = __shfl_up(inc, o); if (lane >= o) inc += y; }
    float total = __shfl(inc, 63), exc = inc - ps;
    float c0, c1;
    if (hd < 12) { c0 = exc + v0; c1 = inc; } else { c0 = total - exc; c1 = total - exc - v0; }
    float* cum = (float*)(p.ws + O_CUM) + ((size_t)gc * 24 + hd) * 128 + 2 * lane;
    float* dtw = (float*)(p.ws + O_DTW) + ((size_t)gc * 24 + hd) * 128 + 2 * lane;
    *(float2*)cum = make_float2(c0, c1); *(float2*)dtw = make_float2(d0, d1);
    if (lane == 0) ((float*)(p.ws + O_CDEC))[gc * 24 + hd] = __expf(total);
  }
}
DI void rope_item(const P& p, int it) {
  int idx = it * 512 + otid(), j = idx & 31, tl = idx >> 5, t = TC + tl, i = tl & 4095;
  float pos = (j < 16) ? (float)(i >> 6) : (float)(i & 63);
  float inv = __expf(-(float)(j & 15) * (9.210340371976184f / 16.f));
  float sn, cs; sincos_acc(pos * inv, sn, cs);
  u16* row = (u16*)(p.ws + O_PROJ) + (size_t)t * NP;
#pragma unroll 4
  for (int hh = 0; hh < 16; ++hh) {
    int base = (hh < 12 ? C_Q + hh * 64 : C_K + (hh - 12) * 64) + j;
    float x1 = bf2f(row[base]), x2 = bf2f(row[base + 32]);
    row[base] = f2bf(x1 * cs - x2 * sn); row[base + 32] = f2bf(x2 * cs + x1 * sn);
  }
}
DI void vt_item(const P& p, int it, LAS char* shm) {
  LAS u16* tile = (LAS u16*)shm;
  const int tid = otid(), t0 = (it >> 2) * 64, c0 = (it & 3) * 64;
  const u16* proj = (const u16*)(p.ws + O_PROJ);
  { int cc = tid & 63, tr = tid >> 6;
#pragma unroll
    for (int i = 0; i < 8; ++i) tile[(tr + 8 * i) * 66 + cc] = proj[(size_t)(t0 + tr + 8 * i) * NP + C_V + c0 + cc]; }
  __syncthreads();
  { int tt = tid & 63, cr = tid >> 6; u16* vt = (u16*)(p.ws + O_VT);
#pragma unroll
    for (int i = 0; i < 8; ++i) vt[(size_t)(c0 + cr + 8 * i) * T + t0 + tt] = tile[tt * 66 + cr + 8 * i]; }
  __syncthreads();
}
DI int s5_tok(int hh, int stp, int dir) { return hh * 64 + (dir ? 63 - stp : stp); }
#define S5_SCAN_STEP(i) do { float n0r = s0r * lr0 - s0i * li0 + a0[i], n0i = s0r * li0 + s0i * lr0 + a2[i]; s0r = n0r; s0i = n0i; \
    float n1r = s1r * lr1 - s1i * li1 + a1[i], n1i = s1r * li1 + s1i * lr1 + a3[i]; s1r = n1r; s1i = n1i; } while (0)
DI void s5p1_item(const P& p, int l, int it) {
  const int tid_ = otid(), lane = tid_ & 63, wave = __builtin_amdgcn_readfirstlane(tid_ >> 6), r = lane & 31, h = lane >> 5;
  const int gc = it >> 3, g = (it & 7) * 4 + (wave >> 1), dir = wave & 1, t0 = gc * 128;
  const float* tab = (const float*)(p.ws + O_S5T) + (size_t)l * S5T_L;
  const int e0 = (dir * 32 + g) * 64 + r;
  const float lr0 = tab[e0 * 2], li0 = tab[e0 * 2 + 1], lr1 = tab[(e0 + 32) * 2], li1 = tab[(e0 + 32) * 2 + 1];
  const u16* bb16 = (const u16*)(tab + 16384) + (size_t)(dir * 32 + g) * 4 * 32 * 16;
  bf16x8 bop[4];
#pragma unroll
  for (int nt = 0; nt < 4; ++nt) bop[nt] = *(const bf16x8*)(bb16 + (nt * 32 + r) * 16 + 8 * h);
  const u16* up = (const u16*)(p.ws + O_PROJ) + C_U + g * 16 + 8 * h;
  const int mh = (r >> 2) & 1, mi = (r & 3) + 4 * (r >> 3);
  float s0r = 0.f, s0i = 0.f, s1r = 0.f, s1i = 0.f;
  f32x16 zero;
#pragma unroll
  for (int i = 0; i < 16; ++i) zero[i] = 0.f;
#pragma unroll 1
  for (int it4 = 0; it4 < 4; ++it4) {
    bf16x8 af = *(const bf16x8*)(up + (size_t)(t0 + s5_tok(mh, 16 * it4 + mi, dir)) * NP);
    f32x16 a0 = __builtin_amdgcn_mfma_f32_32x32x16_bf16(af, bop[0], zero, 0, 0, 0);
    f32x16 a1 = __builtin_amdgcn_mfma_f32_32x32x16_bf16(af, bop[1], zero, 0, 0, 0);
    f32x16 a2 = __builtin_amdgcn_mfma_f32_32x32x16_bf16(af, bop[2], zero, 0, 0, 0);
    f32x16 a3 = __builtin_amdgcn_mfma_f32_32x32x16_bf16(af, bop[3], zero, 0, 0, 0);
#pragma unroll
    for (int i = 0; i < 16; ++i) S5_SCAN_STEP(i);
  }
  float* sh = (float*)(p.ws + O_S5H) + ((size_t)((2 * gc + h) * 32 + g) * 2 + dir) * 128;
  *(float2*)(sh + r * 2) = make_float2(s0r, s0i); *(float2*)(sh + (32 + r) * 2) = make_float2(s1r, s1i);
}
DI void s5comb_item(const P& p, int l, int it) {
  int idx = it * 512 + otid(), pp = idx & 63, dir = (idx >> 6) & 1, g = (idx >> 7) & 31, seq = idx >> 12;
  const float* tab = (const float*)(p.ws + O_S5T) + (size_t)l * S5T_L;
  int e = (dir * 32 + g) * 64 + pp;
  float qr = tab[8192 + e * 2], qi = tab[8192 + e * 2 + 1];
  float hr = 0.f, hi = 0.f; int nc = 4, hc0 = seq * 4;
  if (seq >= 32) { int b = seq - 32; nc = 64; hc0 = 128 + b * 64; size_t o = (size_t)((b * 2 + l) * 2 + dir) * 2048 + g * 64 + pp; hr = pin(p, I_S5R)[o]; hi = pin(p, I_S5I)[o]; }
  float* s5h = (float*)(p.ws + O_S5H);
#pragma unroll 1
  for (int kb = 0; kb < nc; kb += 16) {
    float2 v[16];
#pragma unroll
    for (int k = 0; k < 16; ++k) if (kb + k < nc) {
      int hc = hc0 + (dir ? nc - 1 - (kb + k) : kb + k);
      v[k] = *(const float2*)(s5h + ((size_t)(hc * 32 + g) * 2 + dir) * 128 + pp * 2); }
#pragma unroll
    for (int k = 0; k < 16; ++k) if (kb + k < nc) {
      int hc = hc0 + (dir ? nc - 1 - (kb + k) : kb + k);
      *(float2*)(s5h + ((size_t)(hc * 32 + g) * 2 + dir) * 128 + pp * 2) = make_float2(hr, hi);
      float nr = hr * qr - hi * qi + v[k].x, ni = hr * qi + hi * qr + v[k].y; hr = nr; hi = ni; }
  }
  if (seq < 32) { size_t o = (size_t)((seq * 2 + l) * 2 + dir) * 2048 + g * 64 + pp; p.out[OUT_S5R + o] = hr; p.out[OUT_S5I + o] = hi; }
}
DI void s5p2_item(const P& p, int l, int it, LAS char* shm) {
  const int tid_ = otid(), lane = tid_ & 63, wave = __builtin_amdgcn_readfirstlane(tid_ >> 6), r = lane & 31, h = lane >> 5;
  const int gc = it >> 2, g = (it & 3) * 8 + wave, t0 = gc * 128;
  LAS u16* HT = (LAS u16*)(shm + wave * 17408);
  LAS float* ybuf = (LAS float*)(shm + wave * 17408 + 8704);
  const float* tab = (const float*)(p.ws + O_S5T) + (size_t)l * S5T_L;
  const u16* up = (const u16*)(p.ws + O_PROJ) + C_U + g * 16;
  const int mh = (r >> 2) & 1, mi = (r & 3) + 4 * (r >> 3);
  const float Dv = pin(p, I_S5D)[l * 512 + g * 16 + (r & 15)];
  f32x16 zero;
#pragma unroll
  for (int i = 0; i < 16; ++i) zero[i] = 0.f;
#pragma unroll 1
  for (int dd = 0; dd < 2; ++dd) {
    const int dir = 1 - dd;
    const int e0 = (dir * 32 + g) * 64 + r;
    const float lr0 = tab[e0 * 2], li0 = tab[e0 * 2 + 1], lr1 = tab[(e0 + 32) * 2], li1 = tab[(e0 + 32) * 2 + 1];
    const u16* bb16 = (const u16*)(tab + 16384) + (size_t)(dir * 32 + g) * 4 * 32 * 16;
    const u16* cc16 = (const u16*)(tab + 81920) + (size_t)(dir * 32 + g) * 16 * 128;
    bf16x8 bop[4], cop[8];
#pragma unroll
    for (int nt = 0; nt < 4; ++nt) bop[nt] = *(const bf16x8*)(bb16 + (nt * 32 + r) * 16 + 8 * h);
#pragma unroll
    for (int ks = 0; ks < 8; ++ks) { if (r < 16) cop[ks] = *(const bf16x8*)(cc16 + r * 128 + ks * 16 + 8 * h); else cop[ks] = (bf16x8){0, 0, 0, 0, 0, 0, 0, 0}; }
    const float* sh = (const float*)(p.ws + O_S5H) + ((size_t)((2 * gc + h) * 32 + g) * 2 + dir) * 128;
    float s0r = sh[r * 2], s0i = sh[r * 2 + 1], s1r = sh[(32 + r) * 2], s1i = sh[(32 + r) * 2 + 1];
#pragma unroll 1
    for (int it4 = 0; it4 < 4; ++it4) {
      bf16x8 af = *(const bf16x8*)(up + 8 * h + (size_t)(t0 + s5_tok(mh, 16 * it4 + mi, dir)) * NP);
      f32x16 a0 = __builtin_amdgcn_mfma_f32_32x32x16_bf16(af, bop[0], zero, 0, 0, 0);
      f32x16 a1 = __builtin_amdgcn_mfma_f32_32x32x16_bf16(af, bop[1], zero, 0, 0, 0);
      f32x16 a2 = __builtin_amdgcn_mfma_f32_32x32x16_bf16(af, bop[2], zero, 0, 0, 0);
      f32x16 a3 = __builtin_amdgcn_mfma_f32_32x32x16_bf16(af, bop[3], zero, 0, 0, 0);
#pragma unroll
      for (int i = 0; i < 16; ++i) { S5_SCAN_STEP(i); a0[i] = s0r; a1[i] = s1r; a2[i] = s0i; a3[i] = s1i; }
#pragma unroll
      for (int i = 0; i < 16; i += 2) {
        LAS u16* row = HT + (16 * h + i) * 136 + r;
        unsigned k0 = cvt_pk_bf16(a0[i], a0[i + 1]), k1 = cvt_pk_bf16(a1[i], a1[i + 1]), k2 = cvt_pk_bf16(a2[i], a2[i + 1]), k3 = cvt_pk_bf16(a3[i], a3[i + 1]);
        row[0] = (u16)k0; row[136] = (u16)(k0 >> 16); row[32] = (u16)k1; row[136 + 32] = (u16)(k1 >> 16);
        row[64] = (u16)k2; row[136 + 64] = (u16)(k2 >> 16); row[96] = (u16)k3; row[136 + 96] = (u16)(k3 >> 16);
      }
      asm volatile("s_waitcnt lgkmcnt(0)" ::: "memory");
      f32x16 y2 = zero;
#pragma unroll
      for (int ks = 0; ks < 8; ++ks) {
        bf16x8 a2f = *(const LAS bf16x8*)(HT + r * 136 + ks * 16 + 8 * h);
        y2 = __builtin_amdgcn_mfma_f32_32x32x16_bf16(a2f, cop[ks], y2, 0, 0, 0);
      }
      if (r < 16) {
#pragma unroll
        for (int i2 = 0; i2 < 16; ++i2) {
          const int m2 = crow(i2, h), tok = s5_tok(m2 >> 4, 16 * it4 + (m2 & 15), dir);
          if (dd == 0) ybuf[tok * 16 + r] = y2[i2];
          else {
            float u = bf2f(up[(size_t)(t0 + tok) * NP + r]);
            float y = ybuf[tok * 16 + r] + y2[i2] + Dv * u;
            float gl = y / (1.f + __expf(-1.5957691216057308f * (y + 0.044715f * y * y * y)));
            ((u16*)(p.ws + O_G5))[(size_t)(t0 + tok) * 512 + g * 16 + r] = f2bf(gl);
          }
        }
      }
      asm volatile("s_waitcnt lgkmcnt(0)" ::: "memory");
    }
  }
}
DI void ssd_p1_item(const P& p, int l, int it, LAS char* shm) {
  const int tid = otid(), lane = tid & 63, wave = __builtin_amdgcn_readfirstlane(tid >> 6), r = lane & 31, h = lane >> 5;
  const int gc = it / 3, rr = it - gc * 3, t0 = gc * 128, hd = rr * 8 + wave, dir = hd / 12, head = hd - dir * 12, g = head / 6;
  LAS float* wb = (LAS float*)(shm + wave * 512);
  const float* cum = (const float*)(p.ws + O_CUM) + ((size_t)gc * 24 + hd) * 128;
  const float* dtw = (const float*)(p.ws + O_DTW) + ((size_t)gc * 24 + hd) * 128;
  const float total = dir ? cum[0] : cum[127];
  wb[lane] = dtw[lane] * __expf(total - cum[lane]); wb[lane + 64] = dtw[lane + 64] * __expf(total - cum[lane + 64]);
  asm volatile("s_waitcnt lgkmcnt(0)" ::: "memory");
  const u16* xct = (const u16*)(p.ws + O_XCT);
  const u16* xa0 = xct + (size_t)(head * 64 + r) * T + t0 + 8 * h;
  const u16* xa1 = xa0 + (size_t)32 * T;
  const u16* xb0 = xct + (size_t)(768 + g * 64 + r) * T + t0 + 8 * h;
  const u16* xb1 = xb0 + (size_t)32 * T;
  f32x16 a00, a01, a10, a11;
#pragma unroll
  for (int i = 0; i < 16; ++i) { a00[i] = 0.f; a01[i] = 0.f; a10[i] = 0.f; a11[i] = 0.f; }
#pragma unroll 2
  for (int ks = 0; ks < 8; ++ks) {
    bf16x8 r0 = *(const bf16x8*)(xa0 + ks * 16), r1 = *(const bf16x8*)(xa1 + ks * 16);
    bf16x8 b0 = *(const bf16x8*)(xb0 + ks * 16), b1 = *(const bf16x8*)(xb1 + ks * 16);
    f32x4 w0 = *(const LAS f32x4*)(wb + ks * 16 + 8 * h), w1 = *(const LAS f32x4*)(wb + ks * 16 + 8 * h + 4);
    bf16x8 f0, f1;
#pragma unroll
    for (int j = 0; j < 8; ++j) { float w = j < 4 ? w0[j & 3] : w1[j & 3]; f0[j] = (short)f2bf(bfs(r0[j]) * w); f1[j] = (short)f2bf(bfs(r1[j]) * w); }
    a00 = __builtin_amdgcn_mfma_f32_32x32x16_bf16(f0, b0, a00, 0, 0, 0);
    a01 = __builtin_amdgcn_mfma_f32_32x32x16_bf16(f0, b1, a01, 0, 0, 0);
    a10 = __builtin_amdgcn_mfma_f32_32x32x16_bf16(f1, b0, a10, 0, 0, 0);
    a11 = __builtin_amdgcn_mfma_f32_32x32x16_bf16(f1, b1, a11, 0, 0, 0);
  }
  float* sst = (float*)(p.ws + O_SST) + ((size_t)(gc * 2 + dir) * 12 + head) * 4096;
#pragma unroll
  for (int i = 0; i < 16; ++i) {
    int pr = crow(i, h);
    sst[pr * 64 + r] = a00[i]; sst[pr * 64 + 32 + r] = a01[i]; sst[(32 + pr) * 64 + r] = a10[i]; sst[(32 + pr) * 64 + 32 + r] = a11[i];
  }
  asm volatile("s_waitcnt lgkmcnt(0)" ::: "memory");
}
DI void ssd_p2_item(const P& p, int l, int it, LAS char* shm) {
  const int tid = otid(), lane = tid & 63, wave = __builtin_amdgcn_readfirstlane(tid >> 6), r = lane & 31, h = lane >> 5;
  const int task = it * 8 + wave, lb = task & 3, head = (task >> 2) % 12, gc = task / 48, g = head / 6, t0 = gc * 128;
  LAS float* lf = (LAS float*)(shm + wave * 2048);
  { const float* cumf = (const float*)(p.ws + O_CUM) + ((size_t)gc * 24 + head) * 128;
    const float* dtf = (const float*)(p.ws + O_DTW) + ((size_t)gc * 24 + head) * 128;
    lf[lane] = cumf[lane]; lf[64 + lane] = cumf[64 + lane]; lf[128 + lane] = cumf[12 * 128 + lane]; lf[192 + lane] = cumf[12 * 128 + 64 + lane];
    lf[256 + lane] = dtf[lane]; lf[320 + lane] = dtf[64 + lane]; lf[384 + lane] = dtf[12 * 128 + lane]; lf[448 + lane] = dtf[12 * 128 + 64 + lane]; }
  asm volatile("s_waitcnt lgkmcnt(0)" ::: "memory");
  const int lq = lb * 32 + r;
  const float cfl = lf[lq], cbl = lf[128 + lq];
  const float Dh = pin(p, I_SSDD)[l * 12 + head];
  const u16* xc = (const u16*)(p.ws + O_XC);
  bf16x8 cq[4];
  { const u16* crowp = xc + (size_t)(t0 + lq) * 1024 + 896 + g * 64 + 8 * h;
#pragma unroll
    for (int ks = 0; ks < 4; ++ks) cq[ks] = *(const bf16x8*)(crowp + ks * 16); }
  f32x16 o0, o1;
#pragma unroll
  for (int i = 0; i < 16; ++i) { o0[i] = 0.f; o1[i] = 0.f; }
#pragma unroll
  for (int dir = 0; dir < 2; ++dir) {
    const float* hs = (const float*)(p.ws + O_SST) + ((size_t)(gc * 2 + dir) * 12 + head) * 4096;
    f32x16 u0, u1;
#pragma unroll
    for (int i = 0; i < 16; ++i) { u0[i] = 0.f; u1[i] = 0.f; }
#pragma unroll
    for (int ks = 0; ks < 4; ++ks) {
      const float* h0 = hs + (size_t)r * 64 + ks * 16 + 8 * h; const float* h1 = h0 + 32 * 64;
      float4 x0 = *(const float4*)h0, x1 = *(const float4*)(h0 + 4), y0 = *(const float4*)h1, y1 = *(const float4*)(h1 + 4);
      bf16x8 fa = pack8(x0.x, x0.y, x0.z, x0.w, x1.x, x1.y, x1.z, x1.w), fb = pack8(y0.x, y0.y, y0.z, y0.w, y1.x, y1.y, y1.z, y1.w);
      u0 = __builtin_amdgcn_mfma_f32_32x32x16_bf16(fa, cq[ks], u0, 0, 0, 0);
      u1 = __builtin_amdgcn_mfma_f32_32x32x16_bf16(fb, cq[ks], u1, 0, 0, 0);
    }
    const float sc = __expf(dir ? cbl : cfl);
#pragma unroll
    for (int i = 0; i < 16; ++i) { o0[i] += sc * u0[i]; o1[i] += sc * u1[i]; }
  }
  const u16* xct = (const u16*)(p.ws + O_XCT);
  const u16* vrow0 = xct + (size_t)(head * 64 + r) * T + t0 + 8 * h;
  const u16* vrow1 = vrow0 + (size_t)32 * T;
  const u16* brow = xc + (size_t)(t0 + pi23(r)) * 1024 + 768 + g * 64 + 8 * h;
#pragma unroll 1
  for (int st = 0; st < 4; ++st) {
    f32x16 sg;
#pragma unroll
    for (int i = 0; i < 16; ++i) sg[i] = 0.f;
#pragma unroll
    for (int ks = 0; ks < 4; ++ks) {
      bf16x8 kf = *(const bf16x8*)(brow + (size_t)st * 32 * 1024 + ks * 16);
      sg = __builtin_amdgcn_mfma_f32_32x32x16_bf16(kf, cq[ks], sg, 0, 0, 0);
    }
#pragma unroll
    for (int q = 0; q < 4; ++q) {
      const int sb = st * 32 + 16 * (q >> 1) + 8 * h + 4 * (q & 1);
      f32x4 cf4 = *(const LAS f32x4*)(lf + sb), cb4 = *(const LAS f32x4*)(lf + 128 + sb), df4 = *(const LAS f32x4*)(lf + 256 + sb), db4 = *(const LAS f32x4*)(lf + 384 + sb);
#pragma unroll
      for (int e = 0; e < 4; ++e) {
        const int si = sb + e;
        float wf = (si <= lq) ? df4[e] * __expf(fminf(cfl - cf4[e], 0.f)) : 0.f;
        float wbk = (si >= lq) ? db4[e] * __expf(fminf(cbl - cb4[e], 0.f)) : 0.f;
        float v = sg[q * 4 + e] * (wf + wbk);
        if (si == lq) v += Dh;
        sg[q * 4 + e] = v;
      }
    }
#pragma unroll
    for (int sp = 0; sp < 2; ++sp) {
      bf16x8 pf = pack8(sg[8 * sp], sg[8 * sp + 1], sg[8 * sp + 2], sg[8 * sp + 3], sg[8 * sp + 4], sg[8 * sp + 5], sg[8 * sp + 6], sg[8 * sp + 7]);
      bf16x8 va = *(const bf16x8*)(vrow0 + st * 32 + 16 * sp), vb = *(const bf16x8*)(vrow1 + st * 32 + 16 * sp);
      o0 = __builtin_amdgcn_mfma_f32_32x32x16_bf16(va, pf, o0, 0, 0, 0);
      o1 = __builtin_amdgcn_mfma_f32_32x32x16_bf16(vb, pf, o1, 0, 0, 0);
    }
  }
  u16* yrow = (u16*)(p.ws + O_Y) + (size_t)(t0 + lq) * 768 + head * 64;
#pragma unroll
  for (int gq = 0; gq < 4; ++gq) {
    s16x4 a, bq;
#pragma unroll
    for (int e = 0; e < 4; ++e) { a[e] = (short)f2bf(o0[gq * 4 + e]); bq[e] = (short)f2bf(o1[gq * 4 + e]); }
    *(s16x4*)(yrow + 8 * gq + 4 * h) = a; *(s16x4*)(yrow + 32 + 8 * gq + 4 * h) = bq;
  }
  asm volatile("s_waitcnt lgkmcnt(0)" ::: "memory");
}
DI void ssdcomb_item(const P& p, int l, int it) {
  int idx = it * 512 + otid();
  int pn = idx & 4095, hd = (idx >> 12) % 24, seq = idx / (24 * 4096), dir = hd / 12, head = hd - dir * 12;
  float hs = 0.f; int nc = 2;
  if (seq >= 32) { nc = 32; hs = pin(p, I_SSD)[((size_t)(((seq - 32) * 2 + l) * 2 + dir) * 12 + head) * 4096 + pn]; }
  float* sst = (float*)(p.ws + O_SST); const float* cdec = (const float*)(p.ws + O_CDEC);
#pragma unroll 1
  for (int kb = 0; kb < nc; kb += 16) {
    float v[16], dc[16];
#pragma unroll
    for (int k = 0; k < 16; ++k) if (kb + k < nc) {
      int c = dir ? nc - 1 - (kb + k) : kb + k, gc = chunk_of(seq, c); size_t o = ((size_t)(gc * 2 + dir) * 12 + head);
      v[k] = sst[o * 4096 + pn]; dc[k] = cdec[o]; }
#pragma unroll
    for (int k = 0; k < 16; ++k) if (kb + k < nc) {
      int c = dir ? nc - 1 - (kb + k) : kb + k, gc = chunk_of(seq, c); size_t o = ((size_t)(gc * 2 + dir) * 12 + head);
      sst[o * 4096 + pn] = hs; hs = hs * dc[k] + v[k]; }
  }
  if (seq < 32) p.out[OUT_SSD + ((size_t)((seq * 2 + l) * 2 + dir) * 12 + head) * 4096 + pn] = hs;
}
DI void ph_ssdfinal(const P& p, int l) {
  const int tid_ = otid(), lane = tid_ & 63, wave = __builtin_amdgcn_readfirstlane(tid_ >> 6);
  const u16* proj = (const u16*)(p.ws + O_PROJ);
  const u16* yf = (const u16*)(p.ws + O_Y);
  u16* mix = (u16*)(p.ws + O_MIX);
  for (int r = blockIdx.x * 8 + wave; r < T; r += gridDim.x * 8) {
    float y[12]; float ss = 0.f;
#pragma unroll
    for (int i = 0; i < 3; ++i) {
      int c = i * 256 + lane * 4;
      s16x4 a = *(const s16x4*)(yf + (size_t)r * 768 + c);
      s16x4 z = *(const s16x4*)(proj + (size_t)r * NP + C_Z + c);
#pragma unroll
      for (int e = 0; e < 4; ++e) { float v = bfs(a[e]) * siluf(bfs(z[e])); y[i * 4 + e] = v; ss += v * v; }
    }
    ss = wsum(ss); float rs = rsqrtf(ss * (1.f / 768.f) + 1e-6f);
#pragma unroll
    for (int i = 0; i < 3; ++i) {
      int c = i * 256 + lane * 4;
      float4 w = *(const float4*)(pin(p, I_SSDN) + l * 768 + c);
      s16x4 o; o[0] = (short)f2bf(y[i * 4] * rs * w.x); o[1] = (short)f2bf(y[i * 4 + 1] * rs * w.y); o[2] = (short)f2bf(y[i * 4 + 2] * rs * w.z); o[3] = (short)f2bf(y[i * 4 + 3] * rs * w.w);
      *(s16x4*)(mix + (size_t)r * DM + c) = o;
    }
  }
}
struct AttState { float m, lsum; f32x16 o0, o1; };
struct AttKV { bf16x8 k[4]; bf16x8 v[4]; };

constexpr int ATT_KS = 72, ATT_VS = 264, ATT_VOFF = 256 * ATT_KS;
DI void attn_load_lds(AttKV& t, const LAS u16* sk, const LAS u16* sv, int j, int r, int h) {
  const LAS u16* kp = sk + (j * 32 + pi23(r)) * ATT_KS + 8 * h;
#pragma unroll
  for (int ks = 0; ks < 4; ++ks) t.k[ks] = *(const LAS bf16x8*)(kp + ks * 16);
  const LAS u16* vp = sv + r * ATT_VS + j * 32 + 8 * h;
#pragma unroll
  for (int sp = 0; sp < 2; ++sp) { t.v[sp * 2 + 0] = *(const LAS bf16x8*)(vp + 16 * sp); t.v[sp * 2 + 1] = *(const LAS bf16x8*)(vp + 32 * ATT_VS + 16 * sp); }
}
DI void attn_compute(AttState& st, const bf16x8 (&qf)[4], const AttKV& t, bool mask, int h, int qi, int k0) {
  f32x16 s;
#pragma unroll
  for (int i = 0; i < 16; ++i) s[i] = 0.f;
#pragma unroll
  for (int ks = 0; ks < 4; ++ks) s = __builtin_amdgcn_mfma_f32_32x32x16_bf16(t.k[ks], qf[ks], s, 0, 0, 0);
  float mt = -1e30f;
#pragma unroll
  for (int i = 0; i < 16; ++i) {
    float v = s[i] * 0.125f;
    if (mask) { int d = qi - (k0 + pi23(crow(i, h))); if (d > 128 || d < -128) v = -1e30f; }
    s[i] = v; mt = fmaxf(mt, v);
  }
  mt = fmaxf(mt, __shfl_xor(mt, 32));
  float mn = fmaxf(st.m, mt), alpha = __expf(st.m - mn);
  st.m = mn;
  float ps = 0.f;
#pragma unroll
  for (int i = 0; i < 16; ++i) { float e = __expf(s[i] - mn); s[i] = e; ps += e; }
  st.lsum = st.lsum * alpha + ps;
#pragma unroll
  for (int i = 0; i < 16; ++i) { st.o0[i] *= alpha; st.o1[i] *= alpha; }
#pragma unroll
  for (int sp = 0; sp < 2; ++sp) {
    bf16x8 pf = pack8(s[8 * sp], s[8 * sp + 1], s[8 * sp + 2], s[8 * sp + 3], s[8 * sp + 4], s[8 * sp + 5], s[8 * sp + 6], s[8 * sp + 7]);
    st.o0 = __builtin_amdgcn_mfma_f32_32x32x16_bf16(t.v[sp * 2 + 0], pf, st.o0, 0, 0, 0);
    st.o1 = __builtin_amdgcn_mfma_f32_32x32x16_bf16(t.v[sp * 2 + 1], pf, st.o1, 0, 0, 0);
  }
}
DI void attn_item(const P& p, int l, int item, LAS char* shm) {
  const int tid_ = otid(), lane = tid_ & 63, wave = __builtin_amdgcn_readfirstlane(tid_ >> 6), r = lane & 31, h = lane >> 5;
  int seq, head, q0b, b = 0; bool lat;
  if (item < 768) { lat = true; b = item / 192; head = (item >> 4) % 12; q0b = (item & 15) * 256; seq = 32 + b; }
  else { int it2 = item - 768; lat = false; seq = it2 / 12; head = it2 % 12; q0b = 0; }
  const int q0 = q0b + wave * 32, kvh = head / 3, L = lat ? 4096 : 256;
  const int seqstart = seq < 32 ? seq * 256 : TC + (seq - 32) * 4096;
  const u16* proj = (const u16*)(p.ws + O_PROJ);
  bf16x8 qf[4];
  { const u16* qrow = proj + (size_t)(seqstart + q0 + r) * NP + C_Q + head * 64;
#pragma unroll
    for (int ks = 0; ks < 4; ++ks) qf[ks] = *(const bf16x8*)(qrow + ks * 16 + 8 * h); }
  AttState st; st.m = pin(p, I_SINK)[l * 12 + head]; st.lsum = h == 0 ? 1.f : 0.f;
#pragma unroll
  for (int i = 0; i < 16; ++i) { st.o0[i] = 0.f; st.o1[i] = 0.f; }
  const u16* kself = proj + (size_t)seqstart * NP + C_K + kvh * 64;
  const u16* vself = (const u16*)(p.ws + O_VT) + (size_t)(kvh * 64) * T + seqstart;
  const u16* kc = (const u16*)(p.ws + O_KC) + (size_t)((l * 4 + b) * 4 + kvh) * 512 * 64;
  const u16* vc = (const u16*)(p.ws + O_VCT) + (size_t)((l * 4 + b) * 4 + kvh) * 64 * 512;
  LAS u16* sk = (LAS u16*)shm; LAS u16* sv = sk + ATT_VOFF;
  const int ns = lat ? 4 : 1, kb0 = lat ? q0b - 128 : 0, qi = q0 + r;
  const int krow = tid_ >> 1, khalf = tid_ & 1, vd = tid_ >> 3, vseg = tid_ & 7;
  bf16x8 kreg[4], vreg[4];
#define ATT_STAGE_LOAD(s_) do { const int s__ = (s_); \
    if (lat && s__ < 2) { const u16* kp_ = kc + (size_t)(s__ * 256 + krow) * 64 + khalf * 32; const u16* vp_ = vc + (size_t)vd * 512 + s__ * 256 + vseg * 32; \
      _Pragma("unroll") for (int q_ = 0; q_ < 4; ++q_) { kreg[q_] = *(const bf16x8*)(kp_ + q_ * 8); vreg[q_] = *(const bf16x8*)(vp_ + q_ * 8); } } \
    else { const int kb_ = kb0 + 256 * (lat ? s__ - 2 : 0); const int key_ = kb_ + krow, vk_ = kb_ + vseg * 32; \
      if (key_ >= 0 && key_ < L) { const u16* kp_ = kself + (size_t)key_ * NP + khalf * 32; _Pragma("unroll") for (int q_ = 0; q_ < 4; ++q_) kreg[q_] = *(const bf16x8*)(kp_ + q_ * 8); } \
      if (vk_ >= 0 && vk_ < L) { const u16* vp_ = vself + (size_t)vd * T + vk_; _Pragma("unroll") for (int q_ = 0; q_ < 4; ++q_) vreg[q_] = *(const bf16x8*)(vp_ + q_ * 8); } } } while (0)
  ATT_STAGE_LOAD(0);
#pragma unroll 1
  for (int s = 0; s < ns; ++s) {
    __syncthreads();
#pragma unroll
    for (int q = 0; q < 4; ++q) { *(LAS bf16x8*)(sk + krow * ATT_KS + khalf * 32 + q * 8) = kreg[q]; *(LAS bf16x8*)(sv + vd * ATT_VS + vseg * 32 + q * 8) = vreg[q]; }
    __syncthreads();
    if (s + 1 < ns) ATT_STAGE_LOAD(s + 1);
    const bool band = lat && s >= 2;
    const int kb = band ? kb0 + 256 * (s - 2) : 0;
    int j0 = 0, j1 = 8;
    if (band) { int lo = max(max(0, q0 - 128), kb), hi = min(min(4096, q0 + 160), kb + 256); j0 = (lo - kb) >> 5; j1 = (hi - kb) >> 5; if (j1 < j0) j1 = j0; }
    AttKV ta, tb;
    if (j0 < j1) attn_load_lds(ta, sk, sv, j0, r, h);
#pragma unroll 1
    for (int j = j0; j < j1; j += 2) {
      if (j + 1 < j1) attn_load_lds(tb, sk, sv, j + 1, r, h);
      attn_compute(st, qf, ta, band, h, qi, kb + 32 * j);
      if (j + 1 < j1) {
        if (j + 2 < j1) attn_load_lds(ta, sk, sv, j + 2, r, h);
        attn_compute(st, qf, tb, band, h, qi, kb + 32 * (j + 1));
      }
    }
  }
#undef ATT_STAGE_LOAD
  float lt = st.lsum + __shfl_xor(st.lsum, 32), inv = 1.f / lt;
  u16* orow = (u16*)(p.ws + O_MIX) + (size_t)(seqstart + q0 + r) * DM + 768 + head * 64;
#pragma unroll
  for (int gq = 0; gq < 4; ++gq) {
    s16x4 a, bq;
#pragma unroll
    for (int e = 0; e < 4; ++e) { a[e] = (short)f2bf(st.o0[gq * 4 + e] * inv); bq[e] = (short)f2bf(st.o1[gq * 4 + e] * inv); }
    *(s16x4*)(orow + 8 * gq + 4 * h) = a; *(s16x4*)(orow + 32 + 8 * gq + 4 * h) = bq;
  }
  __syncthreads();
}

#ifdef TPROBE
#define TSTAMP(k) do { if (blockIdx.x == 0 && otid() == 0) ((unsigned long long*)(p0.ws + O_END2))[(k)] = wall_clock64(); } while (0)
#else
#define TSTAMP(k) do { } while (0)
#endif
#define PH_BEGIN(k) if (p0.lo <= (k) && (k) < p0.hi) { P p; p.inp = p0.in; p.out = p0.out; p.ws = p0.ws; p.lo = p0.lo; p.hi = p0.hi; \
    asm volatile("" : "+s"(p.out), "+s"(p.ws)); const int G = gridDim.x, bid = blockIdx.x; (void)G; (void)bid;
#define PH_END(k) if ((k) + 1 < p0.hi) { if ((k) == 0) grid.sync(); else xcd_barrier(xb); } TSTAMP((k) + 1); }

template <int l>
DI void layer_phases(const P& p0, cg::grid_group& grid, const XcdBarrier& xb, LAS char* shm) {
  constexpr int B = 2 + 11 * l;
  PH_BEGIN(B + 0) for (int rep = 0; rep < NREP(0); ++rep) { EpiProj e{(u16*)(p.ws + O_PROJ), (float*)(p.ws + O_DT), p.out, l};
    gemm_phase((const u16*)(p.ws + O_H), (const u16*)(p.ws + O_WIN) + (size_t)l * NP * DM, T, NP, DM, e, shm, 0); } PH_END(B + 0)
  PH_BEGIN(B + 1) for (int rep = 0; rep < NREP(1); ++rep) {
    constexpr int N0 = 1536, N1 = N0 + 6144, N2 = N1 + 1024, N3 = N2 + 1536, N4 = N3 + 192;
    for (int it = bid; it < N4; it += G) {
      if (it < N0) s5p1_item(p, l, it); else if (it < N1) prep_item(p, l, it - N0, shm); else if (it < N2) { if (rep == 0) rope_item(p, it - N1); } else if (it < N3) vt_item(p, it - N2, shm); else cum_item(p, l, it - N3);
    } } PH_END(B + 1)
  PH_BEGIN(B + 2) for (int rep = 0; rep < NREP(2); ++rep) {
    constexpr int N0 = 576, N1 = N0 + 768 + 384, N2 = N1 + 288;
    for (int it = bid; it < N2; it += G) {
      if (it < N0) ssd_p1_item(p, l, it, shm); else if (it < N1) attn_item(p, l, it - N0, shm); else if (rep == 0) s5comb_item(p, l, it - N1);
    } } PH_END(B + 2)
  PH_BEGIN(B + 3) for (int rep = 0; rep < NREP(3); ++rep) {
    constexpr int N0 = 768, N1 = N0 + 6912;
    for (int it = bid; it < N1; it += G) { if (it < N0) s5p2_item(p, l, it, shm); else if (rep == 0) ssdcomb_item(p, l, it - N0); }
    } PH_END(B + 3)
  PH_BEGIN(B + 4) for (int rep = 0; rep < NREP(4); ++rep) {
    for (int it = bid; it < 1152; it += G) ssd_p2_item(p, l, it, shm);
    __syncthreads();
    EpiGlu e{(const u16*)(p.ws + O_G5), pin(p, I_BGLU) + l * 512, (u16*)(p.ws + O_MIX)};
    gemm_phase((const u16*)(p.ws + O_G5), (const u16*)(p.ws + O_WGLU) + (size_t)l * 512 * 512, T, 512, 512, e, shm, 64);
    } PH_END(B + 4)
  PH_BEGIN(B + 5) for (int rep = 0; rep < NREP(5); ++rep) { ph_ssdfinal(p, l); } PH_END(B + 5)
  PH_BEGIN(B + 6) for (int rep = 0; rep < NREP(6); ++rep) { EpiBf16 e{(u16*)(p.ws + O_H)};
    gemm_phase((const u16*)(p.ws + O_MIX), (const u16*)(p.ws + O_WOUT) + (size_t)l * DM * DM, T, DM, DM, e, shm, 0); } PH_END(B + 6)
  PH_BEGIN(B + 7) { const float* modl = (const float*)(p.ws + O_MOD) + (size_t)l * 5 * 12288;
    ph_row<(l == 0 ? 1 : 2), 1>(p, pin(p, I_NMPOST) + l * DM, 4096, pin(p, I_NFPRE) + l * DM, modl, 6144, 8192, modl, (const u16*)p.out, (u16*)(p.ws + O_XB)); } PH_END(B + 7)
  PH_BEGIN(B + 8) for (int rep = 0; rep < NREP(8); ++rep) { EpiSwiglu e{(u16*)(p.ws + O_ACT)};
    gemm_phase((const u16*)(p.ws + O_H), (const u16*)(p.ws + O_WFFI) + (size_t)l * 2 * DFF * DM, T, 2 * DFF, DM, e, shm, 0); } PH_END(B + 8)
  PH_BEGIN(B + 9) for (int rep = 0; rep < NREP(9); ++rep) { EpiBf16 e{(u16*)(p.ws + O_H)};
    gemm_phase((const u16*)(p.ws + O_ACT), (const u16*)(p.ws + O_WFFO) + (size_t)l * DM * DFF, T, DM, DFF, e, shm, 0); } PH_END(B + 9)
  PH_BEGIN(B + 10) { const float* modl = (const float*)(p.ws + O_MOD) + (size_t)l * 5 * 12288;
    constexpr bool last = (l == 1);
    ph_row<2, (last ? 0 : 1)>(p, pin(p, I_NFPOST) + l * DM, 10240, last ? nullptr : pin(p, I_NMPRE) + (l + 1) * DM, last ? modl : modl + 5 * 12288, 0, 2048, modl, (const u16*)(p.ws + O_XB), (u16*)p.out);
    } PH_END(B + 10)
}

__global__ void __launch_bounds__(512) mega(P p0) {
  extern __shared__ __attribute__((aligned(16))) char dyn_smem[];
  LAS char* shm = (LAS char*)dyn_smem;
  cg::grid_group grid = cg::this_grid();
  volatile LAS unsigned* xst = (volatile LAS unsigned*)(shm + 139264);
  if (threadIdx.x < 4) xst[threadIdx.x] = 0u;
  __syncthreads();
  XcdBarrier xb = xcd_barrier_post((unsigned*)(p0.ws + O_BAR), xst);
  TSTAMP(0);
  PH_BEGIN(0) for (int rep = 0; rep < NREP(11); ++rep) { ph_init(p, shm, rep); } PH_END(0)
  PH_BEGIN(1) for (int rep = 0; rep < NREP(12); ++rep) { ph_prenorm(p); } PH_END(1)
  layer_phases<0>(p0, grid, xb, shm);
  layer_phases<1>(p0, grid, xb, shm);
#ifdef TPROBE
  PH_BEGIN(NPH) {
#define TFILL(a, o0, o1) do { const unsigned long long* ts = (const unsigned long long*)(p.ws + O_END2); \
    unsigned long long d = ((a) >= 0) ? ts[(a) + 1] - ts[(a)] : ts[NPH - 1] - ts[0]; size_t n = (size_t)(d / 2); if (n > (size_t)(o1) - (o0)) n = (size_t)(o1) - (o0); \
    for (size_t i = (size_t)blockIdx.x * 512 + otid(); i < n; i += (size_t)gridDim.x * 512) ((unsigned*)p.out)[(o0) + i] = 0xAAAAAAAAu; } while (0)
    TFILL(TP0, 0, 16777216); TFILL(TP1, 16777216, OUT_CK); TFILL(TP2, OUT_CK, OUT_CV); TFILL(TP3, OUT_CV, OUT_SSD);
    TFILL(TP4, OUT_SSD, OUT_S5R); TFILL(TP5, OUT_S5R, OUT_S5I); TFILL(TP6, OUT_S5I, 65536000);
  } }
#endif
}

extern "C" void kernel_launch(void* const* d_in, const int* in_sizes, int n_in, void* d_out, int out_size, void* d_ws, size_t ws_size, hipStream_t stream) {
  static int grid_blocks = 0;
  if (!grid_blocks) {
    if (n_in != N_IN || ws_size < O_END3) { fprintf(stderr, "kernel_launch: bad n_in %d or ws %zu < %zu\n", n_in, ws_size, (size_t)O_END); grid_blocks = -1; return; }
    int dev = 0, cus = 0, per_cu = 0;
    hipGetDevice(&dev);
    hipDeviceGetAttribute(&cus, hipDeviceAttributeMultiprocessorCount, dev);
    hipFuncSetAttribute((const void*)mega, hipFuncAttributeMaxDynamicSharedMemorySize, DYN_LDS);
    hipOccupancyMaxActiveBlocksPerMultiprocessor(&per_cu, (const void*)mega, 512, DYN_LDS);
    if (per_cu < 1) per_cu = 1;
    grid_blocks = cus * per_cu;
    if (grid_blocks % 8) grid_blocks -= grid_blocks % 8;
  }
  if (grid_blocks < 0) return;
  hipMemsetAsync((char*)d_ws + O_MOD, 0, 491520 + 16384, stream);
  P p{};
  for (int i = 0; i < N_IN; ++i) p.in[i] = (const float*)d_in[i];
  p.out = (float*)d_out; p.ws = (char*)d_ws;
#if MULTI_LAUNCH
  for (int ph = 0; ph < NPH_RUN; ++ph) {
    p.lo = ph; p.hi = ph + 1;
    hipLaunchKernelGGL(mega, dim3(grid_blocks), dim3(512), DYN_LDS, stream, p);
  }
#else
#ifdef TPROBE
  p.lo = 0; p.hi = NPH + 1;
#else
  p.lo = 0; p.hi = NPH;
#endif
  void* args[] = {&p};
  hipError_t e = hipLaunchCooperativeKernel((const void*)mega, dim3(grid_blocks), dim3(512), args, DYN_LDS, stream);
  if (e != hipSuccess) fprintf(stderr, "cooperative launch failed: %s (grid %d)\n", hipGetErrorString(e), grid_blocks);
#endif
}
```
